# Optimizing an MI355X kernel written in HIP

```python
import math
import jax, jax.numpy as jnp
from jax import lax
import numpy as np

D_MODEL = 1024
BATCH = 1
SEQ = 16384
DEPTH = 4

GRID_W = 64
CTX_LEN = 256
EPS = 1e-6
ROPE_THETA = 10000.0
Q_BLOCK = 128
N_BRANCH = 3

MLA_HEADS = 8
MLA_Q_RANK = 256
MLA_KV_RANK = 128
MLA_NOPE = 64
MLA_ROPE = 32
MLA_V = 64
MLA_QK = MLA_NOPE + MLA_ROPE
MLA_WIDTH = MLA_HEADS * MLA_V

DIF_HEADS = 4
DIF_HEAD_DIM = 64
DIF_WIDTH = DIF_HEADS * 2 * DIF_HEAD_DIM

SSM_HEADS = 8
SSM_HEAD_DIM = 64
SSM_WIDTH = SSM_HEADS * SSM_HEAD_DIM
SSM_GROUPS = 2
SSM_STATE = 128
SSM_CONV = 5
SSM_CHUNK = 128

N_EXPERTS = 32
TOP_K = 4
D_FF = 1024
SWIGLU_LIMIT = 7.0
SWIGLU_ALPHA = 1.702
MOE_BLOCK = 256

MLA_COLS = MLA_Q_RANK + MLA_KV_RANK + MLA_ROPE
DIF_COLS = 3 * DIF_WIDTH
SSM_COLS = SSM_WIDTH + SSM_WIDTH + 2 * SSM_GROUPS * SSM_STATE + 2 * SSM_HEADS
GATE_COLS = N_BRANCH * D_MODEL
IN_COLS = MLA_COLS + DIF_COLS + SSM_COLS + GATE_COLS

kernel_name = 'hybrid_mla_diff_ssd_moe_diffusion_trunk'


def _rms(x, g):
    xf = x.astype(jnp.float32)
    y = xf * lax.rsqrt(jnp.mean(xf * xf, axis=-1, keepdims=True) + EPS)
    return (y * g.astype(jnp.float32)).astype(x.dtype)


def _modulate(x, g, shift, scale):
    return _rms(x, g) * (1.0 + scale) + shift


def _split(x, sizes):
    idx = np.cumsum(sizes)[:-1].tolist()
    return jnp.split(x, idx, axis=-1)


def _axial_rope_tables(seq_len, rot_dim):
    n_rows = seq_len // GRID_W
    row = jnp.repeat(jnp.arange(n_rows), GRID_W).astype(jnp.float32)
    col = jnp.tile(jnp.arange(GRID_W), n_rows).astype(jnp.float32)
    axis_dim = rot_dim // 2
    inv = ROPE_THETA ** (-jnp.arange(0, axis_dim, 2, dtype=jnp.float32) / axis_dim)
    ang_r = row[:, None] * inv
    ang_c = col[:, None] * inv
    return (jnp.cos(ang_r), jnp.sin(ang_r), jnp.cos(ang_c), jnp.sin(ang_c))


def _rotate(x, cos, sin):
    shape = (x.shape[1],) + (1,) * (x.ndim - 3) + (cos.shape[-1],)
    cos = cos.reshape(shape)
    sin = sin.reshape(shape)
    x1, x2 = jnp.split(x.astype(jnp.float32), 2, axis=-1)
    return jnp.concatenate([x1 * cos - x2 * sin, x2 * cos + x1 * sin], axis=-1).astype(x.dtype)


def _axial_rope(x, tabs):
    cr, sr, cc, sc = tabs
    xr, xc = jnp.split(x, 2, axis=-1)
    return jnp.concatenate([_rotate(xr, cr, sr), _rotate(xc, cc, sc)], axis=-1)


def _sweep_query_blocks(step, q):
    bsz, s = q.shape[:2]
    nb = s // Q_BLOCK
    qb = jnp.swapaxes(q.reshape((bsz, nb, Q_BLOCK) + q.shape[2:]), 0, 1)
    out = lax.map(step, qb)
    return jnp.swapaxes(out, 0, 1).reshape((bsz, s) + out.shape[3:])


def _softmax_attend(q, k, v):
    s = jnp.einsum('bqhd,bkhd->bhqk', q, k).astype(jnp.float32) * (q.shape[-1] ** -0.5)
    p = jax.nn.softmax(s, axis=-1).astype(v.dtype)
    return jnp.einsum('bhqk,bkhe->bqhe', p, v)


def _diff_attend(q, k, v, lam):
    s = jnp.einsum('bqhmd,bkhmd->bmhqk', q, k).astype(jnp.float32) * (q.shape[-1] ** -0.5)
    p = jax.nn.softmax(s, axis=-1)
    w = (p[:, 0] - lam * p[:, 1]).astype(v.dtype)
    return jnp.einsum('bhqk,bkhe->bqhe', w, v)


def _rope_tail(t, tabs, n_rot):
    return jnp.concatenate([t[..., :-n_rot], _axial_rope(t[..., -n_rot:], tabs)], axis=-1)


def _mla_q(cq, g_q, w_uq, g_qn):
    q = _rms(cq, g_q) @ w_uq
    q = q.reshape(q.shape[:2] + (MLA_HEADS, MLA_QK))
    return _rms(q, g_qn)


def _mla_kv(ckv, k_rope, g_kv, w_ukv, g_kn):
    kv = (_rms(ckv, g_kv) @ w_ukv).reshape(ckv.shape[:2] + (MLA_HEADS, MLA_NOPE + MLA_V))
    k_nope, v = jnp.split(kv, [MLA_NOPE], axis=-1)
    k_pe = jnp.broadcast_to(k_rope[:, :, None, :], k_nope.shape[:3] + (MLA_ROPE,))
    k = _rms(jnp.concatenate([k_nope, k_pe], axis=-1), g_kn)
    return k, v


def _mla_branch(cols_ctx, cols_lat, rope, g_q, w_uq, g_kv, w_ukv, g_qn, g_kn, emit_ctx):
    cq_l, ckv_l, kr_l = _split(cols_lat, [MLA_Q_RANK, MLA_KV_RANK, MLA_ROPE])
    cq_c, ckv_c, kr_c = _split(cols_ctx, [MLA_Q_RANK, MLA_KV_RANK, MLA_ROPE])
    k_c, v_c = _mla_kv(ckv_c, kr_c, g_kv, w_ukv, g_kn)
    q_l = _rope_tail(_mla_q(cq_l, g_q, w_uq, g_qn), rope, MLA_ROPE)
    k_l, v_l = _mla_kv(ckv_l, kr_l, g_kv, w_ukv, g_kn)
    k_l = _rope_tail(k_l, rope, MLA_ROPE)
    k_all = jnp.concatenate([k_l, k_c], axis=1)
    v_all = jnp.concatenate([v_l, v_c], axis=1)
    y_l = _sweep_query_blocks(lambda qb: _softmax_attend(qb, k_all, v_all), q_l)
    y_l = y_l.reshape(y_l.shape[:2] + (MLA_WIDTH,))
    y_c = None
    if emit_ctx:
        y_c = _softmax_attend(_mla_q(cq_c, g_q, w_uq, g_qn), k_c, v_c)
        y_c = y_c.reshape(y_c.shape[:2] + (MLA_WIDTH,))
    return y_l, y_c


def _diff_qk(t, g, rope):
    t = _rms(t.reshape(t.shape[:2] + (DIF_HEADS, 2, DIF_HEAD_DIM)), g)
    return t if rope is None else _axial_rope(t, rope)


def _diff_v(t):
    return t.reshape(t.shape[:2] + (DIF_HEADS, 2 * DIF_HEAD_DIM))


def _diff_branch(cols_ctx, cols_lat, rope, g_qn, g_kn, lam_p, g_sub, lam_init, emit_ctx):
    q_l, k_l, v_l = _split(cols_lat, [DIF_WIDTH] * 3)
    q_c, k_c, v_c = _split(cols_ctx, [DIF_WIDTH] * 3)
    lp = lam_p.astype(jnp.float32)
    lam = jnp.exp(jnp.sum(lp[0] * lp[1])) - jnp.exp(jnp.sum(lp[2] * lp[3])) + lam_init
    k_c = _diff_qk(k_c, g_kn, None)
    v_c = _diff_v(v_c)
    q_l = _diff_qk(q_l, g_qn, rope)
    k_l = _diff_qk(k_l, g_kn, rope)
    k_all = jnp.concatenate([k_l, k_c], axis=1)
    v_all = jnp.concatenate([_diff_v(v_l), v_c], axis=1)

    def finish(o):
        return (_rms(o, g_sub) * (1.0 - lam_init)).reshape(o.shape[:2] + (DIF_WIDTH,))

    y_l = finish(_sweep_query_blocks(lambda qb: _diff_attend(qb, k_all, v_all, lam), q_l))
    y_c = finish(_diff_attend(_diff_qk(q_c, g_qn, None), k_c, v_c, lam)) if emit_ctx else None
    return y_l, y_c


def _dwconv_centred(u, w, b):
    ch = u.shape[-1]
    k = w.shape[0]
    y = lax.conv_general_dilated(u, w[:, None, :], window_strides=(1,),
                                 padding=[(k // 2, k // 2)],
                                 dimension_numbers=('NWC', 'WIO', 'NWC'),
                                 feature_group_count=ch)
    return y + b


def _ssd(xs, dt, a, bm, cm, h0):
    bsz, seq, nh, hd = xs.shape
    nc = seq // SSM_CHUNK
    xd = (xs * dt[..., None]).reshape(bsz, nc, SSM_CHUNK, nh, hd)
    bm = bm.reshape(bsz, nc, SSM_CHUNK, nh, SSM_STATE)
    cm = cm.reshape(bsz, nc, SSM_CHUNK, nh, SSM_STATE)
    a_cum = jnp.cumsum(jnp.moveaxis((dt * a).reshape(bsz, nc, SSM_CHUNK, nh), 3, 1), axis=-1)
    causal = jnp.tril(jnp.ones((SSM_CHUNK, SSM_CHUNK), bool))
    seg = jnp.exp(jnp.where(causal, a_cum[..., :, None] - a_cum[..., None, :], -jnp.inf))
    scores = jnp.einsum('bclhn,bcshn->bhcls', cm, bm) * seg
    y_diag = jnp.einsum('bhcls,bcshp->bclhp', scores, xd)
    decay_to_end = jnp.exp(a_cum[..., -1:] - a_cum)
    chunk_states = jnp.einsum('bclhn,bhcl,bclhp->bchpn', bm, decay_to_end, xd)
    chunk_decay = jnp.exp(a_cum[..., -1])

    def carry_state(h, inp):
        s_c, d_c = inp
        return (h * d_c[..., None, None] + s_c).astype(h.dtype), h

    h_final, h_in = lax.scan(carry_state, h0,
                             (jnp.moveaxis(chunk_states, 1, 0), jnp.moveaxis(chunk_decay, 2, 0)))
    y_off = jnp.einsum('bclhn,bchpn,bhcl->bclhp', cm, jnp.moveaxis(h_in, 0, 1), jnp.exp(a_cum))
    return (y_diag + y_off).reshape(bsz, seq, nh, hd), h_final


def _ssm_inputs(cols, conv_w, conv_b, dt_bias):
    z, xbc, dt = _split(cols, [SSM_WIDTH, SSM_WIDTH + 2 * SSM_GROUPS * SSM_STATE, 2 * SSM_HEADS])
    xbc = jax.nn.silu(_dwconv_centred(xbc, conv_w, conv_b))
    xs, bs, cs = _split(xbc, [SSM_WIDTH, SSM_GROUPS * SSM_STATE, SSM_GROUPS * SSM_STATE])
    bsz, l = cols.shape[:2]
    rep = SSM_HEADS // SSM_GROUPS
    xs = xs.reshape(bsz, l, SSM_HEADS, SSM_HEAD_DIM)
    bs = jnp.repeat(bs.reshape(bsz, l, SSM_GROUPS, SSM_STATE), rep, axis=2)
    cs = jnp.repeat(cs.reshape(bsz, l, SSM_GROUPS, SSM_STATE), rep, axis=2)
    dt = jax.nn.softplus(dt.reshape(bsz, l, 2, SSM_HEADS) + dt_bias)
    return z, xs, bs, cs, dt


def _flip_if(t, rev):
    return jnp.flip(t, axis=1) if rev else t


def _gated_group_norm(y, z, g):
    bsz, l = y.shape[:2]
    y = y.reshape(bsz, l, SSM_WIDTH) * jax.nn.silu(z)
    y = _rms(y.reshape(bsz, l, SSM_GROUPS, SSM_WIDTH // SSM_GROUPS), g.reshape(SSM_GROUPS, -1))
    return y.reshape(bsz, l, SSM_WIDTH)


def _ssm_branch(cols_ctx, cols_lat, conv_w, conv_b, dt_bias, a_log, d_skip, g_norm, emit_ctx):
    zc, xc, bc, cc, dtc = _ssm_inputs(cols_ctx, conv_w, conv_b, dt_bias)
    zl, xl, bl, cl, dtl = _ssm_inputs(cols_lat, conv_w, conv_b, dt_bias)
    a = -jnp.exp(a_log)
    h0 = jnp.zeros((xl.shape[0], SSM_HEADS, SSM_HEAD_DIM, SSM_STATE), xl.dtype)
    y_l = 0.0
    y_c = 0.0
    for d in range(2):
        rev = d == 1
        skip = d_skip[d][None, None, :, None]
        yc_d, hc = _ssd(_flip_if(xc, rev), _flip_if(dtc[:, :, d], rev), a[d],
                        _flip_if(bc, rev), _flip_if(cc, rev), h0)
        yl_d, _ = _ssd(_flip_if(xl, rev), _flip_if(dtl[:, :, d], rev), a[d],
                       _flip_if(bl, rev), _flip_if(cl, rev), hc)
        y_l = y_l + _flip_if(yl_d, rev) + skip * xl
        y_c = y_c + _flip_if(yc_d, rev) + skip * xc
    out_l = _gated_group_norm(y_l, zl, g_norm)
    out_c = _gated_group_norm(y_c, zc, g_norm) if emit_ctx else None
    return out_l, out_c


def _merge(ya, yb, yc, gate_cols, p):
    g = jax.nn.sigmoid(gate_cols + p['b_gate'])
    g = g.reshape(gate_cols.shape[:-1] + (N_BRANCH, D_MODEL))
    m = (g[..., 0, :] * (ya @ p['w_up_mla']) + g[..., 1, :] * (yb @ p['w_up_dif'])
         + g[..., 2, :] * (yc @ p['w_up_ssm']))
    return m @ p['w_out']


def _moe(h, w_router, b_router, w_gu, b_gu, w_down, b_down):
    n_tok, dm = h.shape
    logits = (h @ w_router + b_router).astype(jnp.float32)
    top_val, top_idx = lax.top_k(logits, TOP_K)
    gates = jax.nn.softmax(top_val, axis=-1).astype(h.dtype)
    n_assign = n_tok * TOP_K
    flat_e = top_idx.reshape(-1).astype(jnp.int32)
    flat_t = jnp.arange(n_assign, dtype=jnp.int32) // TOP_K
    flat_g = gates.reshape(-1)
    counts = jnp.zeros((N_EXPERTS,), jnp.int32).at[flat_e].add(1)
    padded = (counts + MOE_BLOCK - 1) // MOE_BLOCK * MOE_BLOCK
    pad_end = jnp.cumsum(padded)
    pad_start = pad_end - padded
    raw_start = jnp.cumsum(counts) - counts
    order = jnp.argsort(flat_e)
    sorted_e = flat_e[order]
    dest = pad_start[sorted_e] + jnp.arange(n_assign, dtype=jnp.int32) - raw_start[sorted_e]
    n_blocks = -(-(n_assign + N_EXPERTS * (MOE_BLOCK - 1)) // MOE_BLOCK)
    n_slots = n_blocks * MOE_BLOCK
    slot_tok = jnp.full((n_slots,), n_tok, jnp.int32).at[dest].set(flat_t[order])
    slot_gate = jnp.zeros((n_slots,), h.dtype).at[dest].set(flat_g[order])
    block_start = jnp.arange(n_blocks, dtype=jnp.int32) * MOE_BLOCK
    block_e = jnp.minimum(jnp.searchsorted(pad_end, block_start, side='right'), N_EXPERTS - 1)
    h_pad = jnp.concatenate([h, jnp.zeros((1, dm), h.dtype)], axis=0)
    xb = h_pad[slot_tok].reshape(n_blocks, MOE_BLOCK, dm)

    def expert_block(args):
        xblk, e = args
        gu = xblk @ w_gu[e] + b_gu[e]
        glu, lin = jnp.split(gu, 2, axis=-1)
        glu = jnp.minimum(glu, SWIGLU_LIMIT)
        lin = jnp.clip(lin, -SWIGLU_LIMIT, SWIGLU_LIMIT)
        act = glu * jax.nn.sigmoid(SWIGLU_ALPHA * glu) * (lin + 1.0)
        return act @ w_down[e] + b_down[e]

    yb = lax.map(expert_block, (xb, block_e))
    y_slots = yb.reshape(n_slots, dm) * slot_gate[:, None]
    return jnp.zeros((n_tok + 1, dm), h.dtype).at[slot_tok].add(y_slots)[:n_tok]


def _layer(x_lat, x_ctx, c, c_ctx, rope_mla, rope_dif, lam_init, emit_ctx, p):
    mod_l = (jax.nn.silu(c) @ p['w_mod'] + p['b_mod'])[:, None, :]
    mod_c = jax.nn.silu(c_ctx) @ p['w_mod'] + p['b_mod']
    sh1_l, sc1_l, gt1_l, sh2_l, sc2_l, gt2_l = jnp.split(mod_l, 6, axis=-1)
    sh1_c, sc1_c, gt1_c, sh2_c, sc2_c, gt2_c = jnp.split(mod_c, 6, axis=-1)

    h_l = _modulate(x_lat, p['g_norm1'], sh1_l, sc1_l)
    h_c = _modulate(x_ctx, p['g_norm1'], sh1_c, sc1_c)
    u_l = h_l @ p['w_in']
    u_c = h_c @ p['w_in']
    mla_l, dif_l, ssm_l, gate_l = _split(u_l, [MLA_COLS, DIF_COLS, SSM_COLS, GATE_COLS])
    mla_c, dif_c, ssm_c, gate_c = _split(u_c, [MLA_COLS, DIF_COLS, SSM_COLS, GATE_COLS])

    ya_l, ya_c = _mla_branch(mla_c, mla_l, rope_mla, p['mla_g_q'], p['mla_w_uq'], p['mla_g_kv'],
                             p['mla_w_ukv'], p['mla_g_qn'], p['mla_g_kn'], emit_ctx)
    yb_l, yb_c = _diff_branch(dif_c, dif_l, rope_dif, p['dif_g_qn'], p['dif_g_kn'],
                              p['dif_lambda'], p['dif_g_sub'], lam_init, emit_ctx)
    yc_l, yc_c = _ssm_branch(ssm_c, ssm_l, p['ssm_conv_w'], p['ssm_conv_b'], p['ssm_dt_bias'],
                             p['ssm_a_log'], p['ssm_d'], p['ssm_g_norm'], emit_ctx)

    x_lat = x_lat + gt1_l * _merge(ya_l, yb_l, yc_l, gate_l, p)
    f_l = _modulate(x_lat, p['g_norm2'], sh2_l, sc2_l)
    moe_args = (p['moe_w_router'], p['moe_b_router'], p['moe_w_gu'], p['moe_b_gu'],
                p['moe_w_down'], p['moe_b_down'])
    if emit_ctx:
        x_ctx = x_ctx + gt1_c * _merge(ya_c, yb_c, yc_c, gate_c, p)
        f_c = _modulate(x_ctx, p['g_norm2'], sh2_c, sc2_c)
        n_c = f_c.shape[0] * f_c.shape[1]
        y = _moe(jnp.concatenate([f_c.reshape(-1, D_MODEL), f_l.reshape(-1, D_MODEL)], axis=0), *moe_args)
        x_ctx = x_ctx + gt2_c * y[:n_c].reshape(x_ctx.shape)
        y_l = y[n_c:]
    else:
        y_l = _moe(f_l.reshape(-1, D_MODEL), *moe_args)
    x_lat = x_lat + gt2_l * y_l.reshape(x_lat.shape)
    return x_lat, x_ctx


def setup_inputs(seed: int = 0) -> dict:
    key = jax.random.key(seed)
    ks = iter(jax.random.split(key, 48))
    L = DEPTH

    def nrm(shape, scale):
        return jax.random.normal(next(ks), shape, jnp.float32) * scale

    def gain(shape):
        return 1.0 + nrm(shape, 0.05)

    x = nrm((BATCH, SEQ, D_MODEL), 1.0)
    c = nrm((BATCH, D_MODEL), 1.0)
    ctx = nrm((BATCH, CTX_LEN, D_MODEL), 1.0)
    c_ctx = nrm((D_MODEL,), 1.0)
    w_mod = nrm((L, D_MODEL, 6 * D_MODEL), 0.5 * D_MODEL ** -0.5)
    b_mod = nrm((L, 6 * D_MODEL), 0.02)
    g_norm1 = gain((L, D_MODEL))
    g_norm2 = gain((L, D_MODEL))
    w_in = nrm((L, D_MODEL, IN_COLS), D_MODEL ** -0.5)
    b_gate = nrm((L, GATE_COLS), 0.02)
    mla_g_q = gain((L, MLA_Q_RANK))
    mla_w_uq = nrm((L, MLA_Q_RANK, MLA_HEADS * MLA_QK), MLA_Q_RANK ** -0.5)
    mla_g_kv = gain((L, MLA_KV_RANK))
    mla_w_ukv = nrm((L, MLA_KV_RANK, MLA_HEADS * (MLA_NOPE + MLA_V)), MLA_KV_RANK ** -0.5)
    mla_g_qn = gain((L, MLA_QK))
    mla_g_kn = gain((L, MLA_QK))
    dif_g_qn = gain((L, DIF_HEAD_DIM))
    dif_g_kn = gain((L, DIF_HEAD_DIM))
    dif_lambda = nrm((L, 4, DIF_HEAD_DIM), 0.1)
    dif_g_sub = gain((L, 2 * DIF_HEAD_DIM))
    ssm_conv_w = nrm((L, SSM_CONV, SSM_WIDTH + 2 * SSM_GROUPS * SSM_STATE), SSM_CONV ** -0.5)
    ssm_conv_b = nrm((L, SSM_WIDTH + 2 * SSM_GROUPS * SSM_STATE), 0.02)
    dt0 = jnp.exp(jax.random.uniform(next(ks), (L, 2, SSM_HEADS), jnp.float32,
                                     minval=math.log(1e-3), maxval=math.log(1e-1)))
    ssm_dt_bias = dt0 + jnp.log(-jnp.expm1(-dt0))
    ssm_a_log = jnp.log(jax.random.uniform(next(ks), (L, 2, SSM_HEADS), jnp.float32,
                                           minval=1.0, maxval=16.0))
    ssm_d = gain((L, 2, SSM_HEADS))
    ssm_g_norm = gain((L, SSM_WIDTH))
    w_up_mla = nrm((L, MLA_WIDTH, D_MODEL), MLA_WIDTH ** -0.5)
    w_up_dif = nrm((L, DIF_WIDTH, D_MODEL), DIF_WIDTH ** -0.5)
    w_up_ssm = nrm((L, SSM_WIDTH, D_MODEL), SSM_WIDTH ** -0.5)
    w_out = nrm((L, D_MODEL, D_MODEL), D_MODEL ** -0.5)
    moe_w_router = nrm((L, D_MODEL, N_EXPERTS), D_MODEL ** -0.5)
    moe_b_router = nrm((L, N_EXPERTS), 0.01)
    moe_w_gu = nrm((L, N_EXPERTS, D_MODEL, 2 * D_FF), D_MODEL ** -0.5)
    moe_b_gu = nrm((L, N_EXPERTS, 2 * D_FF), 0.02)
    moe_w_down = nrm((L, N_EXPERTS, D_FF, D_MODEL), D_FF ** -0.5)
    moe_b_down = nrm((L, N_EXPERTS, D_MODEL), 0.02)
    return {'x': x, 'c': c, 'ctx': ctx, 'c_ctx': c_ctx, 'w_mod': w_mod, 'b_mod': b_mod,
            'g_norm1': g_norm1, 'g_norm2': g_norm2, 'w_in': w_in, 'b_gate': b_gate,
            'mla_g_q': mla_g_q, 'mla_w_uq': mla_w_uq, 'mla_g_kv': mla_g_kv, 'mla_w_ukv': mla_w_ukv,
            'mla_g_qn': mla_g_qn, 'mla_g_kn': mla_g_kn, 'dif_g_qn': dif_g_qn, 'dif_g_kn': dif_g_kn,
            'dif_lambda': dif_lambda, 'dif_g_sub': dif_g_sub, 'ssm_conv_w': ssm_conv_w,
            'ssm_conv_b': ssm_conv_b, 'ssm_dt_bias': ssm_dt_bias, 'ssm_a_log': ssm_a_log,
            'ssm_d': ssm_d, 'ssm_g_norm': ssm_g_norm, 'w_up_mla': w_up_mla, 'w_up_dif': w_up_dif,
            'w_up_ssm': w_up_ssm, 'w_out': w_out, 'moe_w_router': moe_w_router,
            'moe_b_router': moe_b_router, 'moe_w_gu': moe_w_gu, 'moe_b_gu': moe_b_gu,
            'moe_w_down': moe_w_down, 'moe_b_down': moe_b_down}


def reference(x, c, ctx, c_ctx, w_mod, b_mod, g_norm1, g_norm2, w_in, b_gate, mla_g_q, mla_w_uq,
              mla_g_kv, mla_w_ukv, mla_g_qn, mla_g_kn, dif_g_qn, dif_g_kn, dif_lambda, dif_g_sub,
              ssm_conv_w, ssm_conv_b, ssm_dt_bias, ssm_a_log, ssm_d, ssm_g_norm, w_up_mla, w_up_dif,
              w_up_ssm, w_out, moe_w_router, moe_b_router, moe_w_gu, moe_b_gu, moe_w_down,
              moe_b_down):
    rope_mla = _axial_rope_tables(x.shape[1], MLA_ROPE)
    rope_dif = _axial_rope_tables(x.shape[1], DIF_HEAD_DIM)
    x_lat, x_ctx = x, ctx
    for i in range(DEPTH):
        p = {'w_mod': w_mod[i], 'b_mod': b_mod[i], 'g_norm1': g_norm1[i], 'g_norm2': g_norm2[i],
             'w_in': w_in[i], 'b_gate': b_gate[i], 'mla_g_q': mla_g_q[i], 'mla_w_uq': mla_w_uq[i],
             'mla_g_kv': mla_g_kv[i], 'mla_w_ukv': mla_w_ukv[i], 'mla_g_qn': mla_g_qn[i],
             'mla_g_kn': mla_g_kn[i], 'dif_g_qn': dif_g_qn[i], 'dif_g_kn': dif_g_kn[i],
             'dif_lambda': dif_lambda[i], 'dif_g_sub': dif_g_sub[i], 'ssm_conv_w': ssm_conv_w[i],
             'ssm_conv_b': ssm_conv_b[i], 'ssm_dt_bias': ssm_dt_bias[i], 'ssm_a_log': ssm_a_log[i],
             'ssm_d': ssm_d[i], 'ssm_g_norm': ssm_g_norm[i], 'w_up_mla': w_up_mla[i],
             'w_up_dif': w_up_dif[i], 'w_up_ssm': w_up_ssm[i], 'w_out': w_out[i],
             'moe_w_router': moe_w_router[i], 'moe_b_router': moe_b_router[i],
             'moe_w_gu': moe_w_gu[i], 'moe_b_gu': moe_b_gu[i], 'moe_w_down': moe_w_down[i],
             'moe_b_down': moe_b_down[i]}
        lam_init = 0.8 - 0.6 * math.exp(-0.3 * i)
        x_lat, x_ctx = _layer(x_lat, x_ctx, c, c_ctx, rope_mla, rope_dif, lam_init,
                              i < DEPTH - 1, p)
    return x_lat
```

```cpp
#include <hip/hip_runtime.h>
#include <stdint.h>
#include <stdio.h>

#define DI __device__ __forceinline__
#define LAS __attribute__((address_space(3)))
typedef unsigned short bf16_t;
typedef short bf16x8 __attribute__((ext_vector_type(8)));
typedef float f32x16 __attribute__((ext_vector_type(16)));
typedef float f32x4 __attribute__((ext_vector_type(4)));
typedef float f32x2 __attribute__((ext_vector_type(2)));
typedef unsigned u32x4 __attribute__((ext_vector_type(4)));
typedef unsigned u32x2 __attribute__((ext_vector_type(2)));
typedef __bf16 bf16x2v __attribute__((ext_vector_type(2)));
typedef int i32x4 __attribute__((ext_vector_type(4)));

DI unsigned pk2(float a, float b) { f32x2 v = {a, b}; return __builtin_bit_cast(unsigned, __builtin_convertvector(v, bf16x2v)); }
typedef int i32x8 __attribute__((ext_vector_type(8)));
DI unsigned pk_fp8x4(float a, float b, float c, float d) { int v = __builtin_amdgcn_cvt_pk_fp8_f32(a, b, 0, false); v = __builtin_amdgcn_cvt_pk_fp8_f32(c, d, v, true); return (unsigned)v; }
DI unsigned pk_bf8x4(float a, float b, float c, float d) { int v = __builtin_amdgcn_cvt_pk_bf8_f32(a, b, 0, false); v = __builtin_amdgcn_cvt_pk_bf8_f32(c, d, v, true); return (unsigned)v; }
typedef short s16x2 __attribute__((ext_vector_type(2)));
DI unsigned pk_bf8x4s(float a, float b, float c, float d, float sc) {
    s16x2 r; asm volatile("" : "=v"(r));
    r = __builtin_amdgcn_cvt_scalef32_pk_bf8_f32(r, a, b, sc, false); r = __builtin_amdgcn_cvt_scalef32_pk_bf8_f32(r, c, d, sc, true); return __builtin_bit_cast(unsigned, r); }
DI void st_fp8x16(unsigned char* p, const float* v) {
    u32x4 w; w.x = pk_fp8x4(v[0], v[1], v[2], v[3]); w.y = pk_fp8x4(v[4], v[5], v[6], v[7]); w.z = pk_fp8x4(v[8], v[9], v[10], v[11]); w.w = pk_fp8x4(v[12], v[13], v[14], v[15]);
    *(u32x4*)p = w;
}
DI bf16_t f2bf(float a) { return (bf16_t)(pk2(a, 0.f) & 0xffffu); }
DI float bf2f(bf16_t v) { return __uint_as_float(((unsigned)v) << 16); }
DI float bflo(unsigned w) { return __uint_as_float(w << 16); }
DI float bfhi(unsigned w) { return __uint_as_float(w & 0xffff0000u); }
template <int CTRL, int RM> DI float dpp_add(float v) { const int y = __builtin_amdgcn_update_dpp(0, __float_as_int(v), CTRL, RM, 0xF, false); return v + __int_as_float(y); }
DI float quad_sum(float v) { v = dpp_add<0xB1, 0xF>(v); v = dpp_add<0x4E, 0xF>(v); return v; }
DI float oct_sum(float v) { v = quad_sum(v); v = dpp_add<0x141, 0xF>(v); return v; }
DI float wave_sum(float v) { v = oct_sum(v); v = dpp_add<0x140, 0xF>(v); v = dpp_add<0x142, 0xA>(v); v = dpp_add<0x143, 0xC>(v);
    return __int_as_float(__builtin_amdgcn_readlane(__float_as_int(v), 63)); }
template <int CTRL, int RM> DI float dpp_max(float v) { const int y = __builtin_amdgcn_update_dpp(__float_as_int(v), __float_as_int(v), CTRL, RM, 0xF, false); return fmaxf(v, __int_as_float(y)); }
DI float wave_max(float v) { v = dpp_max<0xB1, 0xF>(v); v = dpp_max<0x4E, 0xF>(v); v = dpp_max<0x141, 0xF>(v); v = dpp_max<0x140, 0xF>(v); v = dpp_max<0x142, 0xA>(v); v = dpp_max<0x143, 0xC>(v);
    return __int_as_float(__builtin_amdgcn_readlane(__float_as_int(v), 63)); }
DI unsigned pack_i8x4(float a, float b, float c, float d) {
    const int ia = (int)fminf(fmaxf(rintf(a), -127.f), 127.f), ib = (int)fminf(fmaxf(rintf(b), -127.f), 127.f), ic = (int)fminf(fmaxf(rintf(c), -127.f), 127.f), id = (int)fminf(fmaxf(rintf(d), -127.f), 127.f);
    return (unsigned)(ia & 0xff) | ((unsigned)(ib & 0xff) << 8) | ((unsigned)(ic & 0xff) << 16) | ((unsigned)(id & 0xff) << 24); }
DI float lane_xor1(float v) { return __int_as_float(__builtin_amdgcn_update_dpp(0, __float_as_int(v), 0xB1, 0xF, 0xF, false)); }
DI int opaque_tid() { int t = threadIdx.x; asm volatile("" : "+v"(t)); return t; }
DI int opaque_bid() { int b = blockIdx.x; asm volatile("" : "+s"(b)); return b; }
DI float fexp2(float x) { return __builtin_amdgcn_exp2f(x); }
DI float fexp(float x) { return __builtin_amdgcn_exp2f(x * 1.4426950408889634f); }
DI float frcp(float x) { return __builtin_amdgcn_rcpf(x); }
DI float sigmoidf_(float x) { return __builtin_amdgcn_rcpf(1.0f + __builtin_amdgcn_exp2f(-1.4426950408889634f * x)); }
DI float siluf_(float x) { return x * sigmoidf_(x); }

#define XB_TMO      128
#define XB_XCNT(j)  (256  + 64 * (j))
#define XB_XSUB(j)  (1280 + 64 * (j))
#define XB_XGEN(j)  (2304 + 64 * (j))
#define XB_TOP      3328
#define XB_TOPGEN   3392
#define XCD_BAR_WORDS 3456
#define XB_SPIN_CAP (1u << 18)
__device__ __forceinline__ unsigned xb_ld(unsigned* p)              { return __hip_atomic_load(p, __ATOMIC_RELAXED, __HIP_MEMORY_SCOPE_AGENT); }
__device__ __forceinline__ unsigned xb_add(unsigned* p, unsigned v) { return __hip_atomic_fetch_add(p, v, __ATOMIC_RELAXED, __HIP_MEMORY_SCOPE_AGENT); }
__device__ __forceinline__ unsigned xb_xcc_id() { return (unsigned)__builtin_amdgcn_s_getreg((3 << 11) | 20) & 0xFu; }
#define XB_SPIN(cond, bar) do { unsigned _sp = 0; while (cond) { __builtin_amdgcn_s_sleep(1); \
    if ((++_sp & 255u) == 0u) { if (xb_ld(&(bar)[XB_TMO])) break; if (_sp > XB_SPIN_CAP) { atomicAdd(&(bar)[XB_TMO], 1u); break; } } } } while (0)
struct XcdBarrier { unsigned* bar; unsigned x; volatile LAS unsigned* st; };
__device__ __forceinline__ XcdBarrier xcd_barrier_post(unsigned* bar, volatile LAS unsigned* st) {
    XcdBarrier b; b.bar = bar; b.x = xb_xcc_id(); b.st = st;
    if (threadIdx.x == 0) (void)xb_add(&bar[XB_XCNT(b.x)], 1u);
    return b;
}
__device__ __forceinline__ void xcd_barrier_complete(unsigned* bar, unsigned x, unsigned& nloc, unsigned& nx) {
    const unsigned G = gridDim.x * gridDim.y * gridDim.z;
    unsigned sum, cnt, mine, sp = 0u;
    for (;;) {
        sum = 0u; cnt = 0u; mine = 0u;
#pragma unroll
        for (unsigned j = 0; j < 16; ++j) { const unsigned c = xb_ld(&bar[XB_XCNT(j)]); sum += c; cnt += (c > 0u) ? 1u : 0u; mine = (j == x) ? c : mine; }
        if (sum == G) break;
        __builtin_amdgcn_s_sleep(1);
        if ((++sp & 255u) == 0u) { if (xb_ld(&bar[XB_TMO])) break; if (sp > XB_SPIN_CAP) { atomicAdd(&bar[XB_TMO], 1u); break; } }
    }
    nloc = mine > 0u ? mine : 1u; nx = cnt > 0u ? cnt : 1u;
}
__device__ __forceinline__ void xcd_barrier(const XcdBarrier& b) {
    asm volatile("s_waitcnt vmcnt(0)" ::: "memory");
    __syncthreads();
    if (threadIdx.x == 0) {
        unsigned* bar = b.bar;
        __builtin_amdgcn_s_waitcnt(0);
        unsigned nloc = b.st[0], nx = b.st[1];
        if (nloc == 0u) { xcd_barrier_complete(bar, b.x, nloc, nx); b.st[0] = nloc; b.st[1] = nx; }
        const unsigned old = xb_add(&bar[XB_XSUB(b.x)], 1u);
        const unsigned gen = old / nloc;
        if (old + 1u == (gen + 1u) * nloc) {
            __builtin_amdgcn_fence(__ATOMIC_RELEASE, "agent");
            asm volatile("s_waitcnt vmcnt(0)" ::: "memory");
            const unsigned og = xb_add(&bar[XB_TOP], 1u);
            const unsigned tg = og / nx;
            if (og + 1u == (tg + 1u) * nx) xb_add(&bar[XB_TOPGEN], 1u);
            else XB_SPIN(xb_ld(&bar[XB_TOPGEN]) == tg, bar);
            __builtin_amdgcn_fence(__ATOMIC_ACQUIRE, "agent");
            xb_add(&bar[XB_XGEN(b.x)], 1u);
            asm volatile("s_waitcnt vmcnt(0)" ::: "memory");
        } else {
            XB_SPIN(xb_ld(&bar[XB_XGEN(b.x)]) == gen, bar);
            __builtin_amdgcn_fence(__ATOMIC_ACQUIRE, "agent");
            asm volatile("s_waitcnt vmcnt(0)" ::: "memory");
        }
    }
    __syncthreads();
}

constexpr int DM = 1024, SEQ = 16384, CTXN = 256, T = SEQ + CTXN, NLAYER = 4;
constexpr int NIN = 6912;
constexpr int U_CQ = 0, U_CKV = 256, U_KR = 384, U_DQ = 512, U_DK = 1024, U_DV = 1536, U_Z = 2048, U_XS = 2560, U_B = 3072, U_C = 3328, U_DT = 3584, U_G = 3840;
constexpr int NT64 = T / 64, NCHUNK = T / 128, NQB = T / 256;
constexpr int NEXP = 32, DFF = 1024;
constexpr int MOE_ROWS = 74752;
constexpr float EPS = 1e-6f;
constexpr float LOG2E = 1.4426950408889634f;
constexpr int NTHR = 512;
constexpr int GRID = 256;
constexpr int LDS_BYTES = 160 * 1024 - 256;

constexpr size_t al256(size_t x) { return (x + 255) & ~(size_t)255; }
constexpr size_t WS_BAR   = 0;
constexpr size_t WS_CTL   = al256(WS_BAR + XCD_BAR_WORDS * 4);
constexpr int ECS = 64;
constexpr size_t WS_MOD   = al256(WS_CTL + (size_t)NLAYER * 32 * ECS * 4);
constexpr size_t WS_TAB   = al256(WS_MOD + (size_t)NLAYER * 2 * 6144 * 4);
constexpr size_t TAB_FLOATS = (256 + 64) * 8 * 2 + (256 + 64) * 16 * 2;
constexpr size_t WS_WRT   = al256(WS_TAB + TAB_FLOATS * 4);
constexpr size_t WS_WIN   = al256(WS_WRT + (size_t)NLAYER * 32 * 1024 * 4);
constexpr size_t SZ_WIN   = (size_t)NIN * 1024;
constexpr size_t WS_WUQ   = al256(WS_WIN + NLAYER * SZ_WIN);
constexpr size_t SZ_WUQ   = (size_t)768 * 256 * 2;
constexpr size_t WS_WUKV  = al256(WS_WUQ + NLAYER * SZ_WUQ);
constexpr size_t SZ_WUKV  = (size_t)1024 * 256 * 2;
constexpr size_t WS_WUP   = al256(WS_WUKV + NLAYER * SZ_WUKV);
constexpr size_t SZ_WUP   = (size_t)3 * 1024 * 512 * 2;
constexpr size_t WS_WOUT  = al256(WS_WUP + NLAYER * SZ_WUP);
constexpr size_t SZ_WOUT  = (size_t)1024 * 1024 * 2;
constexpr size_t WS_WGU   = al256(WS_WOUT + NLAYER * SZ_WOUT);
constexpr size_t SZ_WGU   = (size_t)32 * 2048 * 1024;
constexpr size_t WS_WDN   = al256(WS_WGU + NLAYER * SZ_WGU);
constexpr size_t SZ_WDN   = (size_t)32 * 1024 * 1024 * 2;
constexpr size_t WS_XCUR  = al256(WS_WDN + NLAYER * SZ_WDN);
constexpr size_t WS_H     = al256(WS_XCUR + (size_t)T * 1024 * 4);
constexpr size_t WS_U     = al256(WS_H + (size_t)T * 1024 * 2);
constexpr size_t WS_DTR   = al256(WS_U + (size_t)T * NIN * 2);
constexpr size_t WS_QRAW  = al256(WS_DTR + (size_t)T * 16 * 4);
constexpr size_t WS_KVRAW = al256(WS_QRAW + (size_t)T * 768 * 2);
constexpr size_t WS_QM    = al256(WS_KVRAW + (size_t)T * 1024 * 2);
constexpr size_t WS_KM    = al256(WS_QM + (size_t)8 * T * 96 * 2);
constexpr size_t WS_VMT   = al256(WS_KM + (size_t)8 * T * 96 * 2);
constexpr size_t WS_QD    = al256(WS_VMT + (size_t)8 * T * 64 * 2);
constexpr size_t WS_KD    = al256(WS_QD + (size_t)8 * T * 64 * 2);
constexpr size_t WS_VDT   = al256(WS_KD + (size_t)8 * T * 64 * 2);
constexpr size_t WS_XSN   = al256(WS_VDT + (size_t)4 * T * 128 * 2);
constexpr size_t WS_XST   = al256(WS_XSN + (size_t)T * 512 * 2);
constexpr size_t WS_BCN   = al256(WS_XST + (size_t)T * 512 * 2);
constexpr size_t WS_DTS   = al256(WS_BCN + (size_t)T * 512 * 2);
constexpr size_t WS_CUM   = al256(WS_DTS + (size_t)T * 16 * 4);
constexpr size_t WS_ST    = al256(WS_CUM + (size_t)T * 16 * 4);
constexpr size_t WS_DEC   = al256(WS_ST + (size_t)NCHUNK * 16 * 8192 * 2);
constexpr size_t WS_HIN   = al256(WS_DEC + (size_t)NCHUNK * 16 * 4);
constexpr size_t WS_YA    = al256(WS_HIN + (size_t)NCHUNK * 16 * 8192 * 2);
constexpr size_t WS_YB    = al256(WS_YA + (size_t)T * 512 * 2);
constexpr size_t WS_YC    = al256(WS_YB + (size_t)T * 512 * 2);
constexpr size_t WS_O1    = al256(WS_YC + (size_t)T * 512 * 2);
constexpr size_t WS_MRG   = al256(WS_O1 + (size_t)320 * 256 * 128 * 4);
constexpr size_t WS_TOPE  = al256(WS_MRG + (size_t)T * 1024 * 2);
constexpr size_t WS_TOPP  = al256(WS_TOPE + (size_t)T * 16);
constexpr size_t WS_TOPG  = al256(WS_TOPP + (size_t)T * 16);
constexpr size_t WS_ELIST = al256(WS_TOPG + (size_t)T * 16);
constexpr size_t WS_ACT   = al256(WS_ELIST + (size_t)32 * T * 4);
constexpr size_t WS_YMOE  = al256(WS_ACT + (size_t)MOE_ROWS * 1024 * 2);
constexpr size_t WS_XG    = al256(WS_YMOE + (size_t)MOE_ROWS * 1024 * 2);
constexpr size_t WS_XGS   = al256(WS_XG + (size_t)32 * T * 1024);
constexpr size_t WS_WGS   = al256(WS_XGS + (size_t)32 * T * 4);
constexpr size_t WS_WINS  = al256(WS_WGS + (size_t)NLAYER * 32 * 2048 * 4);
constexpr size_t WS_HS    = al256(WS_WINS + (size_t)NLAYER * NIN * 4);
constexpr size_t WS_END   = al256(WS_HS + (size_t)T * 4);

struct Params {
    const float* in[36];
    float* out;
    unsigned char* ws;
    int ph_lo, ph_hi;
};

DI int perm32(int r) { return 16 * ((r >> 2) & 1) + 4 * (r >> 3) + (r & 3); }
DI int swz128(int row, int chunk) { return row * 128 + ((chunk ^ ((row >> 1) & 7)) << 4); }

#define MFMA32(a, b, c) __builtin_amdgcn_mfma_f32_32x32x16_bf16((a), (b), (c), 0, 0, 0)

template <int NI> struct GemmAcc { f32x16 a[4][NI]; };

template <int NI, class ARow, int MI = 4>
DI void gemm_tile(char* lds, const ARow& arow, const bf16_t* __restrict__ Bt, int ldb, int K, GemmAcc<NI>& acc) {
    const int tid = opaque_tid(), lane = tid & 63, wid = tid >> 6, wr = wid >> 2, wc = wid & 3, r = lane & 31, h = lane >> 5;
    const int lrow = tid >> 3, lc = tid & 7;
    constexpr int NB = 2 * NI;
    constexpr int STG = 32768 + 16384 * NI;
    const bf16_t* ap[MI];
#pragma unroll
    for (int i = 0; i < MI; ++i) ap[i] = arow(lrow + 64 * i) + lc * 8;
    const bf16_t* bp = Bt + (size_t)lrow * ldb + lc * 8;
    const int woff = swz128(lrow, lc);
#pragma unroll
    for (int mi = 0; mi < MI; ++mi)
#pragma unroll
        for (int ni = 0; ni < NI; ++ni)
#pragma unroll
            for (int i = 0; i < 16; ++i) acc.a[mi][ni][i] = 0.f;
    u32x4 ra0[MI], rb0[NB], ra1[MI], rb1[NB];
#define GT_LOAD(RA, RB, ko) do { _Pragma("unroll") for (int i = 0; i < MI; ++i) RA[i] = *(const u32x4*)(ap[i] + (ko)); \
        _Pragma("unroll") for (int i = 0; i < NB; ++i) RB[i] = *(const u32x4*)(bp + (size_t)i * 64 * ldb + (ko)); } while (0)
#define GT_STORE(RA, RB, so) do { _Pragma("unroll") for (int i = 0; i < MI; ++i) *(u32x4*)(lds + (so) + woff + i * 8192) = RA[i]; \
        _Pragma("unroll") for (int i = 0; i < NB; ++i) *(u32x4*)(lds + (so) + 32768 + woff + i * 8192) = RB[i]; } while (0)
    const int nk = K >> 6;
    const int xsw = (r >> 1) & 7;
    const int pr = perm32(r), wsw = (pr >> 1) & 7;
    const int xbase = (wr * 32 * MI + r) * 128, wbase = 32768 + (wc * 32 * NI + pr) * 128;
#define GT_COMPUTE(st) do { _Pragma("unroll") for (int ks = 0; ks < 4; ++ks) { bf16x8 wf[NI], xf[MI]; \
        _Pragma("unroll") for (int ni = 0; ni < NI; ++ni) wf[ni] = *(const bf16x8*)(lds + (st) + wbase + ni * 4096 + (((2 * ks + h) ^ wsw) << 4)); \
        _Pragma("unroll") for (int mi = 0; mi < MI; ++mi) xf[mi] = *(const bf16x8*)(lds + (st) + xbase + mi * 4096 + (((2 * ks + h) ^ xsw) << 4)); \
        _Pragma("unroll") for (int mi = 0; mi < MI; ++mi) _Pragma("unroll") for (int ni = 0; ni < NI; ++ni) acc.a[mi][ni] = MFMA32(wf[ni], xf[mi], acc.a[mi][ni]); } } while (0)
    GT_LOAD(ra0, rb0, 0);
    GT_STORE(ra0, rb0, 0);
    GT_LOAD(ra1, rb1, 64);
    __syncthreads();
    for (int kt = 0; kt < nk; kt += 2) {
        if (kt + 2 < nk) GT_LOAD(ra0, rb0, (kt + 2) * 64);
        GT_COMPUTE(0);
        GT_STORE(ra1, rb1, STG);
        __syncthreads();
        if (kt + 3 < nk) GT_LOAD(ra1, rb1, (kt + 3) * 64);
        GT_COMPUTE(STG);
        if (kt + 2 < nk) GT_STORE(ra0, rb0, 0);
        __syncthreads();
    }
#undef GT_LOAD
#undef GT_STORE
#undef GT_COMPUTE
}

struct ARowPlain { const bf16_t* base; size_t ld; DI const bf16_t* operator()(int row) const { return base + (size_t)row * ld; } };
struct ARowGather { const bf16_t* base; const int* idx; DI const bf16_t* operator()(int row) const { return base + (size_t)idx[row] * 1024; } };

DI void st_bf16x16(bf16_t* p, const float* v) {
    u32x4 a, b;
    a.x = pk2(v[0], v[1]); a.y = pk2(v[2], v[3]); a.z = pk2(v[4], v[5]); a.w = pk2(v[6], v[7]);
    b.x = pk2(v[8], v[9]); b.y = pk2(v[10], v[11]); b.z = pk2(v[12], v[13]); b.w = pk2(v[14], v[15]);
    *(u32x4*)p = a; *(u32x4*)(p + 8) = b;
}

namespace g8 {
constexpr int BK = 64, HALF = 128, HTB = HALF * BK * 2, STAGE_BYTES = 8 * HTB;
DI int lds_byte(int r, int c) { const int st = (r >> 4) * 2 + (c >> 5), rr = r & 15, cc = c & 31, ob = rr * 64 + cc * 2; return st * 1024 + (ob ^ (((ob >> 9) & 1) << 5)); }
DI void stage_rc(int b, int& R, int& C) { const int st = b / 1024, sb = b % 1024, swz = sb ^ (((sb >> 9) & 1) << 5); R = (st >> 1) * 16 + swz / 64; C = (st & 1) * 32 + (swz % 64) / 2; }
DI int perm32g(int rho) { const int n = rho >> 4, i = rho & 15; return 8 * (i >> 2) + 4 * n + (i & 3); }
struct Unit { const char* a; const char* b; int t0, t1; };
typedef f32x4 Acc[2][2][4][2];
typedef i32x4 AccI[2][2][4][2];
template <bool I8> struct AccSel { typedef f32x4 T; };
template <> struct AccSel<true> { typedef i32x4 T; };

template <bool PERM, bool I8 = false, class Sched, class Epi>
DI void gemm_phase(LAS unsigned char* lds, const int K, const int lda, const Sched& S, const Epi& E) {
    typedef typename AccSel<I8>::T AT_;
    const int tid = opaque_tid(), wid = __builtin_amdgcn_readfirstlane(tid >> 6), lane = tid & 63, wr = wid >> 2, wc = wid & 3, fr = lane & 15, fq = lane >> 4;
    const int nt = K / BK;
    unsigned voffA[2], voffB[2];
#pragma unroll
    for (int i = 0; i < 2; ++i) { int R, C; stage_rc(tid * 16 + i * 8192, R, C); const int Rb = PERM ? ((R & ~31) + perm32g(R & 31)) : R;
        voffA[i] = (unsigned)(R * lda + C) * 2u; voffB[i] = (unsigned)(Rb * K + C) * 2u; }
    const size_t kstep = (size_t)(BK * 2);
    const size_t hstepA = (size_t)HALF * lda * 2, hstepB = (size_t)HALF * K * 2;
    const unsigned ldsw = (unsigned)wid * 1024u;
    const int aoff = lds_byte(wr * 64 + fr, fq * 8), boff = lds_byte(wc * 32 + fr, fq * 8);
#define G8_SA(b, h) (((b) * 2 + (h)) * HTB)
#define G8_SB(b, h) ((4 + (b) * 2 + (h)) * HTB)
#define G8_STAGE(bufoff, gbase, voff) do { _Pragma("unroll") for (int _i = 0; _i < 2; ++_i) \
        __builtin_amdgcn_global_load_lds((const unsigned*)((const char*)(gbase) + (voff)[_i]), (LAS unsigned*)(lds + (bufoff) + ldsw + _i * 8192), 16, 0, 0); } while (0)
#define G8_LDA(dst, b, h) do { _Pragma("unroll") for (int m = 0; m < 4; ++m) _Pragma("unroll") for (int k = 0; k < 2; ++k) dst[m][k] = *(const LAS bf16x8*)(lds + G8_SA(b, h) + aoff + m * 2048 + k * 1024); } while (0)
#define G8_LDB(dst, b, h) do { _Pragma("unroll") for (int n = 0; n < 2; ++n) _Pragma("unroll") for (int k = 0; k < 2; ++k) dst[n][k] = *(const LAS bf16x8*)(lds + G8_SB(b, h) + boff + n * 2048 + k * 1024); } while (0)
#define G8_MMA(ai, bj, At, Bt) do { __builtin_amdgcn_s_setprio(1); _Pragma("unroll") for (int m = 0; m < 4; ++m) _Pragma("unroll") for (int n = 0; n < 2; ++n) _Pragma("unroll") for (int k = 0; k < 2; ++k) \
        { if constexpr (I8) acc[ai][bj][m][n] = __builtin_amdgcn_mfma_i32_16x16x64_i8(__builtin_bit_cast(i32x4, Bt[n][k]), __builtin_bit_cast(i32x4, At[m][k]), acc[ai][bj][m][n], 0, 0, 0); \
          else acc[ai][bj][m][n] = __builtin_amdgcn_mfma_f32_16x16x32_bf16(Bt[n][k], At[m][k], acc[ai][bj][m][n], 0, 0, 0); } __builtin_amdgcn_s_setprio(0); } while (0)
#define G8_WAIT_V(n) asm volatile("s_waitcnt vmcnt(" #n ")" ::: "memory")
#define G8_WAIT_L(n) asm volatile("s_waitcnt lgkmcnt(" #n ")" ::: "memory")
#define G8_BAR __builtin_amdgcn_s_barrier()
#define G8_SCHED __builtin_amdgcn_sched_barrier(0)
    Unit cur, nxt; int ui = 0;
    if (!S.next(0, cur)) return;
    AT_ acc[2][2][4][2];
#pragma unroll
    for (int a = 0; a < 2; ++a)
#pragma unroll
        for (int b = 0; b < 2; ++b)
#pragma unroll
            for (int m = 0; m < 4; ++m)
#pragma unroll
                for (int n = 0; n < 2; ++n) acc[a][b][m][n] = AT_{};
    bf16x8 At[4][2], B0[2][2], B1[2][2];
    const char* cA = cur.a; const char* cB = cur.b;
    G8_STAGE(G8_SB(0, 0), cB, voffB); G8_STAGE(G8_SA(0, 0), cA, voffA); G8_STAGE(G8_SB(0, 1), cB + hstepB, voffB); G8_STAGE(G8_SA(0, 1), cA + hstepA, voffA);
    if (wr == 1) G8_BAR;
    G8_WAIT_V(4); G8_BAR;
    G8_STAGE(G8_SB(1, 0), cB + kstep, voffB); G8_STAGE(G8_SA(1, 0), cA + kstep, voffA); G8_STAGE(G8_SB(1, 1), cB + hstepB + kstep, voffB);
    G8_WAIT_V(6); G8_BAR;
    for (;;) {
        const bool has_next = S.next(ui + 1, nxt);
        const char* nA = has_next ? nxt.a : cA; const char* nB = has_next ? nxt.b : cB;
        for (int t = 0; t < nt; t += 2) {
            const bool last = (t == nt - 2);
            const char* a1 = cA + (size_t)(t + 1) * kstep;
            const char* a2 = last ? nA : cA + (size_t)(t + 2) * kstep; const char* b2 = last ? nB : cB + (size_t)(t + 2) * kstep;
            const char* a3 = a2 + kstep; const char* b3 = b2 + kstep;
            G8_LDB(B0, 0, 0); G8_SCHED; G8_LDA(At, 0, 0); G8_STAGE(G8_SA(1, 1), a1 + hstepA, voffA);
            G8_WAIT_L(8); G8_BAR; G8_WAIT_L(0); G8_MMA(0, 0, At, B0); G8_BAR; G8_SCHED;
            G8_LDB(B1, 0, 1); G8_STAGE(G8_SB(0, 0), b2, voffB);
            G8_BAR; G8_WAIT_L(0); G8_MMA(0, 1, At, B1); G8_BAR;
            G8_LDA(At, 0, 1); G8_STAGE(G8_SA(0, 0), a2, voffA);
            G8_BAR; G8_WAIT_L(0); G8_MMA(1, 0, At, B0); G8_BAR; G8_SCHED;
            G8_STAGE(G8_SB(0, 1), b2 + hstepB, voffB);
            G8_WAIT_V(6); G8_BAR; G8_MMA(1, 1, At, B1); G8_BAR;
            G8_LDB(B0, 1, 0); G8_SCHED; G8_LDA(At, 1, 0); G8_STAGE(G8_SA(0, 1), a2 + hstepA, voffA);
            G8_WAIT_L(8); G8_BAR; G8_WAIT_L(0); G8_MMA(0, 0, At, B0); G8_BAR; G8_SCHED;
            G8_LDB(B1, 1, 1); G8_STAGE(G8_SB(1, 0), b3, voffB);
            G8_BAR; G8_WAIT_L(0); G8_MMA(0, 1, At, B1); G8_BAR;
            G8_LDA(At, 1, 1); G8_STAGE(G8_SA(1, 0), a3, voffA);
            G8_BAR; G8_WAIT_L(0); G8_MMA(1, 0, At, B0); G8_BAR; G8_SCHED;
            G8_STAGE(G8_SB(1, 1), b3 + hstepB, voffB);
            G8_WAIT_V(6); G8_BAR; G8_MMA(1, 1, At, B1); G8_BAR;
        }
        E(acc, cur, wr, wc, fr, fq);
        if (!has_next) break;
#pragma unroll
        for (int a = 0; a < 2; ++a)
#pragma unroll
            for (int b = 0; b < 2; ++b)
#pragma unroll
                for (int m = 0; m < 4; ++m)
#pragma unroll
                    for (int n = 0; n < 2; ++n) acc[a][b][m][n] = AT_{};
        cur = nxt; cA = nA; cB = nB; ++ui;
    }
    G8_WAIT_V(0);
    if (wr == 0) G8_BAR;
    G8_BAR;
#undef G8_SA
#undef G8_SB
#undef G8_STAGE
#undef G8_LDA
#undef G8_LDB
#undef G8_MMA
#undef G8_WAIT_V
#undef G8_WAIT_L
#undef G8_BAR
#undef G8_SCHED
}

template <int nM, int nN>
struct GridSched {
    const char* A; const char* Bt; size_t astep, bstep; int c; int gs;
    DI void init(const void* A_, size_t lda, const void* Bt_, int K) { A = (const char*)A_; Bt = (const char*)Bt_; astep = 256 * lda * 2; bstep = (size_t)256 * K * 2; c = blockIdx.x; asm volatile("" : "+s"(c)); gs = GRID; }
    DI bool next(int i, Unit& u) const {
        constexpr int nwg = nM * nN;
        const int L = i * gs + c; if (L >= nwg) return false;
        int wgid = L; { constexpr int q = nwg / 8, r = nwg % 8; const int xcd = wgid % 8, off = wgid / 8; wgid = (xcd < r ? xcd * (q + 1) : r * (q + 1) + (xcd - r) * q) + off; }
        constexpr int nig = 8 * nN; const int gid = wgid / nig, fm = gid * 8, gsz = (nM - fm) < 8 ? (nM - fm) : 8;
        const int rem = wgid % nig;
        static_assert((nM % 8) == 0 || (nM % 8) == 1 || (nM % 8) == 2 || (nM % 8) == 4, "partial row-tile group must be a power of two");
        const int sh = __builtin_ctz(gsz);
        const int pm = fm + (rem & (gsz - 1)), pn = rem >> sh;
        u.a = A + (size_t)pm * astep; u.b = Bt + (size_t)pn * bstep; u.t0 = pm; u.t1 = pn; return true;
    }
};
}

template <int DK, int DV>
DI void attn_core(char* lds, const bf16_t* __restrict__ Qrows  , const unsigned char* __restrict__ Kt, const unsigned char* __restrict__ Vt,
                  int kt0, int kt1, float shift, f32x16 (&o)[DV / 32], float& lsum_out) {
    constexpr int KCH = DK / 16;
    constexpr int KROWB = (DK == 96) ? 128 : 64;
    constexpr int KSTG = 64 * KROWB, VSTG = DV * 64;
    constexpr int VBASE = 8 * KSTG;
    constexpr int NKP = KSTG / 1024, NVP = VSTG / 1024;
    constexpr int KTILEB = 64 * DK, VTILEB = DV * 64;
    const int tid = opaque_tid(), lane = tid & 63, r = lane & 31, h = lane >> 5;
    const int wid = __builtin_amdgcn_readfirstlane(tid >> 6);
    i32x8 qf8[(DK + 63) / 64];
    {
        const bf16_t* qp = Qrows + (size_t)r * DK;
#pragma unroll
        for (int st = 0; st < (DK + 63) / 64; ++st) {
            const int e0 = (st == 0) ? 32 * h : 64;
            unsigned d[8];
#pragma unroll
            for (int j = 0; j < 4; ++j) { const u32x4 w = *(const u32x4*)(qp + e0 + 8 * j);
                d[2 * j] = pk_fp8x4(bflo(w.x) * 8.0f, bfhi(w.x) * 8.0f, bflo(w.y) * 8.0f, bfhi(w.y) * 8.0f);
                d[2 * j + 1] = pk_fp8x4(bflo(w.z) * 8.0f, bfhi(w.z) * 8.0f, bflo(w.w) * 8.0f, bfhi(w.w) * 8.0f); }
            if (st == 1 && h == 1) {
#pragma unroll
                for (int j = 0; j < 8; ++j) d[j] = 0u;
            }
            qf8[st] = (i32x8){(int)d[0], (int)d[1], (int)d[2], (int)d[3], (int)d[4], (int)d[5], (int)d[6], (int)d[7]};
        }
    }
#define MFMA8(a, b, c) __builtin_amdgcn_mfma_scale_f32_32x32x64_f8f6f4((a), (b), (c), 0, 0, 0, 0x7F7F7F7F, 0, 0x7C7C7C7C)
#pragma unroll
    for (int db = 0; db < DV / 32; ++db)
#pragma unroll
        for (int i = 0; i < 16; ++i) o[db][i] = 0.f;
    const f32x16 cvec = {0.f, 0.f, 0.f, 0.f, 0.f, 0.f, 0.f, 0.f, 0.f, 0.f, 0.f, 0.f, 0.f, 0.f, 0.f, 0.f};
    const int csh = __builtin_amdgcn_readfirstlane((int)ceilf(fmaxf(shift - 15.0f, 0.f)));
    const float psc = __int_as_float((127 + csh) << 23);
    const int pvs = 127 + csh;
    float lsum = 0.f;
    const char* kg = (const char*)Kt + (size_t)kt0 * KTILEB;
    const char* vg = (const char*)Vt + (size_t)kt0 * VTILEB;
    LAS unsigned char* l3 = (LAS unsigned char*)lds;
    const int n = kt1 - kt0;
#define AT_DMAK(slot) do { if (wid < NKP) { const int b_ = wid * 1024 + lane * 16; const int row_ = b_ / KROWB, cs_ = (b_ % KROWB) >> 4; \
        const int c_ = (DK == 96) ? (cs_ ^ ((row_ >> 1) & 7)) : (cs_ ^ ((row_ >> 2) & 3)); \
        if (c_ < KCH) __builtin_amdgcn_global_load_lds((const unsigned*)(kg + (row_ * DK + c_ * 16)), (LAS unsigned*)(l3 + (slot) * KSTG + wid * 1024), 16, 0, 0); } kg += KTILEB; } while (0)
#define AT_DMAV(slot) do { const int pv_ = wid - (8 - NVP); if (pv_ >= 0) { const int b_ = pv_ * 1024 + lane * 16; const int row_ = b_ >> 6, cs_ = (b_ & 63) >> 4; const int c_ = cs_ ^ ((row_ >> 2) & 3) ^ ((row_ >> 4) & 1); \
        __builtin_amdgcn_global_load_lds((const unsigned*)(vg + (row_ * 64 + c_ * 16)), (LAS unsigned*)(l3 + VBASE + (slot) * VSTG + pv_ * 1024), 16, 0, 0); } vg += VTILEB; } while (0)
    const int pr = perm32(r), vsw = ((pr >> 2) & 3) ^ ((pr >> 4) & 1);
    const int onev = (((lane & 15) == 0 && ((lane >> 4) & 1) == 0) || ((lane & 15) == 1 && ((lane >> 4) & 1) == 1)) ? 0x38383838 : 0;
    f32x4 ol = {0.f, 0.f, 0.f, 0.f};
#define MFMA8S(b, c) __builtin_amdgcn_mfma_scale_f32_16x16x128_f8f6f4(((i32x8){onev, onev, onev, onev, onev, onev, onev, onev}), (b), (c), 0, 1, 0, 0x7F7F7F7F, 0, pvs)
    const int ksw = (DK == 96) ? ((r >> 1) & 7) : ((r >> 2) & 3);
#define MFMA8V(a, b, c) __builtin_amdgcn_mfma_scale_f32_32x32x64_f8f6f4((a), (b), (c), 0, 1, 0, 0x7F7F7F7F, 0, pvs)
#define AT_LD32(dst, rowp, c0, sw) do { const u32x4 a0_ = *(const u32x4*)((rowp) + ((((c0)) ^ (sw)) << 4)), a1_ = *(const u32x4*)((rowp) + ((((c0) + 1) ^ (sw)) << 4)); \
        dst = (i32x8){(int)a0_.x, (int)a0_.y, (int)a0_.z, (int)a0_.w, (int)a1_.x, (int)a1_.y, (int)a1_.z, (int)a1_.w}; } while (0)
#define AT_KROW(slot, kb) (lds + (slot) * KSTG + ((kb) * 32 + r) * KROWB)
#define AT_VROW(slot, db) (lds + VBASE + (slot) * VSTG + ((db) * 32 + pr) * 64)
#define AT_EXP(S, kb, a, b) do { _Pragma("unroll") for (int i_ = (a); i_ < (b); ++i_) S[kb][i_] = fexp2(S[kb][i_]); } while (0)
#define AT_ADD(S, kb, a, b) do { _Pragma("unroll") for (int i_ = (a); i_ < (b); ++i_) lsum += S[kb][i_]; } while (0)
#define AT_CVT(S, kb, d) do { _Pragma("unroll") for (int q_ = 0; q_ < 4; ++q_) d[4 * (kb) + q_] = pk_bf8x4s(S[kb][4 * q_], S[kb][4 * q_ + 1], S[kb][4 * q_ + 2], S[kb][4 * q_ + 3], psc); } while (0)
#define AT_SB __builtin_amdgcn_sched_barrier(0)
#define AT_QK(S, slot) do { _Pragma("unroll") for (int kb = 0; kb < 2; ++kb) { i32x8 kf; AT_LD32(kf, AT_KROW(slot, kb), 2 * h, ksw); S[kb] = MFMA8(kf, qf8[0], cvec); \
        if (DK == 96) { AT_LD32(kf, AT_KROW(slot, kb), 4, ksw); S[kb] = MFMA8(kf, qf8[(DK + 63) / 64 - 1], S[kb]); } } } while (0)
    i32x8 kc0, kc1;
#define AT_STEP(S, SN, ks, vs, PRE, NXT) do { unsigned d_[8]; \
        if (DK == 96) { i32x8 k1_, k3_, v0_, v1_; \
            if (!(PRE)) { AT_LD32(kc0, AT_KROW(ks, 0), 2 * h, ksw); AT_LD32(kc1, AT_KROW(ks, 1), 2 * h, ksw); } AT_SB; \
            SN[0] = MFMA8(kc0, qf8[0], cvec); AT_LD32(k1_, AT_KROW(ks, 0), 4, ksw); AT_EXP(S, 0, 0, 8); AT_SB; \
            SN[1] = MFMA8(kc1, qf8[0], cvec); AT_LD32(k3_, AT_KROW(ks, 1), 4, ksw); AT_EXP(S, 0, 8, 16); AT_SB; \
            SN[0] = MFMA8(k1_, qf8[(DK + 63) / 64 - 1], SN[0]); AT_LD32(v0_, AT_VROW(vs, 0), 2 * h, vsw); AT_EXP(S, 1, 0, 8); AT_SB; \
            SN[1] = MFMA8(k3_, qf8[(DK + 63) / 64 - 1], SN[1]); AT_LD32(v1_, AT_VROW(vs, 1), 2 * h, vsw); AT_EXP(S, 1, 8, 16); AT_SB; \
            o[0] = MFMA8V(v0_, pf8, o[0]); if (NXT) AT_LD32(kc0, AT_KROW(((ks) + 1) & 7, 0), 2 * h, ksw); AT_CVT(S, 0, d_); AT_SB; \
            o[1] = MFMA8V(v1_, pf8, o[1]); if (NXT) AT_LD32(kc1, AT_KROW(((ks) + 1) & 7, 1), 2 * h, ksw); AT_CVT(S, 1, d_); AT_SB; \
            ol = MFMA8S(pf8, ol); AT_SB; \
        } else { i32x8 v0_, v1_, v2_, v3_; \
            AT_LD32(kc0, AT_KROW(ks, 0), 2 * h, ksw); AT_LD32(kc1, AT_KROW(ks, 1), 2 * h, ksw); AT_SB;        \
            SN[0] = MFMA8(kc0, qf8[0], cvec); AT_LD32(v0_, AT_VROW(vs, 0), 2 * h, vsw); AT_EXP(S, 0, 0, 8); AT_SB; \
            SN[1] = MFMA8(kc1, qf8[0], cvec); AT_LD32(v1_, AT_VROW(vs, 1), 2 * h, vsw); AT_EXP(S, 0, 8, 16); AT_SB; \
            o[0] = MFMA8V(v0_, pf8, o[0]); AT_LD32(v2_, AT_VROW(vs, DV / 32 - 2), 2 * h, vsw); AT_EXP(S, 1, 0, 8); AT_SB; \
            o[1] = MFMA8V(v1_, pf8, o[1]); AT_LD32(v3_, AT_VROW(vs, DV / 32 - 1), 2 * h, vsw); AT_EXP(S, 1, 8, 16); AT_SB; \
            o[DV / 32 - 2] = MFMA8V(v2_, pf8, o[DV / 32 - 2]); AT_CVT(S, 0, d_); AT_SB; \
            o[DV / 32 - 1] = MFMA8V(v3_, pf8, o[DV / 32 - 1]); AT_CVT(S, 1, d_); AT_SB; \
            ol = MFMA8S(pf8, ol); AT_SB; \
        } \
        pf8 = (i32x8){(int)d_[0], (int)d_[1], (int)d_[2], (int)d_[3], (int)d_[4], (int)d_[5], (int)d_[6], (int)d_[7]}; } while (0)
    AT_DMAK(0); AT_DMAK(1); AT_DMAK(2); AT_DMAK(3); if (n > 4) AT_DMAK(4);
    AT_DMAV(7); vg -= VTILEB; AT_DMAV(0); AT_DMAV(1); AT_DMAV(2);
    asm volatile("s_waitcnt vmcnt(0)" ::: "memory");
    __syncthreads();
    f32x16 sa[2], sb[2];
    i32x8 pf8 = {0, 0, 0, 0, 0, 0, 0, 0};
    AT_QK(sa, 0);
    __syncthreads();
    for (int p = 0; p < n; p += 8) {
        if (p + 5 < n) { AT_DMAK(5); AT_DMAK(6); AT_DMAK(7); AT_DMAK(0); }
        AT_DMAV(3); if (p + 4 < n) { AT_DMAV(4); AT_DMAV(5); AT_DMAV(6); }
        AT_STEP(sa, sb, 1, 7, 0, 1); AT_STEP(sb, sa, 2, 0, 1, 1); AT_STEP(sa, sb, 3, 1, 1, 1); AT_STEP(sb, sa, 4, 2, 1, 0);
        asm volatile("s_waitcnt vmcnt(0)" ::: "memory");
        __syncthreads();
        if (p + 4 >= n) break;
        if (p + 9 < n) { AT_DMAK(1); AT_DMAK(2); AT_DMAK(3); AT_DMAK(4); }
        AT_DMAV(7); if (p + 8 < n) { AT_DMAV(0); AT_DMAV(1); AT_DMAV(2); }
        AT_STEP(sa, sb, 5, 3, 0, 1); AT_STEP(sb, sa, 6, 4, 1, 1); AT_STEP(sa, sb, 7, 5, 1, 1); AT_STEP(sb, sa, 0, 6, 1, 0);
        asm volatile("s_waitcnt vmcnt(0)" ::: "memory");
        __syncthreads();
    }
#pragma unroll
    for (int db = 0; db < DV / 32; ++db) { i32x8 vf; AT_LD32(vf, AT_VROW((n - 1) & 7, db), 2 * h, vsw); o[db] = MFMA8V(vf, pf8, o[db]); }
    ol = MFMA8S(pf8, ol);
#undef AT_DMAK
#undef AT_DMAV
#undef AT_QK
#undef AT_STEP
#undef AT_LD32
#undef AT_KROW
#undef AT_VROW
#undef AT_EXP
#undef AT_ADD
#undef AT_CVT
#undef AT_SB
#undef MFMA8
#undef MFMA8V
#undef MFMA8S
    { const float s0 = __shfl(ol[0], lane & 15), s1 = __shfl(ol[1], lane & 15); lsum_out = ((lane & 16) ? s1 : s0) + lsum; }
}
DI int kperm8(int pos) { const int h = pos >> 5, j = pos & 31; return ((j >> 4) << 5) | (((j >> 2) & 3) << 3) | (h << 2) | (j & 3); }
DI int kperm(int k) { return (k & ~12) | ((k & 4) << 1) | ((k & 8) >> 1); }


DI int win_src_col(int n) {
    if (n < 416) return n;
    if (n < 512) return -1;
    if (n < 3600) return n - 96;
    if (n < 3840) return -1;
    return n - 336;
}
DI int wgu_src_col(int rr) {
    const int ct = rr >> 8, half = (rr >> 7) & 1, jj = rr & 127;
    return half * 1024 + ct * 128 + jj;
}
template <int MAP>
DI void xpose_unit(float* tl, const float* __restrict__ src, int ld_src, int k0, int n0, bf16_t* __restrict__ dst, int ld_dst, const float* __restrict__ kscale) {
    (void)tl;
    const int tid = opaque_tid(), lane = tid & 63, wid = tid >> 6;
    const int n4 = (wid & 3) * 32 + (lane & 7) * 4, k8 = (wid >> 2) * 64 + (lane >> 3) * 8;
    const int nn = n0 + n4;
    const int sc = (MAP == 0) ? nn : (MAP == 1 ? win_src_col(nn) : wgu_src_col(nn));
    f32x4 v[8];
#pragma unroll
    for (int j = 0; j < 8; ++j)
        v[j] = (sc >= 0) ? __builtin_nontemporal_load((const f32x4*)(src + (size_t)(k0 + k8 + j) * ld_src + sc)) : (f32x4){0.f, 0.f, 0.f, 0.f};
    if (kscale) {
        const f32x4 s0 = *(const f32x4*)(kscale + k0 + k8), s1 = *(const f32x4*)(kscale + k0 + k8 + 4);
        v[0] = v[0] * s0.x; v[1] = v[1] * s0.y; v[2] = v[2] * s0.z; v[3] = v[3] * s0.w; v[4] = v[4] * s1.x; v[5] = v[5] * s1.y; v[6] = v[6] * s1.z; v[7] = v[7] * s1.w;
    }
    bf16_t* d = dst + (size_t)(n0 + n4) * ld_dst + k0 + k8;
    { u32x4 w;
      w.x = pk2(v[0].x, v[1].x); w.y = pk2(v[2].x, v[3].x); w.z = pk2(v[4].x, v[5].x); w.w = pk2(v[6].x, v[7].x); *(u32x4*)d = w;
      w.x = pk2(v[0].y, v[1].y); w.y = pk2(v[2].y, v[3].y); w.z = pk2(v[4].y, v[5].y); w.w = pk2(v[6].y, v[7].y); *(u32x4*)(d + ld_dst) = w;
      w.x = pk2(v[0].z, v[1].z); w.y = pk2(v[2].z, v[3].z); w.z = pk2(v[4].z, v[5].z); w.w = pk2(v[6].z, v[7].z); *(u32x4*)(d + 2 * (size_t)ld_dst) = w;
      w.x = pk2(v[0].w, v[1].w); w.y = pk2(v[2].w, v[3].w); w.z = pk2(v[4].w, v[5].w); w.w = pk2(v[6].w, v[7].w); *(u32x4*)(d + 3 * (size_t)ld_dst) = w; }
}

template <int MAP, int LDS_>
DI void quant_rows_unit(char* ldsb, const float* __restrict__ src  , int nt, signed char* __restrict__ dst  , float* __restrict__ scales  ) {
    const int tid = threadIdx.x;
    const int nb = tid & 7, kb = tid >> 3;
    const int n0 = nt * 32, n4 = nb * 4;
    const int sc = (MAP == 1) ? win_src_col(n0 + n4) : wgu_src_col(n0 + n4);
    float* am = (float*)ldsb;
    f32x4 v[16];
#pragma unroll
    for (int j = 0; j < 16; ++j) v[j] = (sc >= 0) ? __builtin_nontemporal_load((const f32x4*)(src + (size_t)(kb * 16 + j) * LDS_ + sc)) : (f32x4){0.f, 0.f, 0.f, 0.f};
    f32x4 mx = {0.f, 0.f, 0.f, 0.f};
#pragma unroll
    for (int j = 0; j < 16; ++j) { mx.x = fmaxf(mx.x, fabsf(v[j].x)); mx.y = fmaxf(mx.y, fabsf(v[j].y)); mx.z = fmaxf(mx.z, fabsf(v[j].z)); mx.w = fmaxf(mx.w, fabsf(v[j].w)); }
    *(f32x4*)(am + kb * 32 + n4) = mx;
    __syncthreads();
    if (tid < 32) { float m = 0.f;
#pragma unroll
        for (int q = 0; q < 64; ++q) m = fmaxf(m, am[q * 32 + tid]);
        const float sc_ = (m > 0.f) ? m * (1.0f / 127.0f) : 1.0f;
        scales[n0 + tid] = sc_; am[2048 + tid] = 1.0f / sc_; }
    __syncthreads();
    const f32x4 inv = *(const f32x4*)(am + 2048 + n4);
    signed char* d = dst + (size_t)(n0 + n4) * 1024 + kb * 16;
    { u32x4 w;
      w.x = pack_i8x4(v[0].x * inv.x, v[1].x * inv.x, v[2].x * inv.x, v[3].x * inv.x); w.y = pack_i8x4(v[4].x * inv.x, v[5].x * inv.x, v[6].x * inv.x, v[7].x * inv.x);
      w.z = pack_i8x4(v[8].x * inv.x, v[9].x * inv.x, v[10].x * inv.x, v[11].x * inv.x); w.w = pack_i8x4(v[12].x * inv.x, v[13].x * inv.x, v[14].x * inv.x, v[15].x * inv.x);
      *(u32x4*)d = w;
      w.x = pack_i8x4(v[0].y * inv.y, v[1].y * inv.y, v[2].y * inv.y, v[3].y * inv.y); w.y = pack_i8x4(v[4].y * inv.y, v[5].y * inv.y, v[6].y * inv.y, v[7].y * inv.y);
      w.z = pack_i8x4(v[8].y * inv.y, v[9].y * inv.y, v[10].y * inv.y, v[11].y * inv.y); w.w = pack_i8x4(v[12].y * inv.y, v[13].y * inv.y, v[14].y * inv.y, v[15].y * inv.y);
      *(u32x4*)(d + 1024) = w;
      w.x = pack_i8x4(v[0].z * inv.z, v[1].z * inv.z, v[2].z * inv.z, v[3].z * inv.z); w.y = pack_i8x4(v[4].z * inv.z, v[5].z * inv.z, v[6].z * inv.z, v[7].z * inv.z);
      w.z = pack_i8x4(v[8].z * inv.z, v[9].z * inv.z, v[10].z * inv.z, v[11].z * inv.z); w.w = pack_i8x4(v[12].z * inv.z, v[13].z * inv.z, v[14].z * inv.z, v[15].z * inv.z);
      *(u32x4*)(d + 2048) = w;
      w.x = pack_i8x4(v[0].w * inv.w, v[1].w * inv.w, v[2].w * inv.w, v[3].w * inv.w); w.y = pack_i8x4(v[4].w * inv.w, v[5].w * inv.w, v[6].w * inv.w, v[7].w * inv.w);
      w.z = pack_i8x4(v[8].w * inv.w, v[9].w * inv.w, v[10].w * inv.w, v[11].w * inv.w); w.w = pack_i8x4(v[12].w * inv.w, v[13].w * inv.w, v[14].w * inv.w, v[15].w * inv.w);
      *(u32x4*)(d + 3072) = w; }
    __syncthreads();
}

constexpr int XP_WIN = NIN / 32  , XP_WUQ = 2 * 6, XP_WUKV = 2 * 8, XP_WUP = 3 * 4 * 8, XP_WOUT = 8 * 8, XP_WGU = 32 * 64  , XP_WDN = 32 * 8 * 8;
constexpr int XP_LAYER = XP_WIN + XP_WUQ + XP_WUKV + XP_WUP + XP_WOUT + XP_WGU + XP_WDN;
constexpr int N_MODU = NLAYER * 96;

constexpr int XP_WDN_MERGE = 3 * (GRID - 32);
constexpr int XP_WDN_DOWN0 = XP_WDN_MERGE + 512, XP_WDN_DOWN1 = XP_WDN_DOWN0 + 512;
constexpr int XP_WDN_ROWS0 = XP_WDN - 336;
constexpr int XP_WDN_OUTN = (XP_WDN_DOWN0 - XP_WDN_MERGE) + (XP_WDN_ROWS0 - XP_WDN_DOWN1);
DI void wdn_units(const Params& P, int l, int u0, int u1, int rk, int nb) {
    unsigned char* ws = P.ws;
    for (int rr = u0 + rk; rr < u1; rr += nb) { const int e = rr / 64, q = rr % 64, kt = q & 7, nt = q >> 3;
        xpose_unit<0>(nullptr, P.in[34] + ((size_t)l * 32 + e) * 1024 * 1024, 1024, kt * 128, nt * 128, (bf16_t*)(ws + WS_WDN + l * SZ_WDN) + (size_t)e * 1024 * 1024, 1024, nullptr); }
}
DI void phase_prologue(const Params& P, char* lds) {
    float* tl = (float*)lds;
    unsigned char* ws = P.ws;
    const int G = GRID, b = blockIdx.x, tid = threadIdx.x;
    for (int u = b; u < NLAYER * XP_LAYER; u += G) {
        const int l = NLAYER - 1 - u / XP_LAYER; int rr = u % XP_LAYER;
        if (rr < XP_WIN) { quant_rows_unit<1, 6576>(lds, P.in[8] + (size_t)l * 1024 * 6576, rr, (signed char*)(ws + WS_WIN + l * SZ_WIN), (float*)(ws + WS_WINS) + (size_t)l * NIN); continue; }
        rr -= XP_WIN;
        if (rr < XP_WUQ) { const int kt = rr & 1, nt = rr >> 1;
            xpose_unit<0>(tl, P.in[11] + (size_t)l * 256 * 768, 768, kt * 128, nt * 128, (bf16_t*)(ws + WS_WUQ + l * SZ_WUQ), 256, P.in[10] + l * 256); continue; }
        rr -= XP_WUQ;
        if (rr < XP_WUKV) { const int kt = rr & 1, nt = rr >> 1;
            if (kt == 0) xpose_unit<0>(tl, P.in[13] + (size_t)l * 128 * 1024, 1024, 0, nt * 128, (bf16_t*)(ws + WS_WUKV + l * SZ_WUKV), 256, P.in[12] + l * 128);
            else { bf16_t* d = (bf16_t*)(ws + WS_WUKV + l * SZ_WUKV) + (size_t)(nt * 128 + (tid >> 2)) * 256 + 128 + (tid & 3) * 32;
#pragma unroll
                for (int q = 0; q < 4; ++q) *(u32x4*)(d + 8 * q) = (u32x4){0u, 0u, 0u, 0u}; }
            continue; }
        rr -= XP_WUKV;
        if (rr < XP_WUP) { const int br = rr / 32, q = rr % 32, kt = q & 3, nt = q >> 2;
            xpose_unit<0>(tl, P.in[26 + br] + (size_t)l * 512 * 1024, 1024, kt * 128, nt * 128, (bf16_t*)(ws + WS_WUP + l * SZ_WUP) + (size_t)br * 1024 * 512, 512, nullptr); continue; }
        rr -= XP_WUP;
        if (rr < XP_WOUT) { const int kt = rr & 7, nt = rr >> 3;
            xpose_unit<0>(tl, P.in[29] + (size_t)l * 1024 * 1024, 1024, kt * 128, nt * 128, (bf16_t*)(ws + WS_WOUT + l * SZ_WOUT), 1024, nullptr); continue; }
        rr -= XP_WOUT;
        if (rr < XP_WGU) { const int e = rr >> 6, nt = rr & 63;
            quant_rows_unit<2, 2048>(lds, P.in[32] + ((size_t)l * 32 + e) * 1024 * 2048, nt, (signed char*)(ws + WS_WGU + l * SZ_WGU) + (size_t)e * 2048 * 1024, (float*)(ws + WS_WGS) + ((size_t)l * 32 + e) * 2048); continue; }
        rr -= XP_WGU;
        if (l == 0) { const int e = rr / 64, q = rr % 64, kt = q & 7, nt = q >> 3;
            xpose_unit<0>(tl, P.in[34] + ((size_t)l * 32 + e) * 1024 * 1024, 1024, kt * 128, nt * 128, (bf16_t*)(ws + WS_WDN + l * SZ_WDN) + (size_t)e * 1024 * 1024, 1024, nullptr); }
    }
    __syncthreads();
    {
        float* sv = (float*)lds;
        float* red = sv + 2048;
        for (int i = tid; i < 2048; i += NTHR) { const float x = (i < 1024) ? P.in[1][i] : P.in[3][i - 1024]; sv[i] = siluf_(x); }
        __syncthreads();
        float* MOD = (float*)(ws + WS_MOD);
        for (int u = b; u < N_MODU; u += G) {
            const int l = u / 96, cg = u % 96, col = cg * 64 + (tid & 63), kp = tid >> 6;
            const float* w = P.in[4] + (size_t)l * 1024 * 6144 + col;
            float a0 = 0.f, a1 = 0.f;
#pragma unroll 16
            for (int k = kp * 128; k < kp * 128 + 128; ++k) { const float wv = w[(size_t)k * 6144]; a0 += sv[k] * wv; a1 += sv[1024 + k] * wv; }
            red[(kp * 64 + (tid & 63)) * 2 + 0] = a0; red[(kp * 64 + (tid & 63)) * 2 + 1] = a1;
            __syncthreads();
            if (tid < 128) { const int c = tid & 63, wsel = tid >> 6; float s = 0.f;
#pragma unroll
                for (int q = 0; q < 8; ++q) s += red[(q * 64 + c) * 2 + wsel];
                MOD[((size_t)l * 2 + wsel) * 6144 + cg * 64 + c] = s + P.in[5][(size_t)l * 6144 + cg * 64 + c]; }
            __syncthreads();
        }
    }
    if (b == G - 1) {
        float* TAB = (float*)(ws + WS_TAB);
        for (int i = tid; i < 320 * 8; i += NTHR) { const int pos = i >> 3, f = i & 7; const float p = (float)(pos < 256 ? pos : pos - 256);
            const float inv = exp2f(-((float)(2 * f) / 16.0f) * 13.287712379549449f); const float ang = p * inv;
            TAB[i] = cosf(ang); TAB[320 * 8 + i] = sinf(ang); }
        for (int i = tid; i < 320 * 16; i += NTHR) { const int pos = i >> 4, f = i & 15; const float p = (float)(pos < 256 ? pos : pos - 256);
            const float inv = exp2f(-((float)(2 * f) / 32.0f) * 13.287712379549449f); const float ang = p * inv;
            TAB[320 * 16 + i] = cosf(ang); TAB[320 * 16 + 320 * 16 + i] = sinf(ang); }
    }
    if (b < NLAYER) {
        float* WRT = (float*)(ws + WS_WRT) + (size_t)b * 32 * 1024;
        const float* src = P.in[30] + (size_t)b * 1024 * 32;
        for (int i = tid; i < 32 * 1024; i += NTHR) { const int k = i >> 5, e = i & 31; WRT[e * 1024 + k] = src[i]; }
    }
}

DI void phase_rows_norm1(const Params& P, int lprev  , int nl  ) {
    unsigned char* ws = P.ws;
    const int G = GRID, tid = opaque_tid(), lane = tid & 63, wid = tid >> 6;
    bf16_t* XCUR = (bf16_t*)(ws + WS_XCUR);
    signed char* H = (signed char*)(ws + WS_H); float* HS = (float*)(ws + WS_HS);
    const float* MOD = (const float*)(ws + WS_MOD);
    const int* ctl = (const int*)(ws + WS_CTL);
    int offs_lane = 0;
    if (lprev >= 0) {
        const int c = (lane < 32) ? ctl[(lprev * 32 + lane) * ECS] : 0;
        const int nb = (c + 255) >> 8;
        int incl = nb;
#pragma unroll
        for (int d = 1; d < 32; d <<= 1) { const int t = __shfl_up(incl, d); if ((lane & 31) >= d) incl += t; }
        offs_lane = (incl - nb) * 256;
    }
    f32x4 Lg1[4], Lsc[4], Lsh[4], Lgt2[4];
#pragma unroll
    for (int j = 0; j < 4; ++j) { const int e = 256 * j + 4 * lane;
        if (nl < NLAYER) { Lg1[j] = *(const f32x4*)(P.in[6] + (size_t)nl * 1024 + e); Lsh[j] = *(const f32x4*)(MOD + ((size_t)nl * 2) * 6144 + e); Lsc[j] = *(const f32x4*)(MOD + ((size_t)nl * 2) * 6144 + 1024 + e); }
        else { Lg1[j] = Lsh[j] = Lsc[j] = (f32x4){0.f, 0.f, 0.f, 0.f}; }
        if (lprev >= 0) Lgt2[j] = *(const f32x4*)(MOD + ((size_t)lprev * 2) * 6144 + 5 * 1024 + e); else Lgt2[j] = (f32x4){0.f, 0.f, 0.f, 0.f}; }
    for (int tb = blockIdx.x * 8 + wid; tb < T; tb += G * 16) {
        int tt[2]; bool ok[2]; int isc[2];
        f32x4 x[2][4];
        int te[2][4], tp[2][4]; float tg[2][4];
#pragma unroll
        for (int q = 0; q < 2; ++q) {
            tt[q] = tb + q * G * 8; ok[q] = tt[q] < T; const int t = ok[q] ? tt[q] : tb; isc[q] = t >= SEQ;
            if (lprev < 0) {
                const float* src = isc[q] ? (P.in[2] + (size_t)(t - SEQ) * 1024) : (P.in[0] + (size_t)t * 1024);
#pragma unroll
                for (int j = 0; j < 4; ++j) x[q][j] = *(const f32x4*)(src + 256 * j + 4 * lane);
            } else {
#pragma unroll
                for (int j = 0; j < 4; ++j) { const u32x2 w = *(const u32x2*)(XCUR + (size_t)t * 1024 + 256 * j + 4 * lane); x[q][j] = (f32x4){bflo(w.x), bfhi(w.x), bflo(w.y), bfhi(w.y)}; }
            }
            if (lprev >= 0) {
                const int* tope = (const int*)(ws + WS_TOPE) + (size_t)t * 4; const int* topp = (const int*)(ws + WS_TOPP) + (size_t)t * 4; const float* topg = (const float*)(ws + WS_TOPG) + (size_t)t * 4;
#pragma unroll
                for (int k = 0; k < 4; ++k) { te[q][k] = tope[k]; tp[q][k] = topp[k]; tg[q][k] = topg[k]; }
            }
        }
        if (lprev >= 0) {
            const bf16_t* Y = (const bf16_t*)(ws + WS_YMOE);
            u32x2 yw[2][4][4];
#pragma unroll
            for (int q = 0; q < 2; ++q)
#pragma unroll
                for (int k = 0; k < 4; ++k) { const int row = __shfl(offs_lane, te[q][k]) + tp[q][k]; const bf16_t* yr = Y + (size_t)row * 1024;
#pragma unroll
                    for (int j = 0; j < 4; ++j) yw[q][k][j] = *(const u32x2*)(yr + 256 * j + 4 * lane); }
#pragma unroll
            for (int q = 0; q < 2; ++q) {
                const float* gt2 = MOD + ((size_t)lprev * 2 + isc[q]) * 6144 + 5 * 1024;
#pragma unroll
                for (int j = 0; j < 4; ++j) { f32x4 y = {0.f, 0.f, 0.f, 0.f};
#pragma unroll
                    for (int k = 0; k < 4; ++k) { const u32x2 w = yw[q][k][j]; const float g = tg[q][k]; y.x += g * bflo(w.x); y.y += g * bfhi(w.x); y.z += g * bflo(w.y); y.w += g * bfhi(w.y); }
                    const f32x4 gg = isc[q] ? *(const f32x4*)(gt2 + 256 * j + 4 * lane) : Lgt2[j]; x[q][j] = x[q][j] + gg * y; }
            }
        }
#pragma unroll
        for (int q = 0; q < 2; ++q) {
            if (!ok[q]) continue;
            const int t = tt[q];
            if (nl < NLAYER) {
#pragma unroll
                for (int j = 0; j < 4; ++j) { u32x2 w; w.x = pk2(x[q][j].x, x[q][j].y); w.y = pk2(x[q][j].z, x[q][j].w); *(u32x2*)(XCUR + (size_t)t * 1024 + 256 * j + 4 * lane) = w; }
                float ss = 0.f;
#pragma unroll
                for (int j = 0; j < 4; ++j) ss += x[q][j].x * x[q][j].x + x[q][j].y * x[q][j].y + x[q][j].z * x[q][j].z + x[q][j].w * x[q][j].w;
                ss = wave_sum(ss);
                const float rstd = rsqrtf(ss * (1.0f / 1024.0f) + EPS);
                const float* sh = MOD + ((size_t)nl * 2 + isc[q]) * 6144;
                const float* sc = sh + 1024;
                f32x4 hv[4]; float am = 0.f;
#pragma unroll
                for (int j = 0; j < 4; ++j) {
                    const int e = 256 * j + 4 * lane;
                    const f32x4 gg = Lg1[j], s1 = isc[q] ? *(const f32x4*)(sc + e) : Lsc[j], b1 = isc[q] ? *(const f32x4*)(sh + e) : Lsh[j];
                    hv[j] = (x[q][j] * rstd) * gg * (s1 + 1.0f) + b1;
                    am = fmaxf(am, fmaxf(fmaxf(fabsf(hv[j].x), fabsf(hv[j].y)), fmaxf(fabsf(hv[j].z), fabsf(hv[j].w))));
                }
                am = wave_max(am);
                const float qs = (am > 0.f) ? am * (1.0f / 127.0f) : 1.0f, qi = 1.0f / qs;
#pragma unroll
                for (int j = 0; j < 4; ++j) *(unsigned*)(H + (size_t)t * 1024 + 256 * j + 4 * lane) = pack_i8x4(hv[j].x * qi, hv[j].y * qi, hv[j].z * qi, hv[j].w * qi);
                if (lane == 0) HS[t] = qs;
            } else if (!isc[q]) {
#pragma unroll
                for (int j = 0; j < 4; ++j) *(f32x4*)(P.out + (size_t)t * 1024 + 256 * j + 4 * lane) = x[q][j];
            }
        }
    }
    if (lprev >= 0 && nl < NLAYER && blockIdx.x >= 32) wdn_units(P, nl, XP_WDN_ROWS0, XP_WDN, (int)blockIdx.x - 32, GRID - 32);
}

DI void phase_router(const Params& P, int l, char* lds) {
    unsigned char* ws = P.ws;
    const bf16_t* XCUR = (const bf16_t*)(ws + WS_XCUR);
    const float* MOD = (const float*)(ws + WS_MOD);
    const float* WRT = (const float*)(ws + WS_WRT) + (size_t)l * 32 * 1024;
    int* ecnt = (int*)(ws + WS_CTL) + l * 32 * ECS;
    float* fl = (float*)lds;
    float* part = fl;
    float* part2 = (float*)(lds + 135424);
    float* lgx = part2 + 512;
    int* dst = (int*)(lds + 135424 + 2048 + 1056);
    int* lcnt = dst + 33 * 4;
    int* lbase = lcnt + 32;
    const float* g2 = P.in[7] + (size_t)l * 1024;
    f32x4 Rg2[4], Rsc[4], Rsh[4];
    { const int lane_ = opaque_tid() & 63;
#pragma unroll
      for (int j = 0; j < 4; ++j) { const int e = 256 * j + 4 * lane_; Rg2[j] = *(const f32x4*)(g2 + e);
          Rsh[j] = *(const f32x4*)(MOD + ((size_t)l * 2) * 6144 + 3 * 1024 + e); Rsc[j] = *(const f32x4*)(MOD + ((size_t)l * 2) * 6144 + 4 * 1024 + e) + 1.0f; } }
    for (int i = opaque_tid(); i < 8 * 33; i += NTHR) lgx[i] = 0.f;
#pragma unroll 1
    for (int pass = 0; pass < 2; ++pass) {
        const int tbase = (int)blockIdx.x * 65;
        const int t0 = tbase + 32 * pass;
        const bool extra = pass == 0;
        const int tx = tbase + 64;
        const int tid = opaque_tid(), lane = tid & 63, wid = tid >> 6, r = lane & 31, h = lane >> 5; (void)tid;
        unsigned pq[5][4]; float rsc[5];
        {
            f32x4 x[5][4]; float ss[5];
#pragma unroll
            for (int q = 0; q < 5; ++q) { const int t = (q < 4) ? (t0 + wid * 4 + q) : tx;
#pragma unroll
                for (int j = 0; j < 4; ++j) { const u32x2 w = *(const u32x2*)(XCUR + (size_t)t * 1024 + 256 * j + 4 * lane); x[q][j] = (f32x4){bflo(w.x), bfhi(w.x), bflo(w.y), bfhi(w.y)}; } }
#pragma unroll
            for (int q = 0; q < 5; ++q) { float s = 0.f;
#pragma unroll
                for (int j = 0; j < 4; ++j) s += x[q][j].x * x[q][j].x + x[q][j].y * x[q][j].y + x[q][j].z * x[q][j].z + x[q][j].w * x[q][j].w;
                ss[q] = wave_sum(s); }
#pragma unroll
            for (int q = 0; q < 5; ++q) {
                if (q == 4 && !(extra && wid == 0)) continue;
                const int t = (q < 4) ? (t0 + wid * 4 + q) : tx, tr = (q < 4) ? (wid * 4 + q) : 32;
                const int isctx = t >= SEQ;
                const float* sh = MOD + ((size_t)l * 2 + isctx) * 6144 + 3 * 1024;
                const float* sc = sh + 1024;
                const float rstd = rsqrtf(ss[q] * (1.0f / 1024.0f) + EPS);
                f32x4 hv[4]; float am = 0.f;
#pragma unroll
                for (int j = 0; j < 4; ++j) {
                    const int e = 256 * j + 4 * lane;
                    const f32x4 gg = Rg2[j], s1 = isctx ? (*(const f32x4*)(sc + e) + 1.0f) : Rsc[j], b1 = isctx ? *(const f32x4*)(sh + e) : Rsh[j];
                    hv[j] = (x[q][j] * rstd) * gg * s1 + b1;
                    am = fmaxf(am, fmaxf(fmaxf(fabsf(hv[j].x), fabsf(hv[j].y)), fmaxf(fabsf(hv[j].z), fabsf(hv[j].w))));
                    float* d = fl + tr * 1025 + e; d[0] = hv[j].x; d[1] = hv[j].y; d[2] = hv[j].z; d[3] = hv[j].w;
                }
                am = wave_max(am);
                const float qs = (am > 0.f) ? am * (1.0f / 127.0f) : 1.0f, qi = 1.0f / qs;
                rsc[q] = qs;
#pragma unroll
                for (int j = 0; j < 4; ++j) pq[q][j] = pack_i8x4(hv[j].x * qi, hv[j].y * qi, hv[j].z * qi, hv[j].w * qi);
            }
        }
        if (tid < 32) lcnt[tid] = 0;
        __syncthreads();
        {
            f32x16 acc;
#pragma unroll
            for (int i = 0; i < 16; ++i) acc[i] = 0.f;
            const int kb = 128 * wid + 64 * h;
            const float* wrow = WRT + (size_t)r * 1024 + kb;
            const float* frow = fl + r * 1025 + kb;
            f32x4 wv[16];
#pragma unroll
            for (int c = 0; c < 16; ++c) wv[c] = *(const f32x4*)(wrow + 4 * c);
#pragma unroll
            for (int c = 0; c < 16; ++c) {
                acc = __builtin_amdgcn_mfma_f32_32x32x2f32(frow[4 * c + 0], wv[c].x, acc, 0, 0, 0);
                acc = __builtin_amdgcn_mfma_f32_32x32x2f32(frow[4 * c + 1], wv[c].y, acc, 0, 0, 0);
                acc = __builtin_amdgcn_mfma_f32_32x32x2f32(frow[4 * c + 2], wv[c].z, acc, 0, 0, 0);
                acc = __builtin_amdgcn_mfma_f32_32x32x2f32(frow[4 * c + 3], wv[c].w, acc, 0, 0, 0);
            }
            if (extra) {
                const float* fx = fl + 32 * 1025 + kb; float a = 0.f;
#pragma unroll
                for (int c = 0; c < 16; ++c) a += fx[4 * c] * wv[c].x + fx[4 * c + 1] * wv[c].y + fx[4 * c + 2] * wv[c].z + fx[4 * c + 3] * wv[c].w;
                part2[(2 * wid + h) * 32 + r] = a;
            }
            __syncthreads();
#pragma unroll
            for (int i = 0; i < 16; ++i) { const int tok = (i & 3) + 8 * (i >> 2) + 4 * h; part[(wid * 32 + tok) * 33 + r] = acc[i]; }
            if (extra && wid == 1 && lane < 32) { float a = 0.f;
#pragma unroll
                for (int w = 0; w < 16; ++w) a += part2[w * 32 + lane];
                lgx[lane] = a; }
        }
        __syncthreads();
        if (wid == 0) {
            int te[4] = {0, 0, 0, 0}; float tg[4] = {0.f, 0.f, 0.f, 0.f}; int lr[4] = {0, 0, 0, 0};
            const bool act = lane < 32 || (extra && lane == 32);
            const int t = (lane < 32) ? (t0 + lane) : tx;
            if (act) {
                float lg[32];
                const float* lsrc = (lane < 32) ? (part + lane * 33) : lgx; const int lstr = (lane < 32) ? 32 * 33 : 33;
#pragma unroll
                for (int e = 0; e < 32; ++e) { float s = P.in[31][l * 32 + e];
#pragma unroll
                    for (int w = 0; w < 8; ++w) s += lsrc[w * lstr + e];
                    lg[e] = s; }
                float tv[4];
#pragma unroll
                for (int k = 0; k < 4; ++k) {
                    float best = -3.0e38f; int bi = 0;
#pragma unroll
                    for (int e = 0; e < 32; ++e) { const bool better = lg[e] > best; best = better ? lg[e] : best; bi = better ? e : bi; }
                    te[k] = bi; tv[k] = best;
#pragma unroll
                    for (int e = 0; e < 32; ++e) lg[e] = (e == bi) ? -3.0e38f : lg[e];
                }
                float se = 0.f;
#pragma unroll
                for (int k = 0; k < 4; ++k) { tg[k] = __expf(tv[k] - tv[0]); se += tg[k]; }
                const float inv = 1.0f / se;
#pragma unroll
                for (int k = 0; k < 4; ++k) { tg[k] *= inv; lr[k] = atomicAdd(lcnt + te[k], 1); }
            }
            if (lane < 32) { const int c = lcnt[lane]; lbase[lane] = c ? atomicAdd(ecnt + lane * ECS, c) : 0; }
            if (act) {
                int* tope = (int*)(ws + WS_TOPE) + (size_t)t * 4;
                int* topp = (int*)(ws + WS_TOPP) + (size_t)t * 4;
                float* topg = (float*)(ws + WS_TOPG) + (size_t)t * 4;
#pragma unroll
                for (int k = 0; k < 4; ++k) {
                    const int pos = lbase[te[k]] + lr[k];
                    tope[k] = te[k]; topp[k] = pos; topg[k] = tg[k];
                    dst[lane * 4 + k] = te[k] * T + pos;
                }
            }
        }
        __syncthreads();
        {
            signed char* XG = (signed char*)(ws + WS_XG); float* XGS = (float*)(ws + WS_XGS);
#pragma unroll
            for (int q = 0; q < 5; ++q) { if (q == 4 && !(extra && wid == 0)) continue;
                const int tr = (q < 4) ? (wid * 4 + q) : 32;
#pragma unroll
                for (int k = 0; k < 4; ++k) { const int drow = dst[tr * 4 + k]; signed char* d = XG + (size_t)drow * 1024 + 4 * lane;
#pragma unroll
                    for (int j = 0; j < 4; ++j) *(unsigned*)(d + 256 * j) = pq[q][j];
                    if (lane == 0) XGS[drow] = rsc[q]; } }
        }
        __syncthreads();
    }
}


struct EpiIn {
    bf16_t* U; float* DTR; const float* bg; const float* hs; const float* wins;
    DI void operator()(const g8::AccI& acc, const g8::Unit& u, int wr, int wc, int fr, int fq) const {
        const bool gate = u.t1 >= (U_G / 256);
        float sa_[2][4];
#pragma unroll
        for (int ai = 0; ai < 2; ++ai)
#pragma unroll
            for (int m = 0; m < 4; ++m) sa_[ai][m] = hs[u.t0 * 256 + 128 * ai + 64 * wr + 16 * m + fr];
        __builtin_amdgcn_sched_barrier(0);
#pragma unroll
        for (int bj = 0; bj < 2; ++bj) {
            const int col = u.t1 * 256 + 128 * bj + 32 * wc + 8 * fq;
            const f32x4 w0 = *(const f32x4*)(wins + col), w1 = *(const f32x4*)(wins + col + 4);
            f32x4 b0 = {0.f, 0.f, 0.f, 0.f}, b1 = {0.f, 0.f, 0.f, 0.f};
            if (gate) { b0 = *(const f32x4*)(bg + col - U_G); b1 = *(const f32x4*)(bg + col - U_G + 4); }
#pragma unroll
            for (int ai = 0; ai < 2; ++ai)
#pragma unroll
                for (int m = 0; m < 4; ++m) {
                    const int row = u.t0 * 256 + 128 * ai + 64 * wr + 16 * m + fr;
                    const float sa = sa_[ai][m];
                    const i32x4 a0 = acc[ai][bj][m][0], a1 = acc[ai][bj][m][1];
                    f32x4 v0 = {(float)a0.x * (sa * w0.x), (float)a0.y * (sa * w0.y), (float)a0.z * (sa * w0.z), (float)a0.w * (sa * w0.w)};
                    f32x4 v1 = {(float)a1.x * (sa * w1.x), (float)a1.y * (sa * w1.y), (float)a1.z * (sa * w1.z), (float)a1.w * (sa * w1.w)};
                    if (gate) {
                        v0.x = sigmoidf_(v0.x + b0.x); v0.y = sigmoidf_(v0.y + b0.y); v0.z = sigmoidf_(v0.z + b0.z); v0.w = sigmoidf_(v0.w + b0.w);
                        v1.x = sigmoidf_(v1.x + b1.x); v1.y = sigmoidf_(v1.y + b1.y); v1.z = sigmoidf_(v1.z + b1.z); v1.w = sigmoidf_(v1.w + b1.w);
                    } else if (col >= U_DT && col < U_DT + 16) {
                        *(f32x4*)(DTR + (size_t)row * 16 + (col - U_DT)) = v0; *(f32x4*)(DTR + (size_t)row * 16 + (col - U_DT) + 4) = v1;
                    }
                    u32x4 w; w.x = pk2(v0.x, v0.y); w.y = pk2(v0.z, v0.w); w.z = pk2(v1.x, v1.y); w.w = pk2(v1.z, v1.w);
                    *(u32x4*)(U + (size_t)row * NIN + col) = w;
                }
        }
    }
};
DI void phase_gemm_in(const Params& P, int l, char* lds) {
    unsigned char* ws = P.ws;
    g8::GridSched<NQB, NIN / 256> S; S.init(ws + WS_H, 512, ws + WS_WIN + l * SZ_WIN, 512);
    EpiIn E{(bf16_t*)(ws + WS_U), (float*)(ws + WS_DTR), P.in[9] + (size_t)l * 3072, (const float*)(ws + WS_HS), (const float*)(ws + WS_WINS) + (size_t)l * NIN};
    g8::gemm_phase<true, true>((LAS unsigned char*)lds, 512, 512, S, E);
}

struct EpiBf16Plain {
    bf16_t* C; int ldc;
    DI void operator()(const g8::Acc& acc, const g8::Unit& u, int wr, int wc, int fr, int fq) const {
#pragma unroll
        for (int ai = 0; ai < 2; ++ai)
#pragma unroll
            for (int m = 0; m < 4; ++m) {
                const int row = u.t0 * 256 + 128 * ai + 64 * wr + 16 * m + fr;
#pragma unroll
                for (int bj = 0; bj < 2; ++bj) {
                    const int col = u.t1 * 256 + 128 * bj + 32 * wc + 8 * fq;
                    const f32x4 v0 = acc[ai][bj][m][0], v1 = acc[ai][bj][m][1];
                    u32x4 w; w.x = pk2(v0.x, v0.y); w.y = pk2(v0.z, v0.w); w.z = pk2(v1.x, v1.y); w.w = pk2(v1.z, v1.w);
                    *(u32x4*)(C + (size_t)row * ldc + col) = w;
                }
            }
    }
};

template <int NI>
DI void gemm_store_bf16(const GemmAcc<NI>& acc, bf16_t* C, size_t ldc, int row0, int col0) {
    const int tid = opaque_tid(), lane = tid & 63, wid = tid >> 6, wr = wid >> 2, wc = wid & 3, r = lane & 31, h = lane >> 5;
#pragma unroll
    for (int mi = 0; mi < 4; ++mi)
#pragma unroll
        for (int ni = 0; ni < NI; ++ni) {
            float v[16];
#pragma unroll
            for (int i = 0; i < 16; ++i) v[i] = acc.a[mi][ni][i];
            st_bf16x16(C + (size_t)(row0 + wr * 128 + mi * 32 + r) * ldc + col0 + wc * 32 * NI + ni * 32 + 16 * h, v);
        }
}

DI void phase_gemm_merge(const Params& P, int l, char* lds) {
    unsigned char* ws = P.ws;
    const int G = GRID;
    const bf16_t* U = (const bf16_t*)(ws + WS_U);
    const bf16_t* WUP = (const bf16_t*)(ws + WS_WUP + l * SZ_WUP);
    bf16_t* MRG = (bf16_t*)(ws + WS_MRG);
    const int nu = (NQB - 1) * 8;
    const int bx_ = opaque_bid() & 7, by_ = opaque_bid() >> 3;
    for (int k_ = 0; ; ++k_) {
        const int rt = k_ * 32 + bx_ * 4 + (by_ >> 3), ct = by_ & 7;
        if (rt * 8 >= nu) break;
        const int tid = opaque_tid(), lane = tid & 63, wid = tid >> 6, wr = wid >> 2, wc = wid & 3, r = lane & 31, h = lane >> 5; (void)tid; (void)wr; (void)wc; (void)r; (void)h;
        float tot[4][16];
#pragma unroll
        for (int mi = 0; mi < 4; ++mi)
#pragma unroll
            for (int i = 0; i < 16; ++i) tot[mi][i] = 0.f;
#pragma unroll 1
        for (int br = 0; br < 3; ++br) {
            const bf16_t* Y = (const bf16_t*)(ws + (br == 0 ? WS_YA : (br == 1 ? WS_YB : WS_YC)));
            GemmAcc<1> acc;
            gemm_tile<1>(lds, ARowPlain{Y + (size_t)rt * 256 * 512, 512}, WUP + (size_t)br * 1024 * 512 + (size_t)ct * 128 * 512, 512, 512, acc);
            u32x4 gg0[4], gg1[4];
#pragma unroll
            for (int mi = 0; mi < 4; ++mi) { const bf16_t* gp = U + (size_t)(rt * 256 + wr * 128 + mi * 32 + r) * NIN + U_G + br * 1024 + ct * 128 + wc * 32 + 16 * h;
                gg0[mi] = *(const u32x4*)gp; gg1[mi] = *(const u32x4*)(gp + 8); }
            __builtin_amdgcn_sched_barrier(0);
#pragma unroll
            for (int mi = 0; mi < 4; ++mi) {
                const u32x4 g0 = gg0[mi], g1 = gg1[mi];
                const unsigned gw[8] = {g0.x, g0.y, g0.z, g0.w, g1.x, g1.y, g1.z, g1.w};
#pragma unroll
                for (int q = 0; q < 8; ++q) { tot[mi][2 * q] += bflo(gw[q]) * acc.a[mi][0][2 * q]; tot[mi][2 * q + 1] += bfhi(gw[q]) * acc.a[mi][0][2 * q + 1]; }
            }
        }
#pragma unroll
        for (int mi = 0; mi < 4; ++mi)
            st_bf16x16(MRG + (size_t)(rt * 256 + wr * 128 + mi * 32 + r) * 1024 + ct * 128 + wc * 32 + 16 * h, tot[mi]);
    }
    if (l + 1 < NLAYER) {
        const int c_ = opaque_bid();
        if ((c_ & 7) == 0) {
            const int su = c_ >> 3, ct = su & 7, qr = su >> 3;
            const int tid = opaque_tid(), lane = tid & 63, wid = tid >> 6, wr = wid >> 2, wc = wid & 3, r = lane & 31, h = lane >> 5; (void)tid;
            const int row = (NQB - 1) * 256 + qr * 64 + wr * 32 + r;
            float tot[16];
#pragma unroll
            for (int i = 0; i < 16; ++i) tot[i] = 0.f;
#pragma unroll 1
            for (int br = 0; br < 3; ++br) {
                const bf16_t* Y = (const bf16_t*)(ws + (br == 0 ? WS_YA : (br == 1 ? WS_YB : WS_YC)));
                GemmAcc<1> acc;
                gemm_tile<1, ARowPlain, 1>(lds, ARowPlain{Y + (size_t)((NQB - 1) * 256 + qr * 64) * 512, 512}, WUP + (size_t)br * 1024 * 512 + (size_t)ct * 128 * 512, 512, 512, acc);
                const bf16_t* gp = U + (size_t)row * NIN + U_G + br * 1024 + ct * 128 + wc * 32 + 16 * h;
                const u32x4 g0 = *(const u32x4*)gp, g1 = *(const u32x4*)(gp + 8);
                const unsigned gw[8] = {g0.x, g0.y, g0.z, g0.w, g1.x, g1.y, g1.z, g1.w};
#pragma unroll
                for (int q = 0; q < 8; ++q) { tot[2 * q] += bflo(gw[q]) * acc.a[0][0][2 * q]; tot[2 * q + 1] += bfhi(gw[q]) * acc.a[0][0][2 * q + 1]; }
            }
            st_bf16x16(MRG + (size_t)row * 1024 + ct * 128 + wc * 32 + 16 * h, tot);
        } else {
            wdn_units(P, l + 1, 0, XP_WDN_MERGE, c_ - (c_ >> 3) - 1, GRID - 32);
        }
    }
}

struct EpiOut {
    bf16_t* XCUR; const float* MOD; int l;
    DI void operator()(const g8::Acc& acc, const g8::Unit& u, int wr, int wc, int fr, int fq) const {
        const float* gt1 = MOD + ((size_t)l * 2 + (u.t0 == NQB - 1 ? 1 : 0)) * 6144 + 2 * 1024;
        f32x4 g[2][2];
#pragma unroll
        for (int bj = 0; bj < 2; ++bj)
#pragma unroll
            for (int n = 0; n < 2; ++n) g[bj][n] = *(const f32x4*)(gt1 + u.t1 * 256 + 128 * bj + 32 * wc + 16 * n + 4 * fq);
#pragma unroll
        for (int ai = 0; ai < 2; ++ai)
#pragma unroll
            for (int mp = 0; mp < 4; mp += 2) {
                u32x2 w[2][2][2];
#pragma unroll
                for (int mm = 0; mm < 2; ++mm) { const int row = u.t0 * 256 + 128 * ai + 64 * wr + 16 * (mp + mm) + fr;
#pragma unroll
                    for (int bj = 0; bj < 2; ++bj)
#pragma unroll
                        for (int n = 0; n < 2; ++n) w[mm][bj][n] = *(const u32x2*)(XCUR + (size_t)row * 1024 + u.t1 * 256 + 128 * bj + 32 * wc + 16 * n + 4 * fq); }
                __builtin_amdgcn_sched_barrier(0);
#pragma unroll
                for (int mm = 0; mm < 2; ++mm) { const int row = u.t0 * 256 + 128 * ai + 64 * wr + 16 * (mp + mm) + fr;
#pragma unroll
                    for (int bj = 0; bj < 2; ++bj)
#pragma unroll
                        for (int n = 0; n < 2; ++n) {
                            const u32x2 ww = w[mm][bj][n];
                            const f32x4 v = (f32x4){bflo(ww.x), bfhi(ww.x), bflo(ww.y), bfhi(ww.y)} + g[bj][n] * acc[ai][bj][mp + mm][n];
                            u32x2 o2; o2.x = pk2(v.x, v.y); o2.y = pk2(v.z, v.w);
                            *(u32x2*)(XCUR + (size_t)row * 1024 + u.t1 * 256 + 128 * bj + 32 * wc + 16 * n + 4 * fq) = o2;
                        } }
                __builtin_amdgcn_sched_barrier(0);
            }
    }
};
DI void phase_gemm_out(const Params& P, int l, char* lds) {
    unsigned char* ws = P.ws;
    EpiOut E{(bf16_t*)(ws + WS_XCUR), (const float*)(ws + WS_MOD), l};
    {
        g8::GridSched<NQB - 1, 4> S; S.init(ws + WS_MRG, 1024, ws + WS_WOUT + l * SZ_WOUT, 1024);
        g8::gemm_phase<false>((LAS unsigned char*)lds, 1024, 1024, S, E);
    }
    if (l + 1 < NLAYER) {
        const int c_ = opaque_bid();
        __syncthreads();
        if ((c_ & 7) == 0) {
            const int su = c_ >> 3, ct = su & 7, qr = su >> 3;
            const int tid = opaque_tid(), lane = tid & 63, wid = tid >> 6, wr = wid >> 2, wc = wid & 3, r = lane & 31, h = lane >> 5; (void)tid;
            const int row = (NQB - 1) * 256 + qr * 64 + wr * 32 + r, col = ct * 128 + wc * 32 + 16 * h;
            GemmAcc<1> acc;
            gemm_tile<1, ARowPlain, 1>(lds, ARowPlain{(const bf16_t*)(ws + WS_MRG) + (size_t)((NQB - 1) * 256 + qr * 64) * 1024, 1024}, (const bf16_t*)(ws + WS_WOUT + l * SZ_WOUT) + (size_t)ct * 128 * 1024, 1024, 1024, acc);
            const float* gt1 = (const float*)(ws + WS_MOD) + ((size_t)l * 2 + 1) * 6144 + 2 * 1024 + col;
            bf16_t* xp = (bf16_t*)(ws + WS_XCUR) + (size_t)row * 1024 + col;
            const u32x4 x0 = *(const u32x4*)xp, x1 = *(const u32x4*)(xp + 8);
            const unsigned xw[8] = {x0.x, x0.y, x0.z, x0.w, x1.x, x1.y, x1.z, x1.w};
            float v[16];
#pragma unroll
            for (int q = 0; q < 8; ++q) { v[2 * q] = bflo(xw[q]) + gt1[2 * q] * acc.a[0][0][2 * q]; v[2 * q + 1] = bfhi(xw[q]) + gt1[2 * q + 1] * acc.a[0][0][2 * q + 1]; }
            st_bf16x16(xp, v);
        } else {
            const int rk = c_ - (c_ >> 3) - 1;
            for (int u = rk; u < XP_WDN_OUTN; u += GRID - 32) { const int rr = (u < XP_WDN_DOWN0 - XP_WDN_MERGE) ? (XP_WDN_MERGE + u) : (XP_WDN_DOWN1 + (u - (XP_WDN_DOWN0 - XP_WDN_MERGE)));
                wdn_units(P, l + 1, rr, rr + 1, 0, 1); }
        }
    }
}

constexpr int MOE_TAB_OFF = 131072 + 1024;
DI int moe_build_table(const int* ecnt, char* lds) {
    int* tab = (int*)(lds + MOE_TAB_OFF);
    const int tid = opaque_tid();
    if (tid < 64) {
        const int e = tid & 31;
        const int nb = (tid < 32) ? ((ecnt[e * ECS] + 255) >> 8) : 0;
        int incl = nb;
#pragma unroll
        for (int d = 1; d < 32; d <<= 1) { const int t = __shfl_up(incl, d); if ((tid & 31) >= d) incl += t; }
        if (tid < 32) { const int base = incl - nb; for (int j = 0; j < nb; ++j) tab[1 + base + j] = (e << 16) | j; if (tid == 31) tab[0] = incl; }
    }
    __syncthreads();
    return tab[0];
}
template <int NCT, bool SPARSE, size_t A_EXPERT_STEP, size_t A_BLK_STEP, size_t W_EXPERT_STEP, size_t W_CT_STEP>
struct MoeSched {
    const char* A; const char* W; const int* tab; int nunits; int c;
    DI bool next(int i, g8::Unit& u) const {
        constexpr int RPX = 32 / NCT;
        const int x = c & 7, y = c >> 3;
        const int rb = i * (GRID / NCT) + x * RPX + y / NCT, ct = y % NCT;
        if (rb * NCT >= nunits) return false;
        const int ej = tab[1 + rb], e = ej >> 16, j = ej & 0xffff;
        u.a = SPARSE ? (A + (size_t)e * A_EXPERT_STEP + (size_t)j * A_BLK_STEP) : (A + (size_t)rb * A_BLK_STEP);
        u.b = W + (size_t)e * W_EXPERT_STEP + (size_t)ct * W_CT_STEP; u.t0 = rb; u.t1 = ct | (e << 8); return true;
    }
};
struct EpiGu {
    bf16_t* ACT; const float* bgu_l; const float* xgs; const float* wgs_l; const int* tab;
    DI void operator()(const g8::AccI& acc, const g8::Unit& u, int wr, int wc, int fr, int fq) const {
        const int ct = u.t1 & 255, e = u.t1 >> 8;
        const int j0 = ct * 128 + 32 * wc + 8 * fq;
        const float* bg = bgu_l + (size_t)e * 2048 + j0;
        const f32x4 bg0 = *(const f32x4*)bg, bg1 = *(const f32x4*)(bg + 4), bl0 = *(const f32x4*)(bg + 1024), bl1 = *(const f32x4*)(bg + 1028);
        const float* ws_ = wgs_l + (size_t)e * 2048 + ct * 256 + 32 * wc + 8 * fq;
        const f32x4 sg0 = *(const f32x4*)ws_, sg1 = *(const f32x4*)(ws_ + 4), sl0 = *(const f32x4*)(ws_ + 128), sl1 = *(const f32x4*)(ws_ + 132);
        const int ej = tab[1 + u.t0];
        const float* xs = xgs + (size_t)(ej >> 16) * T + (ej & 0xffff) * 256;
        float sa_[2][4];
#pragma unroll
        for (int ai = 0; ai < 2; ++ai)
#pragma unroll
            for (int m = 0; m < 4; ++m) sa_[ai][m] = xs[128 * ai + 64 * wr + 16 * m + fr];
        __builtin_amdgcn_sched_barrier(0);
#pragma unroll
        for (int ai = 0; ai < 2; ++ai)
#pragma unroll
            for (int m = 0; m < 4; ++m) {
                const int rl = 128 * ai + 64 * wr + 16 * m + fr, row = u.t0 * 256 + rl;
                const float sa = sa_[ai][m];
                float v[8];
#pragma unroll
                for (int q = 0; q < 8; ++q) {
                    float glu = (float)acc[ai][0][m][q >> 2][q & 3] * (sa * ((q < 4) ? sg0[q & 3] : sg1[q & 3])) + ((q < 4) ? bg0[q & 3] : bg1[q & 3]);
                    float lin = (float)acc[ai][1][m][q >> 2][q & 3] * (sa * ((q < 4) ? sl0[q & 3] : sl1[q & 3])) + ((q < 4) ? bl0[q & 3] : bl1[q & 3]);
                    glu = fminf(glu, 7.0f); lin = fminf(fmaxf(lin, -7.0f), 7.0f);
                    v[q] = glu * sigmoidf_(1.702f * glu) * (lin + 1.0f);
                }
                u32x4 w; w.x = pk2(v[0], v[1]); w.y = pk2(v[2], v[3]); w.z = pk2(v[4], v[5]); w.w = pk2(v[6], v[7]);
                *(u32x4*)(ACT + (size_t)row * 1024 + j0) = w;
            }
    }
};
DI void phase_moe_gu(const Params& P, int l, char* lds) {
    unsigned char* ws = P.ws;
    const int* ecnt = (const int*)(ws + WS_CTL) + l * 32 * ECS;
    const int nblk = moe_build_table(ecnt, lds);
    MoeSched<8, true, (size_t)T * 1024, (size_t)256 * 1024, (size_t)2048 * 1024, (size_t)256 * 1024> S{(const char*)(ws + WS_XG), (const char*)(ws + WS_WGU + l * SZ_WGU), (const int*)(lds + MOE_TAB_OFF), nblk * 8, opaque_bid()};
    EpiGu E{(bf16_t*)(ws + WS_ACT), P.in[33] + (size_t)l * 32 * 2048, (const float*)(ws + WS_XGS), (const float*)(ws + WS_WGS) + (size_t)l * 32 * 2048, (const int*)(lds + MOE_TAB_OFF)};
    g8::gemm_phase<true, true>((LAS unsigned char*)lds, 512, 512, S, E);
}
struct EpiDown {
    bf16_t* Y; const float* bd_l;
    DI void operator()(const g8::Acc& acc, const g8::Unit& u, int wr, int wc, int fr, int fq) const {
        const int ct = u.t1 & 255, e = u.t1 >> 8;
#pragma unroll
        for (int bj = 0; bj < 2; ++bj) {
            const int col = ct * 256 + 128 * bj + 32 * wc + 8 * fq;
            const f32x4 b0 = *(const f32x4*)(bd_l + (size_t)e * 1024 + col), b1 = *(const f32x4*)(bd_l + (size_t)e * 1024 + col + 4);
#pragma unroll
            for (int ai = 0; ai < 2; ++ai)
#pragma unroll
                for (int m = 0; m < 4; ++m) {
                    const int row = u.t0 * 256 + 128 * ai + 64 * wr + 16 * m + fr;
                    const f32x4 v0 = acc[ai][bj][m][0] + b0, v1 = acc[ai][bj][m][1] + b1;
                    u32x4 w; w.x = pk2(v0.x, v0.y); w.y = pk2(v0.z, v0.w); w.z = pk2(v1.x, v1.y); w.w = pk2(v1.z, v1.w);
                    *(u32x4*)(Y + (size_t)row * 1024 + col) = w;
                }
        }
    }
};
DI void phase_moe_down(const Params& P, int l, char* lds) {
    unsigned char* ws = P.ws;
    const int* ecnt = (const int*)(ws + WS_CTL) + l * 32 * ECS;
    const int nblk = moe_build_table(ecnt, lds);
    MoeSched<4, false, 0, (size_t)256 * 2048, (size_t)1024 * 2048, (size_t)256 * 2048> S{(const char*)(ws + WS_ACT), (const char*)(ws + WS_WDN + l * SZ_WDN), (const int*)(lds + MOE_TAB_OFF), nblk * 4, opaque_bid()};
    EpiDown E{(bf16_t*)(ws + WS_YMOE), P.in[35] + (size_t)l * 32 * 1024};
    g8::gemm_phase<true>((LAS unsigned char*)lds, 1024, 1024, S, E);
    if (l + 1 < NLAYER) {
        const int m = nblk - ((nblk - 1) >> 6) * 64;
        const int c_ = opaque_bid(), key = ((c_ & 7) * 8 + ((c_ >> 3) >> 2)) * 4 + ((c_ >> 3) & 3);
        if (m == 64) wdn_units(P, l + 1, XP_WDN_DOWN0, XP_WDN_DOWN1, c_, GRID);
        else if (key >= 4 * m) wdn_units(P, l + 1, XP_WDN_DOWN0, XP_WDN_DOWN1, key - 4 * m, GRID - 4 * m);
    }
}

constexpr int P3_SSM = NCHUNK * 2;
constexpr int P3_MLAQ = NQB * 3, P3_MLAKV = NQB * 4;
constexpr int P3_DIF = NT64;

DI const float* rope_tab(const unsigned char* ws) { return (const float*)(ws + WS_TAB); }

DI void dif_prep_unit(const Params& P, int l, int tile, char* lds) {
    unsigned char* ws = P.ws;
    const int tid = opaque_tid(), lane = tid & 63, wid = tid >> 6;
    const bf16_t* U = (const bf16_t*)(ws + WS_U);
    bf16_t* QD = (bf16_t*)(ws + WS_QD); bf16_t* KD = (bf16_t*)(ws + WS_KD); bf16_t* VDT = (bf16_t*)(ws + WS_VDT);
    const float* TABD = rope_tab(ws) + 320 * 16;
    const float* gq = P.in[16] + l * 64; const float* gk = P.in[17] + l * 64;
    const int sub = lane & 3, grp = lane >> 2;
    const float qscale = 0.125f * LOG2E;
    bf16_t* vs = (bf16_t*)lds;
    u32x4 ld0[8], ld1[8], ldv[8];
#pragma unroll
    for (int q = 0; q < 8; ++q) {
        const int t = tile * 64 + wid * 8 + q;
        const bf16_t* src = U + (size_t)t * NIN + U_DQ + grp * 64 + sub * 16;
        ld0[q] = *(const u32x4*)src; ld1[q] = *(const u32x4*)(src + 8);
        ldv[q] = *(const u32x4*)(U + (size_t)t * NIN + U_DV + lane * 8);
    }
#pragma unroll
    for (int q = 0; q < 8; ++q) {
        const int tl_ = wid * 8 + q, t = tile * 64 + tl_;
        const bool lat = t < SEQ;
        const u32x4 w0 = ld0[q], w1 = ld1[q];
        float x[16] = {bflo(w0.x), bfhi(w0.x), bflo(w0.y), bfhi(w0.y), bflo(w0.z), bfhi(w0.z), bflo(w0.w), bfhi(w0.w),
                       bflo(w1.x), bfhi(w1.x), bflo(w1.y), bfhi(w1.y), bflo(w1.z), bfhi(w1.z), bflo(w1.w), bfhi(w1.w)};
        float ss = 0.f;
#pragma unroll
        for (int i = 0; i < 16; ++i) ss += x[i] * x[i];
        ss = quad_sum(ss);
        const float rstd = rsqrtf(ss * (1.0f / 64.0f) + EPS);
        const float* g = (grp < 8 ? gq : gk) + sub * 16;
#pragma unroll
        for (int i = 0; i < 16; ++i) x[i] = x[i] * rstd * g[i];
        if (lat) {
            const int pos = (sub < 2) ? (t >> 6) : (256 + (t & 63));
            const float* cs = TABD + pos * 16; const float* sn = TABD + 320 * 16 + pos * 16;
#pragma unroll
            for (int i = 0; i < 16; ++i) {
                const float other = lane_xor1(x[i]);
                const float c = cs[i], s = sn[i];
                x[i] = (sub & 1) ? (x[i] * c + other * s) : (x[i] * c - other * s);
            }
        }
        if (grp < 8) {
#pragma unroll
            for (int i = 0; i < 16; ++i) x[i] *= qscale;
            st_bf16x16(QD + ((size_t)grp * T + t) * 64 + sub * 16, x);
        } else {
            st_fp8x16((unsigned char*)KD + ((size_t)(grp - 8) * T + t) * 64 + sub * 16, x);
        }
        *(u32x4*)(vs + tl_ * 520 + lane * 8) = ldv[q];
    }
    __syncthreads();
#pragma unroll 1
    for (int it = 0; it < 4; ++it) {
        const int cid = tid + it * NTHR;
        const int rowc = cid >> 2, pc = cid & 3;
        float e[16];
#pragma unroll
        for (int j = 0; j < 16; ++j) { const int key = kperm8(pc * 16 + j); e[j] = bf2f(vs[key * 520 + rowc]); }
        const int head = rowc >> 7, dv = rowc & 127;
        st_fp8x16((unsigned char*)VDT + (((size_t)head * NT64 + tile) * 128 + dv) * 64 + pc * 16, e);
    }
    __syncthreads();
}

DI void ssm_prep_unit(const Params& P, int l, int chunk, int g, char* lds) {
    unsigned char* ws = P.ws;
    const int tid = opaque_tid(), lane = tid & 63, wid = tid >> 6, r = lane & 31, h = lane >> 5;
    const bf16_t* U = (const bf16_t*)(ws + WS_U);
    const float* DTR = (const float*)(ws + WS_DTR);
    bf16_t* XST = (bf16_t*)(ws + WS_XST); bf16_t* BCN = (bf16_t*)(ws + WS_BCN);
    float* DTS = (float*)(ws + WS_DTS); float* CUM = (float*)(ws + WS_CUM); bf16_t* ST = (bf16_t*)(ws + WS_ST); float* DEC = (float*)(ws + WS_DEC);
    const float* cw = P.in[20] + (size_t)l * 5 * 1024; const float* cb = P.in[21] + (size_t)l * 1024;
    const int t0 = chunk * 128;
    const int seq_lo = (t0 < SEQ) ? 0 : SEQ, seq_hi = (t0 < SEQ) ? SEQ : T;
    constexpr int PT = 136;
    bf16_t* xsT = (bf16_t*)lds;
    bf16_t* bT = (bf16_t*)(lds + 69632);
    float* scl = (float*)(lds + 69632 + 34816);
    auto toff = [](int row, int pos) { return row * PT + ((((pos >> 3) ^ ((row >> 3) & 15)) << 3) | (pos & 7)); };
    {
        const int cg = tid & 63, ts = tid >> 6;
        int ch;
        if (cg < 32) ch = 256 * g + 8 * cg; else if (cg < 48) ch = 512 + 128 * g + 8 * (cg - 32); else ch = 768 + 128 * g + 8 * (cg - 48);
        float wv[5][8], bv[8];
#pragma unroll
        for (int k = 0; k < 5; ++k) {
            const f32x4 a = *(const f32x4*)(cw + (size_t)k * 1024 + ch), b2 = *(const f32x4*)(cw + (size_t)k * 1024 + ch + 4);
            wv[k][0] = a.x; wv[k][1] = a.y; wv[k][2] = a.z; wv[k][3] = a.w; wv[k][4] = b2.x; wv[k][5] = b2.y; wv[k][6] = b2.z; wv[k][7] = b2.w;
        }
        { const f32x4 a = *(const f32x4*)(cb + ch), b2 = *(const f32x4*)(cb + ch + 4); bv[0] = a.x; bv[1] = a.y; bv[2] = a.z; bv[3] = a.w; bv[4] = b2.x; bv[5] = b2.y; bv[6] = b2.z; bv[7] = b2.w; }
        const int tb = t0 + ts * 16;
        u32x4 raw[20];
#pragma unroll
        for (int i = 0; i < 20; ++i) { const int t = tb - 2 + i; raw[i] = (t >= seq_lo && t < seq_hi) ? *(const u32x4*)(U + (size_t)t * NIN + U_XS + ch) : (u32x4){0u, 0u, 0u, 0u}; }
#pragma unroll
        for (int q = 0; q < 16; ++q) {
            float y[8];
#pragma unroll
            for (int i = 0; i < 8; ++i) y[i] = bv[i];
#pragma unroll
            for (int k = 0; k < 5; ++k) { const u32x4 w = raw[q + k];
                y[0] += wv[k][0] * bflo(w.x); y[1] += wv[k][1] * bfhi(w.x); y[2] += wv[k][2] * bflo(w.y); y[3] += wv[k][3] * bfhi(w.y);
                y[4] += wv[k][4] * bflo(w.z); y[5] += wv[k][5] * bfhi(w.z); y[6] += wv[k][6] * bflo(w.w); y[7] += wv[k][7] * bfhi(w.w); }
#pragma unroll
            for (int i = 0; i < 8; ++i) y[i] = siluf_(y[i]);
            const int t = tb + q, tl_ = ts * 16 + q;
            u32x4 w; w.x = pk2(y[0], y[1]); w.y = pk2(y[2], y[3]); w.z = pk2(y[4], y[5]); w.w = pk2(y[6], y[7]);
            if (cg < 32) {
                const int pos = (tl_ & ~15) | kperm(tl_ & 15);
#pragma unroll
                for (int i = 0; i < 8; ++i) xsT[toff(8 * cg + i, pos)] = f2bf(y[i]);
            } else if (cg < 48) {
                *(u32x4*)(BCN + (size_t)t * 512 + 128 * g + 8 * (cg - 32)) = w;
#pragma unroll
                for (int i = 0; i < 8; ++i) bT[toff(8 * (cg - 32) + i, tl_)] = f2bf(y[i]);
            } else {
                *(u32x4*)(BCN + (size_t)t * 512 + 256 + 128 * g + 8 * (cg - 48)) = w;
            }
        }
    }
    {
        const int j = wid, d = j >> 2, hh = 4 * g + (j & 3);
        const float a = -__expf(P.in[23][l * 16 + d * 8 + hh]);
        const float bias = P.in[22][l * 16 + d * 8 + hh];
        const int i0 = 2 * lane, i1 = 2 * lane + 1;
        const int k0 = d ? 127 - i0 : i0, k1 = d ? 127 - i1 : i1;
        const float r0 = DTR[(size_t)(t0 + k0) * 16 + d * 8 + hh] + bias, r1 = DTR[(size_t)(t0 + k1) * 16 + d * 8 + hh] + bias;
        const float sp0 = (r0 > 20.f) ? r0 : log1pf(__expf(r0)), sp1 = (r1 > 20.f) ? r1 : log1pf(__expf(r1));
        const float x0 = sp0 * a, x1 = sp1 * a;
        float incl = x0 + x1;
#pragma unroll
        for (int sft = 1; sft < 64; sft <<= 1) { const float tv = __shfl_up(incl, sft); if (lane >= sft) incl += tv; }
        const float c0 = incl - x1, c1 = incl;
        const float tot = __shfl(incl, 63);
        DTS[(size_t)(t0 + k0) * 16 + d * 8 + hh] = sp0; DTS[(size_t)(t0 + k1) * 16 + d * 8 + hh] = sp1;
        CUM[(size_t)(t0 + k0) * 16 + d * 8 + hh] = c0; CUM[(size_t)(t0 + k1) * 16 + d * 8 + hh] = c1;
        if (lane == 0) DEC[(size_t)chunk * 16 + d * 8 + hh] = __expf(tot);
        scl[j * 128 + ((k0 & ~15) | kperm(k0 & 15))] = sp0 * __expf(tot - c0);
        scl[j * 128 + ((k1 & ~15) | kperm(k1 & 15))] = sp1 * __expf(tot - c1);
    }
    __syncthreads();
    for (int i = tid; i < 256 * 16; i += NTHR) {
        const int chl = i >> 4, pc = i & 15;
        *(u32x4*)(XST + ((size_t)chunk * 512 + 256 * g + chl) * 128 + pc * 8) = *(const u32x4*)(xsT + toff(chl, pc * 8));
    }
    {
        const int j = wid, d = j >> 2, hl = j & 3, hh = 4 * g + hl;
        f32x16 acc[4][2];
#pragma unroll
        for (int nb = 0; nb < 4; ++nb)
#pragma unroll
            for (int pb = 0; pb < 2; ++pb)
#pragma unroll
                for (int i = 0; i < 16; ++i) acc[nb][pb][i] = 0.f;
        const int pr = perm32(r);
#pragma unroll 1
        for (int ks = 0; ks < 8; ++ks) {
            const f32x4 s0 = *(const f32x4*)(scl + j * 128 + 16 * ks + 8 * h), s1 = *(const f32x4*)(scl + j * 128 + 16 * ks + 8 * h + 4);
            bf16x8 xf[2];
#pragma unroll
            for (int pb = 0; pb < 2; ++pb) {
                const u32x4 w = *(const u32x4*)(xsT + toff(hl * 64 + pb * 32 + r, 16 * ks + 8 * h));
                u32x4 o; o.x = pk2(bflo(w.x) * s0.x, bfhi(w.x) * s0.y); o.y = pk2(bflo(w.y) * s0.z, bfhi(w.y) * s0.w);
                o.z = pk2(bflo(w.z) * s1.x, bfhi(w.z) * s1.y); o.w = pk2(bflo(w.w) * s1.z, bfhi(w.w) * s1.w);
                xf[pb] = __builtin_bit_cast(bf16x8, o);
            }
#pragma unroll
            for (int nb = 0; nb < 4; ++nb) {
                const u32x2 lo = *(const u32x2*)(bT + toff(nb * 32 + pr, 16 * ks + 4 * h)), hi = *(const u32x2*)(bT + toff(nb * 32 + pr, 16 * ks + 8 + 4 * h));
                u32x4 bw; bw.x = lo.x; bw.y = lo.y; bw.z = hi.x; bw.w = hi.y;
                const bf16x8 bf = __builtin_bit_cast(bf16x8, bw);
#pragma unroll
                for (int pb = 0; pb < 2; ++pb) acc[nb][pb] = MFMA32(bf, xf[pb], acc[nb][pb]);
            }
        }
        bf16_t* dst = ST + (((size_t)chunk * 2 + d) * 8 + hh) * 8192;
#pragma unroll
        for (int nb = 0; nb < 4; ++nb)
#pragma unroll
            for (int pb = 0; pb < 2; ++pb) { float v[16];
#pragma unroll
                for (int i = 0; i < 16; ++i) v[i] = acc[nb][pb][i];
                st_bf16x16(dst + (size_t)(pb * 32 + r) * 128 + nb * 32 + 16 * h, v); }
    }
    __syncthreads();
}

DI int first_unit(int off) { const int G = GRID; int v = opaque_bid() - (off % G); if (v < 0) v += G; return v; }
struct P3Sched {
    g8::GridSched<NQB, 7> G; const char* Bkv; size_t aoff;
    DI bool next(int i, g8::Unit& u) const {
        if (!G.next(i, u)) return false;
        if (u.t1 >= 3) { u.a += aoff; u.b = Bkv + (size_t)(u.t1 - 3) * G.bstep; }
        return true;
    }
};
struct EpiP3 {
    bf16_t* Q; bf16_t* KV;
    DI void operator()(const g8::Acc& acc, const g8::Unit& u, int wr, int wc, int fr, int fq) const {
        g8::Unit v = u;
        if (u.t1 < 3) { EpiBf16Plain e{Q, 768}; e(acc, v, wr, wc, fr, fq); }
        else { v.t1 = u.t1 - 3; EpiBf16Plain e{KV, 1024}; e(acc, v, wr, wc, fr, fq); }
    }
};
DI void phase_p3(const Params& P, int l, char* lds) {
    unsigned char* ws = P.ws;
    const int G = GRID;
    const bf16_t* U = (const bf16_t*)(ws + WS_U);
    for (int v = first_unit(0); v < P3_SSM; v += G) ssm_prep_unit(P, l, v >> 1, v & 1, lds);
    for (int v = first_unit(P3_SSM); v < P3_DIF; v += G) dif_prep_unit(P, l, v, lds);
    { P3Sched S; S.G.init(U + U_CQ, NIN, ws + WS_WUQ + l * SZ_WUQ, 256);
      S.G.gs = GRID - 8; S.G.c = (S.G.c < 8) ? (1 << 20) : (S.G.c - 8);
      S.Bkv = (const char*)(ws + WS_WUKV + l * SZ_WUKV); S.aoff = (size_t)(U_CKV - U_CQ) * 2;
      EpiP3 E{(bf16_t*)(ws + WS_QRAW), (bf16_t*)(ws + WS_KVRAW)};
      g8::gemm_phase<true>((LAS unsigned char*)lds, 256, NIN, S, E); }
}

DI void mla_finalize_unit(const Params& P, int l, int tile, char* lds) {
    unsigned char* ws = P.ws;
    const int tid = opaque_tid(), lane = tid & 63, wid = tid >> 6;
    const bf16_t* U = (const bf16_t*)(ws + WS_U);
    const bf16_t* QRAW = (const bf16_t*)(ws + WS_QRAW); const bf16_t* KVRAW = (const bf16_t*)(ws + WS_KVRAW);
    bf16_t* QM = (bf16_t*)(ws + WS_QM); bf16_t* KM = (bf16_t*)(ws + WS_KM); bf16_t* VMT = (bf16_t*)(ws + WS_VMT);
    const float* TABM = rope_tab(ws);
    const float* gqn = P.in[14] + l * 96; const float* gkn = P.in[15] + l * 96;
    const int head = lane >> 3, sub = lane & 7;
    const bool act = sub < 6;
    const float qscale = 0.10206207261596575f * LOG2E;
    bf16_t* vs = (bf16_t*)lds;
#pragma unroll 1
    for (int qb = 0; qb < 2; ++qb) {
    u32x2 l_cq[4]; unsigned l_ckv[4]; u32x4 l_q0[4], l_q1[4], l_k0[4], l_k1[4], l_v[4];
#pragma unroll
    for (int qq = 0; qq < 4; ++qq) {
        const int t = tile * 64 + wid * 8 + qb * 4 + qq;
        l_cq[qq] = *(const u32x2*)(U + (size_t)t * NIN + U_CQ + lane * 4);
        l_ckv[qq] = *(const unsigned*)(U + (size_t)t * NIN + U_CKV + lane * 2);
        if (act) { const bf16_t* src = QRAW + (size_t)t * 768 + head * 96 + sub * 16; l_q0[qq] = *(const u32x4*)src; l_q1[qq] = *(const u32x4*)(src + 8);
            const bf16_t* ks = (sub < 4) ? (KVRAW + (size_t)t * 1024 + head * 128 + sub * 16) : (U + (size_t)t * NIN + U_KR + (sub - 4) * 16);
            l_k0[qq] = *(const u32x4*)ks; l_k1[qq] = *(const u32x4*)(ks + 8); }
        else { l_q0[qq] = l_q1[qq] = l_k0[qq] = l_k1[qq] = (u32x4){0u, 0u, 0u, 0u}; }
        l_v[qq] = *(const u32x4*)(KVRAW + (size_t)t * 1024 + (lane >> 3) * 128 + 64 + (lane & 7) * 8);
    }
#pragma unroll
    for (int qq = 0; qq < 4; ++qq) {
        const int q = qb * 4 + qq;
        const int tl_ = wid * 8 + q, t = tile * 64 + tl_;
        const bool lat = t < SEQ;
        float rq, rkv;
        { const u32x2 w = l_cq[qq];
          float s = bflo(w.x) * bflo(w.x) + bfhi(w.x) * bfhi(w.x) + bflo(w.y) * bflo(w.y) + bfhi(w.y) * bfhi(w.y);
          s = wave_sum(s); rq = rsqrtf(s * (1.0f / 256.0f) + EPS);
          const unsigned w2 = l_ckv[qq];
          float s2 = bflo(w2) * bflo(w2) + bfhi(w2) * bfhi(w2);
          s2 = wave_sum(s2); rkv = rsqrtf(s2 * (1.0f / 128.0f) + EPS); }
        const int prow = t >> 6, pcol = 256 + (t & 63);
        {
            float x[16];
            { const u32x4 w0 = l_q0[qq], w1 = l_q1[qq];
                const unsigned ww[8] = {w0.x, w0.y, w0.z, w0.w, w1.x, w1.y, w1.z, w1.w};
#pragma unroll
                for (int i = 0; i < 8; ++i) { x[2 * i] = bflo(ww[i]) * rq; x[2 * i + 1] = bfhi(ww[i]) * rq; } }
            float ss = 0.f;
#pragma unroll
            for (int i = 0; i < 16; ++i) ss += x[i] * x[i];
            ss = oct_sum(ss);
            const float rstd = rsqrtf(ss * (1.0f / 96.0f) + EPS);
            if (act) {
#pragma unroll
                for (int i = 0; i < 16; ++i) x[i] = x[i] * rstd * gqn[sub * 16 + i];
                if (lat && sub >= 4) {
                    const int pos = (sub == 4) ? prow : pcol;
                    const float* cs = TABM + pos * 8; const float* sn = TABM + 320 * 8 + pos * 8;
#pragma unroll
                    for (int i = 0; i < 8; ++i) { const float a = x[i], b2 = x[8 + i], c = cs[i], s = sn[i]; x[i] = a * c - b2 * s; x[8 + i] = b2 * c + a * s; }
                }
#pragma unroll
                for (int i = 0; i < 16; ++i) x[i] *= qscale;
                st_bf16x16(QM + ((size_t)head * T + t) * 96 + sub * 16, x);
            }
        }
        {
            float x[16];
            { const float sc = (sub < 4) ? rkv : 1.0f;
                const u32x4 w0 = l_k0[qq], w1 = l_k1[qq];
                const unsigned ww[8] = {w0.x, w0.y, w0.z, w0.w, w1.x, w1.y, w1.z, w1.w};
#pragma unroll
                for (int i = 0; i < 8; ++i) { x[2 * i] = bflo(ww[i]) * sc; x[2 * i + 1] = bfhi(ww[i]) * sc; } }
            float ss = 0.f;
#pragma unroll
            for (int i = 0; i < 16; ++i) ss += x[i] * x[i];
            ss = oct_sum(ss);
            const float rstd = rsqrtf(ss * (1.0f / 96.0f) + EPS);
            if (act) {
#pragma unroll
                for (int i = 0; i < 16; ++i) x[i] = x[i] * rstd * gkn[sub * 16 + i];
                if (lat && sub >= 4) {
                    const int pos = (sub == 4) ? prow : pcol;
                    const float* cs = TABM + pos * 8; const float* sn = TABM + 320 * 8 + pos * 8;
#pragma unroll
                    for (int i = 0; i < 8; ++i) { const float a = x[i], b2 = x[8 + i], c = cs[i], s = sn[i]; x[i] = a * c - b2 * s; x[8 + i] = b2 * c + a * s; }
                }
                st_fp8x16((unsigned char*)KM + ((size_t)head * T + t) * 96 + sub * 16, x);
            }
        }
        {
            const int hh = lane >> 3, dv0 = (lane & 7) * 8;
            const u32x4 w = l_v[qq];
            u32x4 o; o.x = pk2(bflo(w.x) * rkv, bfhi(w.x) * rkv); o.y = pk2(bflo(w.y) * rkv, bfhi(w.y) * rkv); o.z = pk2(bflo(w.z) * rkv, bfhi(w.z) * rkv); o.w = pk2(bflo(w.w) * rkv, bfhi(w.w) * rkv);
            *(u32x4*)(vs + tl_ * 520 + hh * 64 + dv0) = o;
        }
    }
    }
    __syncthreads();
#pragma unroll 1
    for (int it = 0; it < 4; ++it) {
        const int cid = tid + it * NTHR;
        const int rowc = cid >> 2, pc = cid & 3;
        float e[16];
#pragma unroll
        for (int j = 0; j < 16; ++j) { const int key = kperm8(pc * 16 + j); e[j] = bf2f(vs[key * 520 + rowc]); }
        const int hh = rowc >> 6, dv = rowc & 63;
        st_fp8x16((unsigned char*)VMT + (((size_t)hh * NT64 + tile) * 64 + dv) * 64 + pc * 16, e);
    }
    __syncthreads();
}

DI void ssd_scan(const Params& P) {
    unsigned char* ws = P.ws;
    const bf16_t* __restrict__ ST = (const bf16_t*)(ws + WS_ST); const float* __restrict__ DEC = (const float*)(ws + WS_DEC);
    bf16_t* __restrict__ HIN = (bf16_t*)(ws + WS_HIN);
    const int total = 2 * 8 * 8192;
    static_assert(2 * 8 * 8192 == GRID * NTHR, "one element per thread");
    const int bid_ = opaque_bid();
    const int nsh = (bid_ < 4) ? 0 : ((bid_ < 8) ? 2 : 1);
#pragma unroll 1
    for (int sh = 0; sh < nsh; ++sh) {
        const int e = (sh == 0 ? bid_ : bid_ - 4) * NTHR + opaque_tid();
        const int dh = __builtin_amdgcn_readfirstlane(e >> 13), d = dh >> 3;
        float hst = 0.f;
#pragma unroll 1
        for (int b = 0; b < 5; ++b) {
            bf16_t stv[26]; float dcv[26];
#pragma unroll
            for (int j = 0; j < 26; ++j) {
                const int s = b * 26 + j;
                const int c = (d == 0) ? ((s < 2) ? (128 + s) : (s - 2)) : (129 - s);
                stv[j] = ST[(size_t)c * (16 * 8192) + e]; dcv[j] = DEC[c * 16 + dh];
            }
            __builtin_amdgcn_sched_barrier(0);
#pragma unroll
            for (int j = 0; j < 26; ++j) {
                const int s = b * 26 + j;
                const int c = (d == 0) ? ((s < 2) ? (128 + s) : (s - 2)) : (129 - s);
                HIN[(size_t)c * (16 * 8192) + e] = f2bf(hst);
                hst = hst * dcv[j] + bf2f(stv[j]);
            }
            __builtin_amdgcn_sched_barrier(0);
        }
    }
    (void)total;
}

DI void phase_p3b(const Params& P, int l, char* lds) {
    ssd_scan(P);
    for (int u = blockIdx.x; u < NT64; u += GRID) mla_finalize_unit(P, l, u, lds);
}

DI float gain_bound(const float* g, int n) { float m = 0.f; for (int i = 0; i < n; ++i) m = fmaxf(m, fabsf(g[i])); return m; }

DI void mla_attn_unit(const Params& P, int l, int head, int qb, char* lds, float shift) {
    unsigned char* ws = P.ws;
    const int tid = opaque_tid(), lane = tid & 63, wid = tid >> 6, r = lane & 31, h = lane >> 5;
    const bf16_t* QM = (const bf16_t*)(ws + WS_QM) + (size_t)head * T * 96;
    const unsigned char* KM = (const unsigned char*)(ws + WS_KM) + (size_t)head * T * 96;
    const unsigned char* VMT = (const unsigned char*)(ws + WS_VMT) + (size_t)head * T * 64;
    bf16_t* YA = (bf16_t*)(ws + WS_YA);
    const int kt0 = (qb == NQB - 1) ? (SEQ / 64) : 0, kt1 = NT64;
    f32x16 o[2]; float ls;
    attn_core<96, 64>(lds, QM + (size_t)(qb * 256 + wid * 32) * 96, KM, VMT, kt0, kt1, shift, o, ls);
    const float inv = 1.0f / ls;
    const int t = qb * 256 + wid * 32 + r;
#pragma unroll
    for (int db = 0; db < 2; ++db) { float v[16];
#pragma unroll
        for (int i = 0; i < 16; ++i) v[i] = o[db][i] * inv;
        st_bf16x16(YA + (size_t)t * 512 + head * 64 + db * 32 + 16 * h, v); }
}

DI void dif_attn_unit(const Params& P, int l, int head, int qb, char* lds, float shift, float lam, float lam_init) {
    unsigned char* ws = P.ws;
    const int tid = opaque_tid(), lane = tid & 63, wid = tid >> 6, r = lane & 31, h = lane >> 5;
    const unsigned char* VDT = (const unsigned char*)(ws + WS_VDT) + (size_t)head * T * 128;
    bf16_t* YB = (bf16_t*)(ws + WS_YB);
    float* O1 = (float*)(ws + WS_O1) + (size_t)blockIdx.x * 256 * 128;
    const int kt0 = (qb == NQB - 1) ? (SEQ / 64) : 0, kt1 = NT64;
    const int rowl = wid * 32 + r;
    {
        const int vh = head * 2;
        const bf16_t* QD = (const bf16_t*)(ws + WS_QD) + (size_t)vh * T * 64;
        const unsigned char* KD = (const unsigned char*)(ws + WS_KD) + (size_t)vh * T * 64;
        f32x16 o[4]; float ls;
        attn_core<64, 128>(lds, QD + (size_t)(qb * 256 + wid * 32) * 64, KD, VDT, kt0, kt1, shift, o, ls);
        const float inv = 1.0f / ls;
#pragma unroll
        for (int db = 0; db < 4; ++db)
#pragma unroll
            for (int q = 0; q < 4; ++q)
                *(f32x4*)(O1 + (size_t)rowl * 128 + db * 32 + 16 * h + 4 * q) = (f32x4){o[db][4 * q] * inv, o[db][4 * q + 1] * inv, o[db][4 * q + 2] * inv, o[db][4 * q + 3] * inv};
    }
    {
        const int vh = head * 2 + 1;
        const bf16_t* QD = (const bf16_t*)(ws + WS_QD) + (size_t)vh * T * 64;
        const unsigned char* KD = (const unsigned char*)(ws + WS_KD) + (size_t)vh * T * 64;
        f32x16 o[4]; float ls;
        attn_core<64, 128>(lds, QD + (size_t)(qb * 256 + wid * 32) * 64, KD, VDT, kt0, kt1, shift, o, ls);
        const float inv = 1.0f / ls;
        float ss = 0.f;
#pragma unroll
        for (int db = 0; db < 4; ++db)
#pragma unroll
            for (int q = 0; q < 4; ++q) {
                const f32x4 a = *(const f32x4*)(O1 + (size_t)rowl * 128 + db * 32 + 16 * h + 4 * q);
                o[db][4 * q] = a.x - lam * o[db][4 * q] * inv; o[db][4 * q + 1] = a.y - lam * o[db][4 * q + 1] * inv;
                o[db][4 * q + 2] = a.z - lam * o[db][4 * q + 2] * inv; o[db][4 * q + 3] = a.w - lam * o[db][4 * q + 3] * inv;
                ss += o[db][4 * q] * o[db][4 * q] + o[db][4 * q + 1] * o[db][4 * q + 1] + o[db][4 * q + 2] * o[db][4 * q + 2] + o[db][4 * q + 3] * o[db][4 * q + 3];
            }
        ss += __shfl_xor(ss, 32);
        const float rstd = rsqrtf(ss * (1.0f / 128.0f) + EPS) * (1.0f - lam_init);
        const float* gs = P.in[19] + l * 128;
        const int t = qb * 256 + rowl;
#pragma unroll
        for (int db = 0; db < 4; ++db) { float v[16];
#pragma unroll
            for (int i = 0; i < 16; ++i) v[i] = o[db][i] * rstd * gs[db * 32 + 16 * h + i];
            st_bf16x16(YB + (size_t)t * 512 + head * 128 + db * 32 + 16 * h, v); }
    }
}

DI void ssd_out_unit(const Params& P, int l, int chunk, int hf, int g, char* lds) {
    unsigned char* ws = P.ws;
    const int tid = opaque_tid(), lane = tid & 63, wid = tid >> 6, r = lane & 31, h = lane >> 5;
    const bf16_t* U = (const bf16_t*)(ws + WS_U);
    const bf16_t* XST = (const bf16_t*)(ws + WS_XST); const bf16_t* BCN = (const bf16_t*)(ws + WS_BCN);
    const float* DTS = (const float*)(ws + WS_DTS); const float* CUM = (const float*)(ws + WS_CUM);
    const bf16_t* HIN = (const bf16_t*)(ws + WS_HIN);
    bf16_t* YC = (bf16_t*)(ws + WS_YC);
    const int t0 = chunk * 128;
    char* Bs = lds; char* Cs = lds + 32768; char* Xs = lds + 49152;
    float* dt0 = (float*)(lds + 114688);
    float* dt1 = dt0 + 512; float* cm0 = dt1 + 512; float* cm1 = cm0 + 512;
    float* ssq = cm1 + 512;
    bf16x8 hq[2][8];
    { const int hl_ = wid >> 1, hh_ = 4 * g + hl_, pr_ = perm32(r);
      const bf16_t* hp_ = HIN + (((size_t)chunk * 2 + 0) * 8 + hh_) * 8192;
#pragma unroll
      for (int pb = 0; pb < 2; ++pb)
#pragma unroll
          for (int ks = 0; ks < 8; ++ks) hq[pb][ks] = *(const bf16x8*)(hp_ + (size_t)(pb * 32 + pr_) * 128 + 16 * ks + 8 * h); }
    {
        u32x4 tb_[4], tc_[2], tx_[8]; float ts_[4];
#pragma unroll
        for (int j = 0; j < 4; ++j) { const int i = tid + j * NTHR, row = i >> 4, c = i & 15; tb_[j] = *(const u32x4*)(BCN + (size_t)(t0 + row) * 512 + 128 * g + c * 8); }
#pragma unroll
        for (int j = 0; j < 2; ++j) { const int i = tid + j * NTHR, row = i >> 4, c = i & 15; tc_[j] = *(const u32x4*)(BCN + (size_t)(t0 + hf * 64 + row) * 512 + 256 + 128 * g + c * 8); }
#pragma unroll
        for (int j = 0; j < 8; ++j) { const int i = tid + j * NTHR, row = i >> 4, c = i & 15; tx_[j] = *(const u32x4*)(XST + ((size_t)chunk * 512 + 256 * g + row) * 128 + c * 8); }
        { const int hl_ = tid >> 7, s_ = tid & 127, hh_ = 4 * g + hl_; const size_t b_ = (size_t)(t0 + s_) * 16;
          ts_[0] = DTS[b_ + hh_]; ts_[1] = DTS[b_ + 8 + hh_]; ts_[2] = CUM[b_ + hh_]; ts_[3] = CUM[b_ + 8 + hh_]; }
#pragma unroll
        for (int j = 0; j < 4; ++j) { const int i = tid + j * NTHR, row = i >> 4, c = i & 15; *(u32x4*)(Bs + row * 256 + ((c ^ (row & 15)) << 4)) = tb_[j]; }
#pragma unroll
        for (int j = 0; j < 2; ++j) { const int i = tid + j * NTHR, row = i >> 4, c = i & 15; *(u32x4*)(Cs + row * 256 + ((c ^ (row & 15)) << 4)) = tc_[j]; }
#pragma unroll
        for (int j = 0; j < 8; ++j) { const int i = tid + j * NTHR, row = i >> 4, c = i & 15; *(u32x4*)(Xs + row * 256 + ((c ^ (row & 15)) << 4)) = tx_[j]; }
        dt0[tid] = ts_[0]; dt1[tid] = ts_[1]; cm0[tid] = ts_[2]; cm1[tid] = ts_[3];
    }
    __syncthreads();
    const int hl = wid >> 1, lb = wid & 1, hh = 4 * g + hl;
    const int lrow = hf * 64 + lb * 32 + r;
    const int pr = perm32(r);
    bf16x8 cf[8];
    { const int crow_ = lb * 32 + r;
#pragma unroll
      for (int ks = 0; ks < 8; ++ks) cf[ks] = *(const bf16x8*)(Cs + crow_ * 256 + (((2 * ks + h) ^ (crow_ & 15)) << 4)); }
    const float c0l = cm0[hl * 128 + lrow], c1l = cm1[hl * 128 + lrow];
    f32x16 y[2];
#pragma unroll
    for (int pb = 0; pb < 2; ++pb)
#pragma unroll
        for (int i = 0; i < 16; ++i) y[pb][i] = 0.f;
#define SSD_OFFDIAG(d) do { f32x16 a_[2]; \
        _Pragma("unroll") for (int pb = 0; pb < 2; ++pb) _Pragma("unroll") for (int i = 0; i < 16; ++i) a_[pb][i] = 0.f; \
        _Pragma("unroll") for (int ks = 0; ks < 8; ++ks) _Pragma("unroll") for (int pb = 0; pb < 2; ++pb) a_[pb] = MFMA32(hq[pb][ks], cf[ks], a_[pb]); \
        const float e_ = __expf((d) == 0 ? c0l : c1l); \
        _Pragma("unroll") for (int pb = 0; pb < 2; ++pb) _Pragma("unroll") for (int i = 0; i < 16; ++i) y[pb][i] += e_ * a_[pb][i]; } while (0)
#define SSD_LDH(d) do { const bf16_t* hp_ = HIN + (((size_t)chunk * 2 + (d)) * 8 + hh) * 8192; \
        _Pragma("unroll") for (int pb = 0; pb < 2; ++pb) _Pragma("unroll") for (int ks = 0; ks < 8; ++ks) hq[pb][ks] = *(const bf16x8*)(hp_ + (size_t)(pb * 32 + pr) * 128 + 16 * ks + 8 * h); } while (0)
    SSD_OFFDIAG(0);
    SSD_LDH(1);
#pragma unroll 1
    for (int sb = 0; sb < 4; ++sb) {
        f32x16 x;
#pragma unroll
        for (int i = 0; i < 16; ++i) x[i] = 0.f;
        const int brow = sb * 32 + r;
#pragma unroll
        for (int ks = 0; ks < 8; ++ks) {
            const bf16x8 bf = *(const bf16x8*)(Bs + brow * 256 + (((2 * ks + h) ^ (brow & 15)) << 4));
            x = MFMA32(bf, cf[ks], x);
        }
        float m[16];
#pragma unroll
        for (int q4 = 0; q4 < 4; ++q4) {
            const int s0 = sb * 32 + 8 * q4 + 4 * h;
            const f32x4 vc0 = *(const f32x4*)(cm0 + hl * 128 + s0), vc1 = *(const f32x4*)(cm1 + hl * 128 + s0);
            const f32x4 vd0 = *(const f32x4*)(dt0 + hl * 128 + s0), vd1 = *(const f32x4*)(dt1 + hl * 128 + s0);
#pragma unroll
            for (int jj = 0; jj < 4; ++jj) {
                const int s = s0 + jj;
                const float w0 = (s <= lrow) ? __expf(fminf(c0l - vc0[jj], 0.f)) * vd0[jj] : 0.f;
                const float w1 = (s >= lrow) ? __expf(fminf(c1l - vc1[jj], 0.f)) * vd1[jj] : 0.f;
                m[4 * q4 + jj] = x[4 * q4 + jj] * (w0 + w1);
            }
        }
#pragma unroll
        for (int s2 = 0; s2 < 2; ++s2) {
            u32x4 w; w.x = pk2(m[8 * s2 + 0], m[8 * s2 + 1]); w.y = pk2(m[8 * s2 + 2], m[8 * s2 + 3]); w.z = pk2(m[8 * s2 + 4], m[8 * s2 + 5]); w.w = pk2(m[8 * s2 + 6], m[8 * s2 + 7]);
            const bf16x8 mf = __builtin_bit_cast(bf16x8, w);
#pragma unroll
            for (int pb = 0; pb < 2; ++pb) {
                const int xrow = hl * 64 + pb * 32 + pr, c = 2 * (2 * sb + s2) + h;
                const bf16x8 xf = *(const bf16x8*)(Xs + xrow * 256 + ((c ^ (xrow & 15)) << 4));
                y[pb] = MFMA32(xf, mf, y[pb]);
            }
        }
    }
    SSD_OFFDIAG(1);
#undef SSD_OFFDIAG
#undef SSD_LDH
    const int t = t0 + lrow;
    const float dsk = P.in[24][l * 16 + hh] + P.in[24][l * 16 + 8 + hh];
    float ss = 0.f;
#pragma unroll
    for (int pb = 0; pb < 2; ++pb) {
        const int ch = hh * 64 + pb * 32 + 16 * h;
        const u32x4 z0 = *(const u32x4*)(U + (size_t)t * NIN + U_Z + ch), z1 = *(const u32x4*)(U + (size_t)t * NIN + U_Z + ch + 8);
        const unsigned zw[8] = {z0.x, z0.y, z0.z, z0.w, z1.x, z1.y, z1.z, z1.w};
        const int xpos = (lrow & ~15) | kperm(lrow & 15);
#pragma unroll
        for (int q = 0; q < 8; ++q) {
            const int xr0 = hl * 64 + pb * 32 + 16 * h + 2 * q, xr1 = xr0 + 1;
            const float xa = bf2f(*(const bf16_t*)(Xs + xr0 * 256 + (((xpos >> 3) ^ (xr0 & 15)) << 4) + (xpos & 7) * 2));
            const float xb = bf2f(*(const bf16_t*)(Xs + xr1 * 256 + (((xpos >> 3) ^ (xr1 & 15)) << 4) + (xpos & 7) * 2));
            float v0 = y[pb][2 * q] + dsk * xa, v1 = y[pb][2 * q + 1] + dsk * xb;
            v0 *= siluf_(bflo(zw[q])); v1 *= siluf_(bfhi(zw[q]));
            y[pb][2 * q] = v0; y[pb][2 * q + 1] = v1; ss += v0 * v0 + v1 * v1;
        }
    }
    ss += __shfl_xor(ss, 32);
    if (h == 0) ssq[hl * 64 + lb * 32 + r] = ss;
    __syncthreads();
    const int rr = lb * 32 + r;
    const float tot = ssq[rr] + ssq[64 + rr] + ssq[128 + rr] + ssq[192 + rr];
    const float rstd = rsqrtf(tot * (1.0f / 256.0f) + EPS);
    const float* gn = P.in[25] + l * 512;
#pragma unroll
    for (int pb = 0; pb < 2; ++pb) { const int ch = hh * 64 + pb * 32 + 16 * h; float v[16];
#pragma unroll
        for (int i = 0; i < 16; ++i) v[i] = y[pb][i] * rstd * gn[ch + i];
        st_bf16x16(YC + (size_t)t * 512 + ch, v); }
    __syncthreads();
}

constexpr int P4_DIF = 4 * NQB, P4_MLA = 8 * NQB, P4_SSD = NCHUNK * 4;

DI void phase_p4(const Params& P, int l, char* lds) {
    const int G = GRID;
    float sh_m, sh_d, lam;
    {
        const float gq = gain_bound(P.in[14] + l * 96, 96), gk = gain_bound(P.in[15] + l * 96, 96);
        sh_m = 9.797958971132712f * gq * gk * LOG2E * 1.02f;
        const float dq = gain_bound(P.in[16] + l * 64, 64), dk = gain_bound(P.in[17] + l * 64, 64);
        sh_d = 8.0f * dq * dk * LOG2E * 1.02f;
        const float* lp = P.in[18] + l * 256;
        float s1 = 0.f, s2 = 0.f;
        for (int i = 0; i < 64; ++i) { s1 += lp[i] * lp[64 + i]; s2 += lp[128 + i] * lp[192 + i]; }
        lam = __expf(s1) - __expf(s2);
    }
    const float lam_init = 0.8f - 0.6f * __expf(-0.3f * (float)l);
    lam += lam_init;
    const bool lastl = (l == NLAYER - 1);
    const int ndif = lastl ? 4 * (NQB - 1) : P4_DIF, nmla = lastl ? 8 * (NQB - 1) : P4_MLA, nssd = lastl ? (NCHUNK - 2) * 4 : P4_SSD;
    for (int v = first_unit(0); v < ndif; v += G) dif_attn_unit(P, l, v & 3, v >> 2, lds, sh_d, lam, lam_init);
    for (int v = first_unit(P4_DIF); v < nmla; v += G) mla_attn_unit(P, l, v & 7, v >> 3, lds, sh_m);
    {
        int* wq = (int*)(P.ws + WS_CTL) + l * 32 * ECS + 32;
        int* sl = (int*)(lds + 160000);
        for (;;) {
            __syncthreads();
            if (opaque_tid() == 0) *sl = __hip_atomic_fetch_add(wq, 1, __ATOMIC_RELAXED, __HIP_MEMORY_SCOPE_AGENT);
            __syncthreads();
            const int v = __builtin_amdgcn_readfirstlane(*sl);
            if (v >= nssd) break;
            ssd_out_unit(P, l, v >> 2, (v >> 1) & 1, v & 1, lds);
        }
    }
}

constexpr int N_PHASES = 2 + 10 * NLAYER;
#ifndef MK_PER_PHASE
#define MK_PER_PHASE 0
#endif

template <bool FUSED>
__global__ void __launch_bounds__(NTHR, 2) mega_fwd(Params P0) {
    extern __shared__ __attribute__((aligned(16))) char lds[];
    const int lo = FUSED ? 0 : P0.ph_lo, hi = FUSED ? N_PHASES : P0.ph_hi;
    constexpr bool fused = FUSED;
    volatile LAS unsigned* xbw = (volatile LAS unsigned*)(lds + LDS_BYTES - 16);
    XcdBarrier bar; bar.bar = (unsigned*)(P0.ws + WS_BAR); bar.x = 0; bar.st = xbw;
    if (fused) {
        if (threadIdx.x == 0) { xbw[0] = 0u; xbw[1] = 0u; xbw[2] = 0u; xbw[3] = 0u; }
        __syncthreads();
        bar = xcd_barrier_post((unsigned*)(P0.ws + WS_BAR), xbw);
    }
#define IN(k) (FUSED || (lo <= (k) && (k) < hi))
#define SEAM(k) do { if (FUSED) { if ((k) + 1 < N_PHASES) { XcdBarrier b2_ = bar; b2_.x = xb_xcc_id(); xcd_barrier(b2_); } } } while (0)
    if (IN(0)) phase_prologue(P0, lds);
    SEAM(0);
    if (IN(1)) phase_rows_norm1(P0, -1, 0);
    SEAM(1);
#pragma unroll 1
    for (int l = 0; l < NLAYER; ++l) {
        const int b = 2 + 10 * l;
        Params Q = P0; { int z = 0; asm volatile("" : "+s"(z)); Q.ws = P0.ws + z; }
        if (IN(b + 0)) phase_gemm_in(Q, l, lds);
        SEAM(b + 0);
        if (IN(b + 1)) phase_p3(Q, l, lds);
        SEAM(b + 1);
        if (IN(b + 2)) phase_p3b(Q, l, lds);
        SEAM(b + 2);
        if (IN(b + 3)) phase_p4(Q, l, lds);
        SEAM(b + 3);
        if (IN(b + 4)) phase_gemm_merge(Q, l, lds);
        SEAM(b + 4);
        if (IN(b + 5)) phase_gemm_out(Q, l, lds);
        SEAM(b + 5);
        if (IN(b + 6)) phase_router(Q, l, lds);
        SEAM(b + 6);
        if (IN(b + 7)) phase_moe_gu(Q, l, lds);
        SEAM(b + 7);
        if (IN(b + 8)) phase_moe_down(Q, l, lds);
        SEAM(b + 8);
        if (IN(b + 9)) phase_rows_norm1(Q, l, l + 1);
        SEAM(b + 9);
    }
#undef IN
#undef SEAM
}


extern "C" void kernel_launch(void* const* d_in, const int* in_sizes, int n_in, void* d_out, int out_size, void* d_ws, size_t ws_size, hipStream_t stream) {
    static int grid = 0;
    if (grid == 0) {
        if (n_in != 36 || ws_size < WS_END) { fprintf(stderr, "kernel_launch: unexpected n_in %d or ws_size %zu (< %zu)\n", n_in, ws_size, (size_t)WS_END); grid = -1; return; }
        int dev = 0, cus = 0;
        if (hipGetDevice(&dev) != hipSuccess || hipDeviceGetAttribute(&cus, hipDeviceAttributeMultiprocessorCount, dev) != hipSuccess) { grid = -1; return; }
        if (hipFuncSetAttribute((const void*)mega_fwd<MK_PER_PHASE == 0>, hipFuncAttributeMaxDynamicSharedMemorySize, LDS_BYTES) != hipSuccess) { fprintf(stderr, "kernel_launch: hipFuncSetAttribute failed\n"); grid = -1; return; }
        int per_cu = 0;
        if (hipOccupancyMaxActiveBlocksPerMultiprocessor(&per_cu, (const void*)mega_fwd<MK_PER_PHASE == 0>, NTHR, LDS_BYTES) != hipSuccess || per_cu < 1) { fprintf(stderr, "kernel_launch: occupancy query says %d\n", per_cu); }
        (void)hipGetLastError();
        if (cus < GRID) { fprintf(stderr, "kernel_launch: built for a %d-CU device, found %d CUs; nothing launched\n", GRID, cus); grid = -1; return; }
        grid = GRID;
    }
    if (grid < 0) return;
    (void)hipMemsetAsync((char*)d_ws + WS_BAR, 0, WS_MOD - WS_BAR, stream);
    Params p{};
    for (int i = 0; i < 36; ++i) p.in[i] = (const float*)d_in[i];
    p.out = (float*)d_out; p.ws = (unsigned char*)d_ws;
#if MK_PER_PHASE
    for (int k = 0; k < N_PHASES; ++k) { p.ph_lo = k; p.ph_hi = k + 1; hipLaunchKernelGGL(mega_fwd<MK_PER_PHASE == 0>, dim3(grid), dim3(NTHR), LDS_BYTES, stream, p); }
#else
    p.ph_lo = 0; p.ph_hi = N_PHASES;
    hipLaunchKernelGGL(mega_fwd<MK_PER_PHASE == 0>, dim3(grid), dim3(NTHR), LDS_BYTES, stream, p);
#endif
}
```

```cpp
#include <hip/hip_runtime.h>
#include <stdint.h>
#include <stdio.h>

#define DI __device__ __forceinline__
#define LAS __attribute__((address_space(3)))
typedef unsigned short bf16_t;
typedef short bf16x8 __attribute__((ext_vector_type(8)));
typedef float f32x16 __attribute__((ext_vector_type(16)));
typedef float f32x4 __attribute__((ext_vector_type(4)));
typedef float f32x2 __attribute__((ext_vector_type(2)));
typedef unsigned u32x4 __attribute__((ext_vector_type(4)));
typedef unsigned u32x2 __attribute__((ext_vector_type(2)));
typedef __bf16 bf16x2v __attribute__((ext_vector_type(2)));
typedef int i32x4 __attribute__((ext_vector_type(4)));

DI unsigned pk2(float a, float b) { f32x2 v = {a, b}; return __builtin_bit_cast(unsigned, __builtin_convertvector(v, bf16x2v)); }
typedef int i32x8 __attribute__((ext_vector_type(8)));
DI unsigned pk_fp8x4(float a, float b, float c, float d) { int v = __builtin_amdgcn_cvt_pk_fp8_f32(a, b, 0, false); v = __builtin_amdgcn_cvt_pk_fp8_f32(c, d, v, true); return (unsigned)v; }
DI unsigned pk_bf8x4(float a, float b, float c, float d) { int v = __builtin_amdgcn_cvt_pk_bf8_f32(a, b, 0, false); v = __builtin_amdgcn_cvt_pk_bf8_f32(c, d, v, true); return (unsigned)v; }
typedef short s16x2 __attribute__((ext_vector_type(2)));
DI unsigned pk_bf8x4s(float a, float b, float c, float d, float sc) {
    s16x2 r; asm volatile("" : "=v"(r));
    r = __builtin_amdgcn_cvt_scalef32_pk_bf8_f32(r, a, b, sc, false); r = __builtin_amdgcn_cvt_scalef32_pk_bf8_f32(r, c, d, sc, true); return __builtin_bit_cast(unsigned, r); }
DI void st_fp8x16(unsigned char* p, const float* v) {
    u32x4 w; w.x = pk_fp8x4(v[0], v[1], v[2], v[3]); w.y = pk_fp8x4(v[4], v[5], v[6], v[7]); w.z = pk_fp8x4(v[8], v[9], v[10], v[11]); w.w = pk_fp8x4(v[12], v[13], v[14], v[15]);
    *(u32x4*)p = w;
}
DI bf16_t f2bf(float a) { return (bf16_t)(pk2(a, 0.f) & 0xffffu); }
DI float bf2f(bf16_t v) { return __uint_as_float(((unsigned)v) << 16); }
DI float bflo(unsigned w) { return __uint_as_float(w << 16); }
DI float bfhi(unsigned w) { return __uint_as_float(w & 0xffff0000u); }
template <int CTRL, int RM> DI float dpp_add(float v) { const int y = __builtin_amdgcn_update_dpp(0, __float_as_int(v), CTRL, RM, 0xF, false); return v + __int_as_float(y); }
DI float quad_sum(float v) { v = dpp_add<0xB1, 0xF>(v); v = dpp_add<0x4E, 0xF>(v); return v; }
DI float oct_sum(float v) { v = quad_sum(v); v = dpp_add<0x141, 0xF>(v); return v; }
DI float wave_sum(float v) { v = oct_sum(v); v = dpp_add<0x140, 0xF>(v); v = dpp_add<0x142, 0xA>(v); v = dpp_add<0x143, 0xC>(v);
    return __int_as_float(__builtin_amdgcn_readlane(__float_as_int(v), 63)); }
template <int CTRL, int RM> DI float dpp_max(float v) { const int y = __builtin_amdgcn_update_dpp(__float_as_int(v), __float_as_int(v), CTRL, RM, 0xF, false); return fmaxf(v, __int_as_float(y)); }
DI float wave_max(float v) { v = dpp_max<0xB1, 0xF>(v); v = dpp_max<0x4E, 0xF>(v); v = dpp_max<0x141, 0xF>(v); v = dpp_max<0x140, 0xF>(v); v = dpp_max<0x142, 0xA>(v); v = dpp_max<0x143, 0xC>(v);
    return __int_as_float(__builtin_amdgcn_readlane(__float_as_int(v), 63)); }
DI unsigned pack_i8x4(float a, float b, float c, float d) {
    const int ia = (int)fminf(fmaxf(rintf(a), -127.f), 127.f), ib = (int)fminf(fmaxf(rintf(b), -127.f), 127.f), ic = (int)fminf(fmaxf(rintf(c), -127.f), 127.f), id = (int)fminf(fmaxf(rintf(d), -127.f), 127.f);
    return (unsigned)(ia & 0xff) | ((unsigned)(ib & 0xff) << 8) | ((unsigned)(ic & 0xff) << 16) | ((unsigned)(id & 0xff) << 24); }
DI float lane_xor1(float v) { return __int_as_float(__builtin_amdgcn_update_dpp(0, __float_as_int(v), 0xB1, 0xF, 0xF, false)); }
DI int opaque_tid() { int t = threadIdx.x; asm volatile("" : "+v"(t)); return t; }
DI int opaque_bid() { int b = blockIdx.x; asm volatile("" : "+s"(b)); return b; }
DI float fexp2(float x) { return __builtin_amdgcn_exp2f(x); }
DI float fexp(float x) { return __builtin_amdgcn_exp2f(x * 1.4426950408889634f); }
DI float frcp(float x) { return __builtin_amdgcn_rcpf(x); }
DI float sigmoidf_(float x) { return __builtin_amdgcn_rcpf(1.0f + __builtin_amdgcn_exp2f(-1.4426950408889634f * x)); }
DI float siluf_(float x) { return x * sigmoidf_(x); }

#define XB_TMO      128
#define XB_XCNT(j)  (256  + 64 * (j))
#define XB_XSUB(j)  (1280 + 64 * (j))
#define XB_XGEN(j)  (2304 + 64 * (j))
#define XB_TOP      3328
#define XB_TOPGEN   3392
#define XCD_BAR_WORDS 3456
#define XB_SPIN_CAP (1u << 18)
__device__ __forceinline__ unsigned xb_ld(unsigned* p)              { return __hip_atomic_load(p, __ATOMIC_RELAXED, __HIP_MEMORY_SCOPE_AGENT); }
__device__ __forceinline__ unsigned xb_add(unsigned* p, unsigned v) { return __hip_atomic_fetch_add(p, v, __ATOMIC_RELAXED, __HIP_MEMORY_SCOPE_AGENT); }
__device__ __forceinline__ unsigned xb_xcc_id() { return (unsigned)__builtin_amdgcn_s_getreg((3 << 11) | 20) & 0xFu; }
#define XB_SPIN(cond, bar) do { unsigned _sp = 0; while (cond) { __builtin_amdgcn_s_sleep(1); \
    if ((++_sp & 255u) == 0u) { if (xb_ld(&(bar)[XB_TMO])) break; if (_sp > XB_SPIN_CAP) { atomicAdd(&(bar)[XB_TMO], 1u); break; } } } } while (0)
struct XcdBarrier { unsigned* bar; unsigned x; volatile LAS unsigned* st; };
__device__ __forceinline__ XcdBarrier xcd_barrier_post(unsigned* bar, volatile LAS unsigned* st) {
    XcdBarrier b; b.bar = bar; b.x = xb_xcc_id(); b.st = st;
    if (threadIdx.x == 0) (void)xb_add(&bar[XB_XCNT(b.x)], 1u);
    return b;
}
__device__ __forceinline__ void xcd_barrier_complete(unsigned* bar, unsigned x, unsigned& nloc, unsigned& nx) {
    const unsigned G = gridDim.x * gridDim.y * gridDim.z;
    unsigned sum, cnt, mine, sp = 0u;
    for (;;) {
        sum = 0u; cnt = 0u; mine = 0u;
#pragma unroll
        for (unsigned j = 0; j < 16; ++j) { const unsigned c = xb_ld(&bar[XB_XCNT(j)]); sum += c; cnt += (c > 0u) ? 1u : 0u; mine = (j == x) ? c : mine; }
        if (sum == G) break;
        __builtin_amdgcn_s_sleep(1);
        if ((++sp & 255u) == 0u) { if (xb_ld(&bar[XB_TMO])) break; if (sp > XB_SPIN_CAP) { atomicAdd(&bar[XB_TMO], 1u); break; } }
    }
    nloc = mine > 0u ? mine : 1u; nx = cnt > 0u ? cnt : 1u;
}
__device__ __forceinline__ void xcd_barrier(const XcdBarrier& b) {
    asm volatile("s_waitcnt vmcnt(0)" ::: "memory");
    __syncthreads();
    if (threadIdx.x == 0) {
        unsigned* bar = b.bar;
        __builtin_amdgcn_s_waitcnt(0);
        unsigned nloc = b.st[0], nx = b.st[1];
        if (nloc == 0u) { xcd_barrier_complete(bar, b.x, nloc, nx); b.st[0] = nloc; b.st[1] = nx; }
        const unsigned old = xb_add(&bar[XB_XSUB(b.x)], 1u);
        const unsigned gen = old / nloc;
        if (old + 1u == (gen + 1u) * nloc) {
            __builtin_amdgcn_fence(__ATOMIC_RELEASE, "agent");
            asm volatile("s_waitcnt vmcnt(0)" ::: "memory");
            const unsigned og = xb_add(&bar[XB_TOP], 1u);
            const unsigned tg = og / nx;
            if (og + 1u == (tg + 1u) * nx) xb_add(&bar[XB_TOPGEN], 1u);
            else XB_SPIN(xb_ld(&bar[XB_TOPGEN]) == tg, bar);
            __builtin_amdgcn_fence(__ATOMIC_ACQUIRE, "agent");
            xb_add(&bar[XB_XGEN(b.x)], 1u);
            asm volatile("s_waitcnt vmcnt(0)" ::: "memory");
        } else {
            XB_SPIN(xb_ld(&bar[XB_XGEN(b.x)]) == gen, bar);
            __builtin_amdgcn_fence(__ATOMIC_ACQUIRE, "agent");
            asm volatile("s_waitcnt vmcnt(0)" ::: "memory");
        }
    }
    __syncthreads();
}

constexpr int DM = 1024, SEQ = 16384, CTXN = 256, T = SEQ + CTXN, NLAYER = 4;
constexpr int NIN = 6912;
constexpr int U_CQ = 0, U_CKV = 256, U_KR = 384, U_DQ = 512, U_DK = 1024, U_DV = 1536, U_Z = 2048, U_XS = 2560, U_B = 3072, U_C = 3328, U_DT = 3584, U_G = 3840;
constexpr int NT64 = T / 64, NCHUNK = T / 128, NQB = T / 256;
constexpr int NEXP = 32, DFF = 1024;
constexpr int MOE_ROWS = 74752;
constexpr float EPS = 1e-6f;
constexpr float LOG2E = 1.4426950408889634f;
constexpr int NTHR = 512;
constexpr int GRID = 256;
constexpr int LDS_BYTES = 160 * 1024 - 256;

constexpr size_t al256(size_t x) { return (x + 255) & ~(size_t)255; }
constexpr size_t WS_BAR   = 0;
constexpr size_t WS_CTL   = al256(WS_BAR + XCD_BAR_WORDS * 4);
constexpr int ECS = 64;
constexpr size_t WS_MOD   = al256(WS_CTL + (size_t)NLAYER * 32 * ECS * 4);
constexpr size_t WS_TAB   = al256(WS_MOD + (size_t)NLAYER * 2 * 6144 * 4);
constexpr size_t TAB_FLOATS = (256 + 64) * 8 * 2 + (256 + 64) * 16 * 2;
constexpr size_t WS_WRT   = al256(WS_TAB + TAB_FLOATS * 4);
constexpr size_t WS_WIN   = al256(WS_WRT + (size_t)NLAYER * 32 * 1024 * 4);
constexpr size_t SZ_WIN   = (size_t)NIN * 1024;
constexpr size_t WS_WUQ   = al256(WS_WIN + NLAYER * SZ_WIN);
constexpr size_t SZ_WUQ   = (size_t)768 * 256 * 2;
constexpr size_t WS_WUKV  = al256(WS_WUQ + NLAYER * SZ_WUQ);
constexpr size_t SZ_WUKV  = (size_t)1024 * 256 * 2;
constexpr size_t WS_WUP   = al256(WS_WUKV + NLAYER * SZ_WUKV);
constexpr size_t SZ_WUP   = (size_t)3 * 1024 * 512 * 2;
constexpr size_t WS_WOUT  = al256(WS_WUP + NLAYER * SZ_WUP);
constexpr size_t SZ_WOUT  = (size_t)1024 * 1024 * 2;
constexpr size_t WS_WGU   = al256(WS_WOUT + NLAYER * SZ_WOUT);
constexpr size_t SZ_WGU   = (size_t)32 * 2048 * 1024;
constexpr size_t WS_WDN   = al256(WS_WGU + NLAYER * SZ_WGU);
constexpr size_t SZ_WDN   = (size_t)32 * 1024 * 1024 * 2;
constexpr size_t WS_XCUR  = al256(WS_WDN + NLAYER * SZ_WDN);
constexpr size_t WS_H     = al256(WS_XCUR + (size_t)T * 1024 * 4);
constexpr size_t WS_U     = al256(WS_H + (size_t)T * 1024 * 2);
constexpr size_t WS_DTR   = al256(WS_U + (size_t)T * NIN * 2);
constexpr size_t WS_QRAW  = al256(WS_DTR + (size_t)T * 16 * 4);
constexpr size_t WS_KVRAW = al256(WS_QRAW + (size_t)T * 768 * 2);
constexpr size_t WS_QM    = al256(WS_KVRAW + (size_t)T * 1024 * 2);
constexpr size_t WS_KM    = al256(WS_QM + (size_t)8 * T * 96 * 2);
constexpr size_t WS_VMT   = al256(WS_KM + (size_t)8 * T * 96 * 2);
constexpr size_t WS_QD    = al256(WS_VMT + (size_t)8 * T * 64 * 2);
constexpr size_t WS_KD    = al256(WS_QD + (size_t)8 * T * 64 * 2);
constexpr size_t WS_VDT   = al256(WS_KD + (size_t)8 * T * 64 * 2);
constexpr size_t WS_XSN   = al256(WS_VDT + (size_t)4 * T * 128 * 2);
constexpr size_t WS_XST   = al256(WS_XSN + (size_t)T * 512 * 2);
constexpr size_t WS_BCN   = al256(WS_XST + (size_t)T * 512 * 2);
constexpr size_t WS_DTS   = al256(WS_BCN + (size_t)T * 512 * 2);
constexpr size_t WS_CUM   = al256(WS_DTS + (size_t)T * 16 * 4);
constexpr size_t WS_ST    = al256(WS_CUM + (size_t)T * 16 * 4);
constexpr size_t WS_DEC   = al256(WS_ST + (size_t)NCHUNK * 16 * 8192 * 2);
constexpr size_t WS_HIN   = al256(WS_DEC + (size_t)NCHUNK * 16 * 4);
constexpr size_t WS_YA    = al256(WS_HIN + (size_t)NCHUNK * 16 * 8192 * 2);
constexpr size_t WS_YB    = al256(WS_YA + (size_t)T * 512 * 2);
constexpr size_t WS_YC    = al256(WS_YB + (size_t)T * 512 * 2);
constexpr size_t WS_O1    = al256(WS_YC + (size_t)T * 512 * 2);
constexpr size_t WS_MRG   = al256(WS_O1 + (size_t)320 * 256 * 128 * 4);
constexpr size_t WS_TOPE  = al256(WS_MRG + (size_t)T * 1024 * 2);
constexpr size_t WS_TOPP  = al256(WS_TOPE + (size_t)T * 16);
constexpr size_t WS_TOPG  = al256(WS_TOPP + (size_t)T * 16);
constexpr size_t WS_ELIST = al256(WS_TOPG + (size_t)T * 16);
constexpr size_t WS_ACT   = al256(WS_ELIST + (size_t)32 * T * 4);
constexpr size_t WS_YMOE  = al256(WS_ACT + (size_t)MOE_ROWS * 1024 * 2);
constexpr size_t WS_XG    = al256(WS_YMOE + (size_t)MOE_ROWS * 1024 * 2);
constexpr size_t WS_XGS   = al256(WS_XG + (size_t)32 * T * 1024);
constexpr size_t WS_WGS   = al256(WS_XGS + (size_t)32 * T * 4);
constexpr size_t WS_WINS  = al256(WS_WGS + (size_t)NLAYER * 32 * 2048 * 4);
constexpr size_t WS_HS    = al256(WS_WINS + (size_t)NLAYER * NIN * 4);
constexpr size_t WS_END   = al256(WS_HS + (size_t)T * 4);

struct Params {
    const float* in[36];
    float* out;
    unsigned char* ws;
    int ph_lo, ph_hi;
};

DI int perm32(int r) { return 16 * ((r >> 2) & 1) + 4 * (r >> 3) + (r & 3); }
DI int swz128(int row, int chunk) { return row * 128 + ((chunk ^ ((row >> 1) & 7)) << 4); }

#define MFMA32(a, b, c) __builtin_amdgcn_mfma_f32_32x32x16_bf16((a), (b), (c), 0, 0, 0)

template <int NI> struct GemmAcc { f32x16 a[4][NI]; };

template <int NI, class ARow, int MI = 4>
DI void gemm_tile(char* lds, const ARow& arow, const bf16_t* __restrict__ Bt, int ldb, int K, GemmAcc<NI>& acc) {
    const int tid = opaque_tid(), lane = tid & 63, wid = tid >> 6, wr = wid >> 2, wc = wid & 3, r = lane & 31, h = lane >> 5;
    const int lrow = tid >> 3, lc = tid & 7;
    constexpr int NB = 2 * NI;
    constexpr int STG = 32768 + 16384 * NI;
    const bf16_t* ap[MI];
#pragma unroll
    for (int i = 0; i < MI; ++i) ap[i] = arow(lrow + 64 * i) + lc * 8;
    const bf16_t* bp = Bt + (size_t)lrow * ldb + lc * 8;
    const int woff = swz128(lrow, lc);
#pragma unroll
    for (int mi = 0; mi < MI; ++mi)
#pragma unroll
        for (int ni = 0; ni < NI; ++ni)
#pragma unroll
            for (int i = 0; i < 16; ++i) acc.a[mi][ni][i] = 0.f;
    u32x4 ra0[MI], rb0[NB], ra1[MI], rb1[NB];
#define GT_LOAD(RA, RB, ko) do { _Pragma("unroll") for (int i = 0; i < MI; ++i) RA[i] = *(const u32x4*)(ap[i] + (ko)); \
        _Pragma("unroll") for (int i = 0; i < NB; ++i) RB[i] = *(const u32x4*)(bp + (size_t)i * 64 * ldb + (ko)); } while (0)
#define GT_STORE(RA, RB, so) do { _Pragma("unroll") for (int i = 0; i < MI; ++i) *(u32x4*)(lds + (so) + woff + i * 8192) = RA[i]; \
        _Pragma("unroll") for (int i = 0; i < NB; ++i) *(u32x4*)(lds + (so) + 32768 + woff + i * 8192) = RB[i]; } while (0)
    const int nk = K >> 6;
    const int xsw = (r >> 1) & 7;
    const int pr = perm32(r), wsw = (pr >> 1) & 7;
    const int xbase = (wr * 32 * MI + r) * 128, wbase = 32768 + (wc * 32 * NI + pr) * 128;
#define GT_COMPUTE(st) do { _Pragma("unroll") for (int ks = 0; ks < 4; ++ks) { bf16x8 wf[NI], xf[MI]; \
        _Pragma("unroll") for (int ni = 0; ni < NI; ++ni) wf[ni] = *(const bf16x8*)(lds + (st) + wbase + ni * 4096 + (((2 * ks + h) ^ wsw) << 4)); \
        _Pragma("unroll") for (int mi = 0; mi < MI; ++mi) xf[mi] = *(const bf16x8*)(lds + (st) + xbase + mi * 4096 + (((2 * ks + h) ^ xsw) << 4)); \
        _Pragma("unroll") for (int mi = 0; mi < MI; ++mi) _Pragma("unroll") for (int ni = 0; ni < NI; ++ni) acc.a[mi][ni] = MFMA32(wf[ni], xf[mi], acc.a[mi][ni]); } } while (0)
    GT_LOAD(ra0, rb0, 0);
    GT_STORE(ra0, rb0, 0);
    GT_LOAD(ra1, rb1, 64);
    __syncthreads();
    for (int kt = 0; kt < nk; kt += 2) {
        if (kt + 2 < nk) GT_LOAD(ra0, rb0, (kt + 2) * 64);
        GT_COMPUTE(0);
        GT_STORE(ra1, rb1, STG);
        __syncthreads();
        if (kt + 3 < nk) GT_LOAD(ra1, rb1, (kt + 3) * 64);
        GT_COMPUTE(STG);
        if (kt + 2 < nk) GT_STORE(ra0, rb0, 0);
        __syncthreads();
    }
#undef GT_LOAD
#undef GT_STORE
#undef GT_COMPUTE
}

struct ARowPlain { const bf16_t* base; size_t ld; DI const bf16_t* operator()(int row) const { return base + (size_t)row * ld; } };
struct ARowGather { const bf16_t* base; const int* idx; DI const bf16_t* operator()(int row) const { return base + (size_t)idx[row] * 1024; } };

DI void st_bf16x16(bf16_t* p, const float* v) {
    u32x4 a, b;
    a.x = pk2(v[0], v[1]); a.y = pk2(v[2], v[3]); a.z = pk2(v[4], v[5]); a.w = pk2(v[6], v[7]);
    b.x = pk2(v[8], v[9]); b.y = pk2(v[10], v[11]); b.z = pk2(v[12], v[13]); b.w = pk2(v[14], v[15]);
    *(u32x4*)p = a; *(u32x4*)(p + 8) = b;
}

namespace g8 {
constexpr int BK = 64, HALF = 128, HTB = HALF * BK * 2, STAGE_BYTES = 8 * HTB;
DI int lds_byte(int r, int c) { const int st = (r >> 4) * 2 + (c >> 5), rr = r & 15, cc = c & 31, ob = rr * 64 + cc * 2; return st * 1024 + (ob ^ (((ob >> 9) & 1) << 5)); }
DI void stage_rc(int b, int& R, int& C) { const int st = b / 1024, sb = b % 1024, swz = sb ^ (((sb >> 9) & 1) << 5); R = (st >> 1) * 16 + swz / 64; C = (st & 1) * 32 + (swz % 64) / 2; }
DI int perm32g(int rho) { const int n = rho >> 4, i = rho & 15; return 8 * (i >> 2) + 4 * n + (i & 3); }
struct Unit { const char* a; const char* b; int t0, t1; };
typedef f32x4 Acc[2][2][4][2];
typedef i32x4 AccI[2][2][4][2];
template <bool I8> struct AccSel { typedef f32x4 T; };
template <> struct AccSel<true> { typedef i32x4 T; };

template <bool PERM, bool I8 = false, class Sched, class Epi>
DI void gemm_phase(LAS unsigned char* lds, const int K, const int lda, const Sched& S, const Epi& E) {
    typedef typename AccSel<I8>::T AT_;
    const int tid = opaque_tid(), wid = __builtin_amdgcn_readfirstlane(tid >> 6), lane = tid & 63, wr = wid >> 2, wc = wid & 3, fr = lane & 15, fq = lane >> 4;
    const int nt = K / BK;
    unsigned voffA[2], voffB[2];
#pragma unroll
    for (int i = 0; i < 2; ++i) { int R, C; stage_rc(tid * 16 + i * 8192, R, C); const int Rb = PERM ? ((R & ~31) + perm32g(R & 31)) : R;
        voffA[i] = (unsigned)(R * lda + C) * 2u; voffB[i] = (unsigned)(Rb * K + C) * 2u; }
    const size_t kstep = (size_t)(BK * 2);
    const size_t hstepA = (size_t)HALF * lda * 2, hstepB = (size_t)HALF * K * 2;
    const unsigned ldsw = (unsigned)wid * 1024u;
    const int aoff = lds_byte(wr * 64 + fr, fq * 8), boff = lds_byte(wc * 32 + fr, fq * 8);
#define G8_SA(b, h) (((b) * 2 + (h)) * HTB)
#define G8_SB(b, h) ((4 + (b) * 2 + (h)) * HTB)
#define G8_STAGE(bufoff, gbase, voff) do { _Pragma("unroll") for (int _i = 0; _i < 2; ++_i) \
        __builtin_amdgcn_global_load_lds((const unsigned*)((const char*)(gbase) + (voff)[_i]), (LAS unsigned*)(lds + (bufoff) + ldsw + _i * 8192), 16, 0, 0); } while (0)
#define G8_LDA(dst, b, h) do { _Pragma("unroll") for (int m = 0; m < 4; ++m) _Pragma("unroll") for (int k = 0; k < 2; ++k) dst[m][k] = *(const LAS bf16x8*)(lds + G8_SA(b, h) + aoff + m * 2048 + k * 1024); } while (0)
#define G8_LDB(dst, b, h) do { _Pragma("unroll") for (int n = 0; n < 2; ++n) _Pragma("unroll") for (int k = 0; k < 2; ++k) dst[n][k] = *(const LAS bf16x8*)(lds + G8_SB(b, h) + boff + n * 2048 + k * 1024); } while (0)
#define G8_MMA(ai, bj, At, Bt) do { __builtin_amdgcn_s_setprio(1); _Pragma("unroll") for (int m = 0; m < 4; ++m) _Pragma("unroll") for (int n = 0; n < 2; ++n) _Pragma("unroll") for (int k = 0; k < 2; ++k) \
        { if constexpr (I8) acc[ai][bj][m][n] = __builtin_amdgcn_mfma_i32_16x16x64_i8(__builtin_bit_cast(i32x4, Bt[n][k]), __builtin_bit_cast(i32x4, At[m][k]), acc[ai][bj][m][n], 0, 0, 0); \
          else acc[ai][bj][m][n] = __builtin_amdgcn_mfma_f32_16x16x32_bf16(Bt[n][k], At[m][k], acc[ai][bj][m][n], 0, 0, 0); } __builtin_amdgcn_s_setprio(0); } while (0)
#define G8_WAIT_V(n) asm volatile("s_waitcnt vmcnt(" #n ")" ::: "memory")
#define G8_WAIT_L(n) asm volatile("s_waitcnt lgkmcnt(" #n ")" ::: "memory")
#define G8_BAR __builtin_amdgcn_s_barrier()
#define G8_SCHED __builtin_amdgcn_sched_barrier(0)
    Unit cur, nxt; int ui = 0;
    if (!S.next(0, cur)) return;
    AT_ acc[2][2][4][2];
#pragma unroll
    for (int a = 0; a < 2; ++a)
#pragma unroll
        for (int b = 0; b < 2; ++b)
#pragma unroll
            for (int m = 0; m < 4; ++m)
#pragma unroll
                for (int n = 0; n < 2; ++n) acc[a][b][m][n] = AT_{};
    bf16x8 At[4][2], B0[2][2], B1[2][2];
    const char* cA = cur.a; const char* cB = cur.b;
    G8_STAGE(G8_SB(0, 0), cB, voffB); G8_STAGE(G8_SA(0, 0), cA, voffA); G8_STAGE(G8_SB(0, 1), cB + hstepB, voffB); G8_STAGE(G8_SA(0, 1), cA + hstepA, voffA);
    if (wr == 1) G8_BAR;
    G8_WAIT_V(4); G8_BAR;
    G8_STAGE(G8_SB(1, 0), cB + kstep, voffB); G8_STAGE(G8_SA(1, 0), cA + kstep, voffA); G8_STAGE(G8_SB(1, 1), cB + hstepB + kstep, voffB);
    G8_WAIT_V(6); G8_BAR;
    for (;;) {
        const bool has_next = S.next(ui + 1, nxt);
        const char* nA = has_next ? nxt.a : cA; const char* nB = has_next ? nxt.b : cB;
        for (int t = 0; t < nt; t += 2) {
            const bool last = (t == nt - 2);
            const char* a1 = cA + (size_t)(t + 1) * kstep;
            const char* a2 = last ? nA : cA + (size_t)(t + 2) * kstep; const char* b2 = last ? nB : cB + (size_t)(t + 2) * kstep;
            const char* a3 = a2 + kstep; const char* b3 = b2 + kstep;
            G8_LDB(B0, 0, 0); G8_SCHED; G8_LDA(At, 0, 0); G8_STAGE(G8_SA(1, 1), a1 + hstepA, voffA);
            G8_WAIT_L(8); G8_BAR; G8_WAIT_L(0); G8_MMA(0, 0, At, B0); G8_BAR; G8_SCHED;
            G8_LDB(B1, 0, 1); G8_STAGE(G8_SB(0, 0), b2, voffB);
            G8_BAR; G8_WAIT_L(0); G8_MMA(0, 1, At, B1); G8_BAR;
            G8_LDA(At, 0, 1); G8_STAGE(G8_SA(0, 0), a2, voffA);
            G8_BAR; G8_WAIT_L(0); G8_MMA(1, 0, At, B0); G8_BAR; G8_SCHED;
            G8_STAGE(G8_SB(0, 1), b2 + hstepB, voffB);
            G8_WAIT_V(6); G8_BAR; G8_MMA(1, 1, At, B1); G8_BAR;
            G8_LDB(B0, 1, 0); G8_SCHED; G8_LDA(At, 1, 0); G8_STAGE(G8_SA(0, 1), a2 + hstepA, voffA);
            G8_WAIT_L(8); G8_BAR; G8_WAIT_L(0); G8_MMA(0, 0, At, B0); G8_BAR; G8_SCHED;
            G8_LDB(B1, 1, 1); G8_STAGE(G8_SB(1, 0), b3, voffB);
            G8_BAR; G8_WAIT_L(0); G8_MMA(0, 1, At, B1); G8_BAR;
            G8_LDA(At, 1, 1); G8_STAGE(G8_SA(1, 0), a3, voffA);
            G8_BAR; G8_WAIT_L(0); G8_MMA(1, 0, At, B0); G8_BAR; G8_SCHED;
            G8_STAGE(G8_SB(1, 1), b3 + hstepB, voffB);
            G8_WAIT_V(6); G8_BAR; G8_MMA(1, 1, At, B1); G8_BAR;
        }
        E(acc, cur, wr, wc, fr, fq);
        if (!has_next) break;
#pragma unroll
        for (int a = 0; a < 2; ++a)
#pragma unroll
            for (int b = 0; b < 2; ++b)
#pragma unroll
                for (int m = 0; m < 4; ++m)
#pragma unroll
                    for (int n = 0; n < 2; ++n) acc[a][b][m][n] = AT_{};
        cur = nxt; cA = nA; cB = nB; ++ui;
    }
    G8_WAIT_V(0);
    if (wr == 0) G8_BAR;
    G8_BAR;
#undef G8_SA
#undef G8_SB
#undef G8_STAGE
#undef G8_LDA
#undef G8_LDB
#undef G8_MMA
#undef G8_WAIT_V
#undef G8_WAIT_L
#undef G8_BAR
#undef G8_SCHED
}

template <int nM, int nN>
struct GridSched {
    const char* A; const char* Bt; size_t astep, bstep; int c; int gs;
    DI void init(const void* A_, size_t lda, const void* Bt_, int K) { A = (const char*)A_; Bt = (const char*)Bt_; astep = 256 * lda * 2; bstep = (size_t)256 * K * 2; c = blockIdx.x; asm volatile("" : "+s"(c)); gs = GRID; }
    DI bool next(int i, Unit& u) const {
        constexpr int nwg = nM * nN;
        const int L = i * gs + c; if (L >= nwg) return false;
        int wgid = L; { constexpr int q = nwg / 8, r = nwg % 8; const int xcd = wgid % 8, off = wgid / 8; wgid = (xcd < r ? xcd * (q + 1) : r * (q + 1) + (xcd - r) * q) + off; }
        constexpr int nig = 8 * nN; const int gid = wgid / nig, fm = gid * 8, gsz = (nM - fm) < 8 ? (nM - fm) : 8;
        const int rem = wgid % nig;
        static_assert((nM % 8) == 0 || (nM % 8) == 1 || (nM % 8) == 2 || (nM % 8) == 4, "partial row-tile group must be a power of two");
        const int sh = __builtin_ctz(gsz);
        const int pm = fm + (rem & (gsz - 1)), pn = rem >> sh;
        u.a = A + (size_t)pm * astep; u.b = Bt + (size_t)pn * bstep; u.t0 = pm; u.t1 = pn; return true;
    }
};
}

template <int DK, int DV>
DI void attn_core(char* lds, const bf16_t* __restrict__ Qrows  , const unsigned char* __restrict__ Kt, const unsigned char* __restrict__ Vt,
                  int kt0, int kt1, float shift, f32x16 (&o)[DV / 32], float& lsum_out) {
    constexpr int KCH = DK / 16;
    constexpr int KROWB = (DK == 96) ? 128 : 64;
    constexpr int KSTG = 64 * KROWB, VSTG = DV * 64;
    constexpr int VBASE = 8 * KSTG;
    constexpr int NKP = KSTG / 1024, NVP = VSTG / 1024;
    constexpr int KTILEB = 64 * DK, VTILEB = DV * 64;
    const int tid = opaque_tid(), lane = tid & 63, r = lane & 31, h = lane >> 5;
    const int wid = __builtin_amdgcn_readfirstlane(tid >> 6);
    i32x8 qf8[(DK + 63) / 64];
    {
        const bf16_t* qp = Qrows + (size_t)r * DK;
#pragma unroll
        for (int st = 0; st < (DK + 63) / 64; ++st) {
            const int e0 = (st == 0) ? 32 * h : 64;
            unsigned d[8];
#pragma unroll
            for (int j = 0; j < 4; ++j) { const u32x4 w = *(const u32x4*)(qp + e0 + 8 * j);
                d[2 * j] = pk_fp8x4(bflo(w.x) * 8.0f, bfhi(w.x) * 8.0f, bflo(w.y) * 8.0f, bfhi(w.y) * 8.0f);
                d[2 * j + 1] = pk_fp8x4(bflo(w.z) * 8.0f, bfhi(w.z) * 8.0f, bflo(w.w) * 8.0f, bfhi(w.w) * 8.0f); }
            if (st == 1 && h == 1) {
#pragma unroll
                for (int j = 0; j < 8; ++j) d[j] = 0u;
            }
            qf8[st] = (i32x8){(int)d[0], (int)d[1], (int)d[2], (int)d[3], (int)d[4], (int)d[5], (int)d[6], (int)d[7]};
        }
    }
#define MFMA8(a, b, c) __builtin_amdgcn_mfma_scale_f32_32x32x64_f8f6f4((a), (b), (c), 0, 0, 0, 0x7F7F7F7F, 0, 0x7C7C7C7C)
#pragma unroll
    for (int db = 0; db < DV / 32; ++db)
#pragma unroll
        for (int i = 0; i < 16; ++i) o[db][i] = 0.f;
    const f32x16 cvec = {0.f, 0.f, 0.f, 0.f, 0.f, 0.f, 0.f, 0.f, 0.f, 0.f, 0.f, 0.f, 0.f, 0.f, 0.f, 0.f};
    const int csh = __builtin_amdgcn_readfirstlane((int)ceilf(fmaxf(shift - 15.0f, 0.f)));
    const float psc = __int_as_float((127 + csh) << 23);
    const int pvs = 127 + csh;
    float lsum = 0.f;
    const char* kg = (const char*)Kt + (size_t)kt0 * KTILEB;
    const char* vg = (const char*)Vt + (size_t)kt0 * VTILEB;
    LAS unsigned char* l3 = (LAS unsigned char*)lds;
    const int n = kt1 - kt0;
#define AT_DMAK(slot) do { if (wid < NKP) { const int b_ = wid * 1024 + lane * 16; const int row_ = b_ / KROWB, cs_ = (b_ % KROWB) >> 4; \
        const int c_ = (DK == 96) ? (cs_ ^ ((row_ >> 1) & 7)) : (cs_ ^ ((row_ >> 2) & 3)); \
        if (c_ < KCH) __builtin_amdgcn_global_load_lds((const unsigned*)(kg + (row_ * DK + c_ * 16)), (LAS unsigned*)(l3 + (slot) * KSTG + wid * 1024), 16, 0, 0); } kg += KTILEB; } while (0)
#define AT_DMAV(slot) do { const int pv_ = wid - (8 - NVP); if (pv_ >= 0) { const int b_ = pv_ * 1024 + lane * 16; const int row_ = b_ >> 6, cs_ = (b_ & 63) >> 4; const int c_ = cs_ ^ ((row_ >> 2) & 3) ^ ((row_ >> 4) & 1); \
        __builtin_amdgcn_global_load_lds((const unsigned*)(vg + (row_ * 64 + c_ * 16)), (LAS unsigned*)(l3 + VBASE + (slot) * VSTG + pv_ * 1024), 16, 0, 0); } vg += VTILEB; } while (0)
    const int pr = perm32(r), vsw = ((pr >> 2) & 3) ^ ((pr >> 4) & 1);
    const int onev = (((lane & 15) == 0 && ((lane >> 4) & 1) == 0) || ((lane & 15) == 1 && ((lane >> 4) & 1) == 1)) ? 0x38383838 : 0;
    f32x4 ol = {0.f, 0.f, 0.f, 0.f};
#define MFMA8S(b, c) __builtin_amdgcn_mfma_scale_f32_16x16x128_f8f6f4(((i32x8){onev, onev, onev, onev, onev, onev, onev, onev}), (b), (c), 0, 1, 0, 0x7F7F7F7F, 0, pvs)
    const int ksw = (DK == 96) ? ((r >> 1) & 7) : ((r >> 2) & 3);
#define MFMA8V(a, b, c) __builtin_amdgcn_mfma_scale_f32_32x32x64_f8f6f4((a), (b), (c), 0, 1, 0, 0x7F7F7F7F, 0, pvs)
#define AT_LD32(dst, rowp, c0, sw) do { const u32x4 a0_ = *(const u32x4*)((rowp) + ((((c0)) ^ (sw)) << 4)), a1_ = *(const u32x4*)((rowp) + ((((c0) + 1) ^ (sw)) << 4)); \
        dst = (i32x8){(int)a0_.x, (int)a0_.y, (int)a0_.z, (int)a0_.w, (int)a1_.x, (int)a1_.y, (int)a1_.z, (int)a1_.w}; } while (0)
#define AT_KROW(slot, kb) (lds + (slot) * KSTG + ((kb) * 32 + r) * KROWB)
#define AT_VROW(slot, db) (lds + VBASE + (slot) * VSTG + ((db) * 32 + pr) * 64)
#define AT_EXP(S, kb, a, b) do { _Pragma("unroll") for (int i_ = (a); i_ < (b); ++i_) S[kb][i_] = fexp2(S[kb][i_]); } while (0)
#define AT_ADD(S, kb, a, b) do { _Pragma("unroll") for (int i_ = (a); i_ < (b); ++i_) lsum += S[kb][i_]; } while (0)
#define AT_CVT(S, kb, d) do { _Pragma("unroll") for (int q_ = 0; q_ < 4; ++q_) d[4 * (kb) + q_] = pk_bf8x4s(S[kb][4 * q_], S[kb][4 * q_ + 1], S[kb][4 * q_ + 2], S[kb][4 * q_ + 3], psc); } while (0)
#define AT_SB __builtin_amdgcn_sched_barrier(0)
#define AT_QK(S, slot) do { _Pragma("unroll") for (int kb = 0; kb < 2; ++kb) { i32x8 kf; AT_LD32(kf, AT_KROW(slot, kb), 2 * h, ksw); S[kb] = MFMA8(kf, qf8[0], cvec); \
        if (DK == 96) { AT_LD32(kf, AT_KROW(slot, kb), 4, ksw); S[kb] = MFMA8(kf, qf8[(DK + 63) / 64 - 1], S[kb]); } } } while (0)
    i32x8 kc0, kc1;
#define AT_STEP(S, SN, ks, vs, PRE, NXT) do { unsigned d_[8]; \
        if (DK == 96) { i32x8 k1_, k3_, v0_, v1_; \
            if (!(PRE)) { AT_LD32(kc0, AT_KROW(ks, 0), 2 * h, ksw); AT_LD32(kc1, AT_KROW(ks, 1), 2 * h, ksw); } AT_SB; \
            SN[0] = MFMA8(kc0, qf8[0], cvec); AT_LD32(k1_, AT_KROW(ks, 0), 4, ksw); AT_EXP(S, 0, 0, 8); AT_SB; \
            SN[1] = MFMA8(kc1, qf8[0], cvec); AT_LD32(k3_, AT_KROW(ks, 1), 4, ksw); AT_EXP(S, 0, 8, 16); AT_SB; \
            SN[0] = MFMA8(k1_, qf8[(DK + 63) / 64 - 1], SN[0]); AT_LD32(v0_, AT_VROW(vs, 0), 2 * h, vsw); AT_EXP(S, 1, 0, 8); AT_SB; \
            SN[1] = MFMA8(k3_, qf8[(DK + 63) / 64 - 1], SN[1]); AT_LD32(v1_, AT_VROW(vs, 1), 2 * h, vsw); AT_EXP(S, 1, 8, 16); AT_SB; \
            o[0] = MFMA8V(v0_, pf8, o[0]); if (NXT) AT_LD32(kc0, AT_KROW(((ks) + 1) & 7, 0), 2 * h, ksw); AT_CVT(S, 0, d_); AT_SB; \
            o[1] = MFMA8V(v1_, pf8, o[1]); if (NXT) AT_LD32(kc1, AT_KROW(((ks) + 1) & 7, 1), 2 * h, ksw); AT_CVT(S, 1, d_); AT_SB; \
            ol = MFMA8S(pf8, ol); AT_SB; \
        } else { i32x8 v0_, v1_, v2_, v3_; \
            AT_LD32(kc0, AT_KROW(ks, 0), 2 * h, ksw); AT_LD32(kc1, AT_KROW(ks, 1), 2 * h, ksw); AT_SB;        \
            SN[0] = MFMA8(kc0, qf8[0], cvec); AT_LD32(v0_, AT_VROW(vs, 0), 2 * h, vsw); AT_EXP(S, 0, 0, 8); AT_SB; \
            SN[1] = MFMA8(kc1, qf8[0], cvec); AT_LD32(v1_, AT_VROW(vs, 1), 2 * h, vsw); AT_EXP(S, 0, 8, 16); AT_SB; \
            o[0] = MFMA8V(v0_, pf8, o[0]); AT_LD32(v2_, AT_VROW(vs, DV / 32 - 2), 2 * h, vsw); AT_EXP(S, 1, 0, 8); AT_SB; \
            o[1] = MFMA8V(v1_, pf8, o[1]); AT_LD32(v3_, AT_VROW(vs, DV / 32 - 1), 2 * h, vsw); AT_EXP(S, 1, 8, 16); AT_SB; \
            o[DV / 32 - 2] = MFMA8V(v2_, pf8, o[DV / 32 - 2]); AT_CVT(S, 0, d_); AT_SB; \
            o[DV / 32 - 1] = MFMA8V(v3_, pf8, o[DV / 32 - 1]); AT_CVT(S, 1, d_); AT_SB; \
            ol = MFMA8S(pf8, ol); AT_SB; \
        } \
        pf8 = (i32x8){(int)d_[0], (int)d_[1], (int)d_[2], (int)d_[3], (int)d_[4], (int)d_[5], (int)d_[6], (int)d_[7]}; } while (0)
    AT_DMAK(0); AT_DMAK(1); AT_DMAK(2); AT_DMAK(3); if (n > 4) AT_DMAK(4);
    AT_DMAV(7); vg -= VTILEB; AT_DMAV(0); AT_DMAV(1); AT_DMAV(2);
    asm volatile("s_waitcnt vmcnt(0)" ::: "memory");
    __syncthreads();
    f32x16 sa[2], sb[2];
    i32x8 pf8 = {0, 0, 0, 0, 0, 0, 0, 0};
    AT_QK(sa, 0);
    __syncthreads();
    for (int p = 0; p < n; p += 8) {
        if (p + 5 < n) { AT_DMAK(5); AT_DMAK(6); AT_DMAK(7); AT_DMAK(0); }
        AT_DMAV(3); if (p + 4 < n) { AT_DMAV(4); AT_DMAV(5); AT_DMAV(6); }
        AT_STEP(sa, sb, 1, 7, 0, 1); AT_STEP(sb, sa, 2, 0, 1, 1); AT_STEP(sa, sb, 3, 1, 1, 1); AT_STEP(sb, sa, 4, 2, 1, 0);
        asm volatile("s_waitcnt vmcnt(0)" ::: "memory");
        __syncthreads();
        if (p + 4 >= n) break;
        if (p + 9 < n) { AT_DMAK(1); AT_DMAK(2); AT_DMAK(3); AT_DMAK(4); }
        AT_DMAV(7); if (p + 8 < n) { AT_DMAV(0); AT_DMAV(1); AT_DMAV(2); }
        AT_STEP(sa, sb, 5, 3, 0, 1); AT_STEP(sb, sa, 6, 4, 1, 1); AT_STEP(sa, sb, 7, 5, 1, 1); AT_STEP(sb, sa, 0, 6, 1, 0);
        asm volatile("s_waitcnt vmcnt(0)" ::: "memory");
        __syncthreads();
    }
#pragma unroll
    for (int db = 0; db < DV / 32; ++db) { i32x8 vf; AT_LD32(vf, AT_VROW((n - 1) & 7, db), 2 * h, vsw); o[db] = MFMA8V(vf, pf8, o[db]); }
    ol = MFMA8S(pf8, ol);
#undef AT_DMAK
#undef AT_DMAV
#undef AT_QK
#undef AT_STEP
#undef AT_LD32
#undef AT_KROW
#undef AT_VROW
#undef AT_EXP
#undef AT_ADD
#undef AT_CVT
#undef AT_SB
#undef MFMA8
#undef MFMA8V
#undef MFMA8S
    { const float s0 = __shfl(ol[0], lane & 15), s1 = __shfl(ol[1], lane & 15); lsum_out = ((lane & 16) ? s1 : s0) + lsum; }
}
DI int kperm8(int pos) { const int h = pos >> 5, j = pos & 31; return ((j >> 4) << 5) | (((j >> 2) & 3) << 3) | (h << 2) | (j & 3); }
DI int kperm(int k) { return (k & ~12) | ((k & 4) << 1) | ((k & 8) >> 1); }


DI int win_src_col(int n) {
    if (n < 416) return n;
    if (n < 512) return -1;
    if (n < 3600) return n - 96;
    if (n < 3840) return -1;
    return n - 336;
}
DI int wgu_src_col(int rr) {
    const int ct = rr >> 8, half = (rr >> 7) & 1, jj = rr & 127;
    return half * 1024 + ct * 128 + jj;
}
template <int MAP>
DI void xpose_unit(float* tl, const float* __restrict__ src, int ld_src, int k0, int n0, bf16_t* __restrict__ dst, int ld_dst, const float* __restrict__ kscale) {
    (void)tl;
    const int tid = opaque_tid(), lane = tid & 63, wid = tid >> 6;
    const int n4 = (wid & 3) * 32 + (lane & 7) * 4, k8 = (wid >> 2) * 64 + (lane >> 3) * 8;
    const int nn = n0 + n4;
    const int sc = (MAP == 0) ? nn : (MAP == 1 ? win_src_col(nn) : wgu_src_col(nn));
    f32x4 v[8];
#pragma unroll
    for (int j = 0; j < 8; ++j)
        v[j] = (sc >= 0) ? __builtin_nontemporal_load((const f32x4*)(src + (size_t)(k0 + k8 + j) * ld_src + sc)) : (f32x4){0.f, 0.f, 0.f, 0.f};
    if (kscale) {
        const f32x4 s0 = *(const f32x4*)(kscale + k0 + k8), s1 = *(const f32x4*)(kscale + k0 + k8 + 4);
        v[0] = v[0] * s0.x; v[1] = v[1] * s0.y; v[2] = v[2] * s0.z; v[3] = v[3] * s0.w; v[4] = v[4] * s1.x; v[5] = v[5] * s1.y; v[6] = v[6] * s1.z; v[7] = v[7] * s1.w;
    }
    bf16_t* d = dst + (size_t)(n0 + n4) * ld_dst + k0 + k8;
    { u32x4 w;
      w.x = pk2(v[0].x, v[1].x); w.y = pk2(v[2].x, v[3].x); w.z = pk2(v[4].x, v[5].x); w.w = pk2(v[6].x, v[7].x); *(u32x4*)d = w;
      w.x = pk2(v[0].y, v[1].y); w.y = pk2(v[2].y, v[3].y); w.z = pk2(v[4].y, v[5].y); w.w = pk2(v[6].y, v[7].y); *(u32x4*)(d + ld_dst) = w;
      w.x = pk2(v[0].z, v[1].z); w.y = pk2(v[2].z, v[3].z); w.z = pk2(v[4].z, v[5].z); w.w = pk2(v[6].z, v[7].z); *(u32x4*)(d + 2 * (size_t)ld_dst) = w;
      w.x = pk2(v[0].w, v[1].w); w.y = pk2(v[2].w, v[3].w); w.z = pk2(v[4].w, v[5].w); w.w = pk2(v[6].w, v[7].w); *(u32x4*)(d + 3 * (size_t)ld_dst) = w; }
}

template <int MAP, int LDS_>
DI void quant_rows_unit(char* ldsb, const float* __restrict__ src  , int nt, signed char* __restrict__ dst  , float* __restrict__ scales  ) {
    const int tid = threadIdx.x;
    const int nb = tid & 7, kb = tid >> 3;
    const int n0 = nt * 32, n4 = nb * 4;
    const int sc = (MAP == 1) ? win_src_col(n0 + n4) : wgu_src_col(n0 + n4);
    float* am = (float*)ldsb;
    f32x4 v[16];
#pragma unroll
    for (int j = 0; j < 16; ++j) v[j] = (sc >= 0) ? __builtin_nontemporal_load((const f32x4*)(src + (size_t)(kb * 16 + j) * LDS_ + sc)) : (f32x4){0.f, 0.f, 0.f, 0.f};
    f32x4 mx = {0.f, 0.f, 0.f, 0.f};
#pragma unroll
    for (int j = 0; j < 16; ++j) { mx.x = fmaxf(mx.x, fabsf(v[j].x)); mx.y = fmaxf(mx.y, fabsf(v[j].y)); mx.z = fmaxf(mx.z, fabsf(v[j].z)); mx.w = fmaxf(mx.w, fabsf(v[j].w)); }
    *(f32x4*)(am + kb * 32 + n4) = mx;
    __syncthreads();
    if (tid < 32) { float m = 0.f;
#pragma unroll
        for (int q = 0; q < 64; ++q) m = fmaxf(m, am[q * 32 + tid]);
        const float sc_ = (m > 0.f) ? m * (1.0f / 127.0f) : 1.0f;
        scales[n0 + tid] = sc_; am[2048 + tid] = 1.0f / sc_; }
    __syncthreads();
    const f32x4 inv = *(const f32x4*)(am + 2048 + n4);
    signed char* d = dst + (size_t)(n0 + n4) * 1024 + kb * 16;
    { u32x4 w;
      w.x = pack_i8x4(v[0].x * inv.x, v[1].x * inv.x, v[2].x * inv.x, v[3].x * inv.x); w.y = pack_i8x4(v[4].x * inv.x, v[5].x * inv.x, v[6].x * inv.x, v[7].x * inv.x);
      w.z = pack_i8x4(v[8].x * inv.x, v[9].x * inv.x, v[10].x * inv.x, v[11].x * inv.x); w.w = pack_i8x4(v[12].x * inv.x, v[13].x * inv.x, v[14].x * inv.x, v[15].x * inv.x);
      *(u32x4*)d = w;
      w.x = pack_i8x4(v[0].y * inv.y, v[1].y * inv.y, v[2].y * inv.y, v[3].y * inv.y); w.y = pack_i8x4(v[4].y * inv.y, v[5].y * inv.y, v[6].y * inv.y, v[7].y * inv.y);
      w.z = pack_i8x4(v[8].y * inv.y, v[9].y * inv.y, v[10].y * inv.y, v[11].y * inv.y); w.w = pack_i8x4(v[12].y * inv.y, v[13].y * inv.y, v[14].y * inv.y, v[15].y * inv.y);
      *(u32x4*)(d + 1024) = w;
      w.x = pack_i8x4(v[0].z * inv.z, v[1].z * inv.z, v[2].z * inv.z, v[3].z * inv.z); w.y = pack_i8x4(v[4].z * inv.z, v[5].z * inv.z, v[6].z * inv.z, v[7].z * inv.z);
      w.z = pack_i8x4(v[8].z * inv.z, v[9].z * inv.z, v[10].z * inv.z, v[11].z * inv.z); w.w = pack_i8x4(v[12].z * inv.z, v[13].z * inv.z, v[14].z * inv.z, v[15].z * inv.z);
      *(u32x4*)(d + 2048) = w;
      w.x = pack_i8x4(v[0].w * inv.w, v[1].w * inv.w, v[2].w * inv.w, v[3].w * inv.w); w.y = pack_i8x4(v[4].w * inv.w, v[5].w * inv.w, v[6].w * inv.w, v[7].w * inv.w);
      w.z = pack_i8x4(v[8].w * inv.w, v[9].w * inv.w, v[10].w * inv.w, v[11].w * inv.w); w.w = pack_i8x4(v[12].w * inv.w, v[13].w * inv.w, v[14].w * inv.w, v[15].w * inv.w);
      *(u32x4*)(d + 3072) = w; }
    __syncthreads();
}

constexpr int XP_WIN = NIN / 32  , XP_WUQ = 2 * 6, XP_WUKV = 2 * 8, XP_WUP = 3 * 4 * 8, XP_WOUT = 8 * 8, XP_WGU = 32 * 64  , XP_WDN = 32 * 8 * 8;
constexpr int XP_LAYER = XP_WIN + XP_WUQ + XP_WUKV + XP_WUP + XP_WOUT + XP_WGU + XP_WDN;
constexpr int N_MODU = NLAYER * 96;

constexpr int XP_WDN_MERGE = 3 * (GRID - 32);
constexpr int XP_WDN_DOWN0 = XP_WDN_MERGE + 512, XP_WDN_DOWN1 = XP_WDN_DOWN0 + 512;
constexpr int XP_WDN_ROWS0 = XP_WDN - 336;
constexpr int XP_WDN_OUTN = (XP_WDN_DOWN0 - XP_WDN_MERGE) + (XP_WDN_ROWS0 - XP_WDN_DOWN1);
DI void wdn_units(const Params& P, int l, int u0, int u1, int rk, int nb) {
    unsigned char* ws = P.ws;
    for (int rr = u0 + rk; rr < u1; rr += nb) { const int e = rr / 64, q = rr % 64, kt = q & 7, nt = q >> 3;
        xpose_unit<0>(nullptr, P.in[34] + ((size_t)l * 32 + e) * 1024 * 1024, 1024, kt * 128, nt * 128, (bf16_t*)(ws + WS_WDN + l * SZ_WDN) + (size_t)e * 1024 * 1024, 1024, nullptr); }
}
DI void phase_prologue(const Params& P, char* lds) {
    float* tl = (float*)lds;
    unsigned char* ws = P.ws;
    const int G = GRID, b = blockIdx.x, tid = threadIdx.x;
    for (int u = b; u < NLAYER * XP_LAYER; u += G) {
        const int l = NLAYER - 1 - u / XP_LAYER; int rr = u % XP_LAYER;
        if (rr < XP_WIN) { quant_rows_unit<1, 6576>(lds, P.in[8] + (size_t)l * 1024 * 6576, rr, (signed char*)(ws + WS_WIN + l * SZ_WIN), (float*)(ws + WS_WINS) + (size_t)l * NIN); continue; }
        rr -= XP_WIN;
        if (rr < XP_WUQ) { const int kt = rr & 1, nt = rr >> 1;
            xpose_unit<0>(tl, P.in[11] + (size_t)l * 256 * 768, 768, kt * 128, nt * 128, (bf16_t*)(ws + WS_WUQ + l * SZ_WUQ), 256, P.in[10] + l * 256); continue; }
        rr -= XP_WUQ;
        if (rr < XP_WUKV) { const int kt = rr & 1, nt = rr >> 1;
            if (kt == 0) xpose_unit<0>(tl, P.in[13] + (size_t)l * 128 * 1024, 1024, 0, nt * 128, (bf16_t*)(ws + WS_WUKV + l * SZ_WUKV), 256, P.in[12] + l * 128);
            else { bf16_t* d = (bf16_t*)(ws + WS_WUKV + l * SZ_WUKV) + (size_t)(nt * 128 + (tid >> 2)) * 256 + 128 + (tid & 3) * 32;
#pragma unroll
                for (int q = 0; q < 4; ++q) *(u32x4*)(d + 8 * q) = (u32x4){0u, 0u, 0u, 0u}; }
            continue; }
        rr -= XP_WUKV;
        if (rr < XP_WUP) { const int br = rr / 32, q = rr % 32, kt = q & 3, nt = q >> 2;
            xpose_unit<0>(tl, P.in[26 + br] + (size_t)l * 512 * 1024, 1024, kt * 128, nt * 128, (bf16_t*)(ws + WS_WUP + l * SZ_WUP) + (size_t)br * 1024 * 512, 512, nullptr); continue; }
        rr -= XP_WUP;
        if (rr < XP_WOUT) { const int kt = rr & 7, nt = rr >> 3;
            xpose_unit<0>(tl, P.in[29] + (size_t)l * 1024 * 1024, 1024, kt * 128, nt * 128, (bf16_t*)(ws + WS_WOUT + l * SZ_WOUT), 1024, nullptr); continue; }
        rr -= XP_WOUT;
        if (rr < XP_WGU) { const int e = rr >> 6, nt = rr & 63;
            quant_rows_unit<2, 2048>(lds, P.in[32] + ((size_t)l * 32 + e) * 1024 * 2048, nt, (signed char*)(ws + WS_WGU + l * SZ_WGU) + (size_t)e * 2048 * 1024, (float*)(ws + WS_WGS) + ((size_t)l * 32 + e) * 2048); continue; }
        rr -= XP_WGU;
        if (l == 0) { const int e = rr / 64, q = rr % 64, kt = q & 7, nt = q >> 3;
            xpose_unit<0>(tl, P.in[34] + ((size_t)l * 32 + e) * 1024 * 1024, 1024, kt * 128, nt * 128, (bf16_t*)(ws + WS_WDN + l * SZ_WDN) + (size_t)e * 1024 * 1024, 1024, nullptr); }
    }
    __syncthreads();
    {
        float* sv = (float*)lds;
        float* red = sv + 2048;
        for (int i = tid; i < 2048; i += NTHR) { const float x = (i < 1024) ? P.in[1][i] : P.in[3][i - 1024]; sv[i] = siluf_(x); }
        __syncthreads();
        float* MOD = (float*)(ws + WS_MOD);
        for (int u = b; u < N_MODU; u += G) {
            const int l = u / 96, cg = u % 96, col = cg * 64 + (tid & 63), kp = tid >> 6;
            const float* w = P.in[4] + (size_t)l * 1024 * 6144 + col;
            float a0 = 0.f, a1 = 0.f;
#pragma unroll 16
            for (int k = kp * 128; k < kp * 128 + 128; ++k) { const float wv = w[(size_t)k * 6144]; a0 += sv[k] * wv; a1 += sv[1024 + k] * wv; }
            red[(kp * 64 + (tid & 63)) * 2 + 0] = a0; red[(kp * 64 + (tid & 63)) * 2 + 1] = a1;
            __syncthreads();
            if (tid < 128) { const int c = tid & 63, wsel = tid >> 6; float s = 0.f;
#pragma unroll
                for (int q = 0; q < 8; ++q) s += red[(q * 64 + c) * 2 + wsel];
                MOD[((size_t)l * 2 + wsel) * 6144 + cg * 64 + c] = s + P.in[5][(size_t)l * 6144 + cg * 64 + c]; }
            __syncthreads();
        }
    }
    if (b == G - 1) {
        float* TAB = (float*)(ws + WS_TAB);
        for (int i = tid; i < 320 * 8; i += NTHR) { const int pos = i >> 3, f = i & 7; const float p = (float)(pos < 256 ? pos : pos - 256);
            const float inv = exp2f(-((float)(2 * f) / 16.0f) * 13.287712379549449f); const float ang = p * inv;
            TAB[i] = cosf(ang); TAB[320 * 8 + i] = sinf(ang); }
        for (int i = tid; i < 320 * 16; i += NTHR) { const int pos = i >> 4, f = i & 15; const float p = (float)(pos < 256 ? pos : pos - 256);
            const float inv = exp2f(-((float)(2 * f) / 32.0f) * 13.287712379549449f); const float ang = p * inv;
            TAB[320 * 16 + i] = cosf(ang); TAB[320 * 16 + 320 * 16 + i] = sinf(ang); }
    }
    if (b == G - 2 && tid < NLAYER) {
        const int l = tid;
        float gq = 0.f, gk = 0.f, dq = 0.f, dk = 0.f;
        for (int i = 0; i < 96; ++i) { gq = fmaxf(gq, fabsf(P.in[14][l * 96 + i])); gk = fmaxf(gk, fabsf(P.in[15][l * 96 + i])); }
        for (int i = 0; i < 64; ++i) { dq = fmaxf(dq, fabsf(P.in[16][l * 64 + i])); dk = fmaxf(dk, fabsf(P.in[17][l * 64 + i])); }
        const float* lp = P.in[18] + l * 256;
        float s1 = 0.f, s2 = 0.f;
        for (int i = 0; i < 64; ++i) { s1 += lp[i] * lp[64 + i]; s2 += lp[128 + i] * lp[192 + i]; }
        float* ac_ = (float*)((int*)(ws + WS_CTL) + l * 32 * ECS + 40);
        ac_[0] = 9.797958971132712f * gq * gk * LOG2E * 1.02f;
        ac_[1] = 8.0f * dq * dk * LOG2E * 1.02f;
        ac_[2] = __expf(s1) - __expf(s2);
    }
    if (b < NLAYER) {
        float* WRT = (float*)(ws + WS_WRT) + (size_t)b * 32 * 1024;
        const float* src = P.in[30] + (size_t)b * 1024 * 32;
        for (int i = tid; i < 32 * 1024; i += NTHR) { const int k = i >> 5, e = i & 31; WRT[e * 1024 + k] = src[i]; }
    }
}

DI void phase_rows_norm1(const Params& P, int lprev  , int nl  ) {
    unsigned char* ws = P.ws;
    const int G = GRID, tid = opaque_tid(), lane = tid & 63, wid = tid >> 6;
    bf16_t* XCUR = (bf16_t*)(ws + WS_XCUR);
    signed char* H = (signed char*)(ws + WS_H); float* HS = (float*)(ws + WS_HS);
    const float* MOD = (const float*)(ws + WS_MOD);
    const int* ctl = (const int*)(ws + WS_CTL);
    int offs_lane = 0;
    if (lprev >= 0) {
        const int c = (lane < 32) ? ctl[(lprev * 32 + lane) * ECS] : 0;
        const int nb = (c + 255) >> 8;
        int incl = nb;
#pragma unroll
        for (int d = 1; d < 32; d <<= 1) { const int t = __shfl_up(incl, d); if ((lane & 31) >= d) incl += t; }
        offs_lane = (incl - nb) * 256;
    }
    f32x4 Lg1[4], Lsc[4], Lsh[4], Lgt2[4];
#pragma unroll
    for (int j = 0; j < 4; ++j) { const int e = 256 * j + 4 * lane;
        if (nl < NLAYER) { Lg1[j] = *(const f32x4*)(P.in[6] + (size_t)nl * 1024 + e); Lsh[j] = *(const f32x4*)(MOD + ((size_t)nl * 2) * 6144 + e); Lsc[j] = *(const f32x4*)(MOD + ((size_t)nl * 2) * 6144 + 1024 + e); }
        else { Lg1[j] = Lsh[j] = Lsc[j] = (f32x4){0.f, 0.f, 0.f, 0.f}; }
        if (lprev >= 0) Lgt2[j] = *(const f32x4*)(MOD + ((size_t)lprev * 2) * 6144 + 5 * 1024 + e); else Lgt2[j] = (f32x4){0.f, 0.f, 0.f, 0.f}; }
    for (int tb = blockIdx.x * 8 + wid; tb < T; tb += G * 16) {
        int tt[2]; bool ok[2]; int isc[2];
        f32x4 x[2][4];
        int te[2][4], tp[2][4]; float tg[2][4];
#pragma unroll
        for (int q = 0; q < 2; ++q) {
            tt[q] = tb + q * G * 8; ok[q] = tt[q] < T; const int t = ok[q] ? tt[q] : tb; isc[q] = t >= SEQ;
            if (lprev < 0) {
                const float* src = isc[q] ? (P.in[2] + (size_t)(t - SEQ) * 1024) : (P.in[0] + (size_t)t * 1024);
#pragma unroll
                for (int j = 0; j < 4; ++j) x[q][j] = *(const f32x4*)(src + 256 * j + 4 * lane);
            } else {
#pragma unroll
                for (int j = 0; j < 4; ++j) { const u32x2 w = *(const u32x2*)(XCUR + (size_t)t * 1024 + 256 * j + 4 * lane); x[q][j] = (f32x4){bflo(w.x), bfhi(w.x), bflo(w.y), bfhi(w.y)}; }
            }
            if (lprev >= 0) {
                const int* tope = (const int*)(ws + WS_TOPE) + (size_t)t * 4; const int* topp = (const int*)(ws + WS_TOPP) + (size_t)t * 4; const float* topg = (const float*)(ws + WS_TOPG) + (size_t)t * 4;
#pragma unroll
                for (int k = 0; k < 4; ++k) { te[q][k] = tope[k]; tp[q][k] = topp[k]; tg[q][k] = topg[k]; }
            }
        }
        if (lprev >= 0) {
            const bf16_t* Y = (const bf16_t*)(ws + WS_YMOE);
            u32x2 yw[2][4][4];
#pragma unroll
            for (int q = 0; q < 2; ++q)
#pragma unroll
                for (int k = 0; k < 4; ++k) { const int row = __shfl(offs_lane, te[q][k]) + tp[q][k]; const bf16_t* yr = Y + (size_t)row * 1024;
#pragma unroll
                    for (int j = 0; j < 4; ++j) yw[q][k][j] = *(const u32x2*)(yr + 256 * j + 4 * lane); }
#pragma unroll
            for (int q = 0; q < 2; ++q) {
                const float* gt2 = MOD + ((size_t)lprev * 2 + isc[q]) * 6144 + 5 * 1024;
#pragma unroll
                for (int j = 0; j < 4; ++j) { f32x4 y = {0.f, 0.f, 0.f, 0.f};
#pragma unroll
                    for (int k = 0; k < 4; ++k) { const u32x2 w = yw[q][k][j]; const float g = tg[q][k]; y.x += g * bflo(w.x); y.y += g * bfhi(w.x); y.z += g * bflo(w.y); y.w += g * bfhi(w.y); }
                    const f32x4 gg = isc[q] ? *(const f32x4*)(gt2 + 256 * j + 4 * lane) : Lgt2[j]; x[q][j] = x[q][j] + gg * y; }
            }
        }
#pragma unroll
        for (int q = 0; q < 2; ++q) {
            if (!ok[q]) continue;
            const int t = tt[q];
            if (nl < NLAYER) {
#pragma unroll
                for (int j = 0; j < 4; ++j) { u32x2 w; w.x = pk2(x[q][j].x, x[q][j].y); w.y = pk2(x[q][j].z, x[q][j].w); *(u32x2*)(XCUR + (size_t)t * 1024 + 256 * j + 4 * lane) = w; }
                float ss = 0.f;
#pragma unroll
                for (int j = 0; j < 4; ++j) ss += x[q][j].x * x[q][j].x + x[q][j].y * x[q][j].y + x[q][j].z * x[q][j].z + x[q][j].w * x[q][j].w;
                ss = wave_sum(ss);
                const float rstd = rsqrtf(ss * (1.0f / 1024.0f) + EPS);
                const float* sh = MOD + ((size_t)nl * 2 + isc[q]) * 6144;
                const float* sc = sh + 1024;
                f32x4 hv[4]; float am = 0.f;
#pragma unroll
                for (int j = 0; j < 4; ++j) {
                    const int e = 256 * j + 4 * lane;
                    const f32x4 gg = Lg1[j], s1 = isc[q] ? *(const f32x4*)(sc + e) : Lsc[j], b1 = isc[q] ? *(const f32x4*)(sh + e) : Lsh[j];
                    hv[j] = (x[q][j] * rstd) * gg * (s1 + 1.0f) + b1;
                    am = fmaxf(am, fmaxf(fmaxf(fabsf(hv[j].x), fabsf(hv[j].y)), fmaxf(fabsf(hv[j].z), fabsf(hv[j].w))));
                }
                am = wave_max(am);
                const float qs = (am > 0.f) ? am * (1.0f / 127.0f) : 1.0f, qi = 1.0f / qs;
#pragma unroll
                for (int j = 0; j < 4; ++j) *(unsigned*)(H + (size_t)t * 1024 + 256 * j + 4 * lane) = pack_i8x4(hv[j].x * qi, hv[j].y * qi, hv[j].z * qi, hv[j].w * qi);
                if (lane == 0) HS[t] = qs;
            } else if (!isc[q]) {
#pragma unroll
                for (int j = 0; j < 4; ++j) *(f32x4*)(P.out + (size_t)t * 1024 + 256 * j + 4 * lane) = x[q][j];
            }
        }
    }
    if (lprev >= 0 && nl < NLAYER && blockIdx.x >= 32) wdn_units(P, nl, XP_WDN_ROWS0, XP_WDN, (int)blockIdx.x - 32, GRID - 32);
}

DI void phase_router(const Params& P, int l, char* lds) {
    unsigned char* ws = P.ws;
    const bf16_t* XCUR = (const bf16_t*)(ws + WS_XCUR);
    const float* MOD = (const float*)(ws + WS_MOD);
    const float* WRT = (const float*)(ws + WS_WRT) + (size_t)l * 32 * 1024;
    int* ecnt = (int*)(ws + WS_CTL) + l * 32 * ECS;
    float* fl = (float*)lds;
    float* part = fl;
    float* part2 = (float*)(lds + 135424);
    float* lgx = part2 + 512;
    int* dst = (int*)(lds + 135424 + 2048 + 1056);
    int* lcnt = dst + 33 * 4;
    int* lbase = lcnt + 32;
    const float* g2 = P.in[7] + (size_t)l * 1024;
    f32x4 Rg2[4], Rsc[4], Rsh[4];
    { const int lane_ = opaque_tid() & 63;
#pragma unroll
      for (int j = 0; j < 4; ++j) { const int e = 256 * j + 4 * lane_; Rg2[j] = *(const f32x4*)(g2 + e);
          Rsh[j] = *(const f32x4*)(MOD + ((size_t)l * 2) * 6144 + 3 * 1024 + e); Rsc[j] = *(const f32x4*)(MOD + ((size_t)l * 2) * 6144 + 4 * 1024 + e) + 1.0f; } }
    for (int i = opaque_tid(); i < 8 * 33; i += NTHR) lgx[i] = 0.f;
#pragma unroll 1
    for (int pass = 0; pass < 2; ++pass) {
        const int tbase = (int)blockIdx.x * 65;
        const int t0 = tbase + 32 * pass;
        const bool extra = pass == 0;
        const int tx = tbase + 64;
        const int tid = opaque_tid(), lane = tid & 63, wid = tid >> 6, r = lane & 31, h = lane >> 5; (void)tid;
        unsigned pq[5][4]; float rsc[5];
        {
            f32x4 x[5][4]; float ss[5];
#pragma unroll
            for (int q = 0; q < 5; ++q) { const int t = (q < 4) ? (t0 + wid * 4 + q) : tx;
#pragma unroll
                for (int j = 0; j < 4; ++j) { const u32x2 w = *(const u32x2*)(XCUR + (size_t)t * 1024 + 256 * j + 4 * lane); x[q][j] = (f32x4){bflo(w.x), bfhi(w.x), bflo(w.y), bfhi(w.y)}; } }
#pragma unroll
            for (int q = 0; q < 5; ++q) { float s = 0.f;
#pragma unroll
                for (int j = 0; j < 4; ++j) s += x[q][j].x * x[q][j].x + x[q][j].y * x[q][j].y + x[q][j].z * x[q][j].z + x[q][j].w * x[q][j].w;
                ss[q] = wave_sum(s); }
#pragma unroll
            for (int q = 0; q < 5; ++q) {
                if (q == 4 && !(extra && wid == 0)) continue;
                const int t = (q < 4) ? (t0 + wid * 4 + q) : tx, tr = (q < 4) ? (wid * 4 + q) : 32;
                const int isctx = t >= SEQ;
                const float* sh = MOD + ((size_t)l * 2 + isctx) * 6144 + 3 * 1024;
                const float* sc = sh + 1024;
                const float rstd = rsqrtf(ss[q] * (1.0f / 1024.0f) + EPS);
                f32x4 hv[4]; float am = 0.f;
#pragma unroll
                for (int j = 0; j < 4; ++j) {
                    const int e = 256 * j + 4 * lane;
                    const f32x4 gg = Rg2[j], s1 = isctx ? (*(const f32x4*)(sc + e) + 1.0f) : Rsc[j], b1 = isctx ? *(const f32x4*)(sh + e) : Rsh[j];
                    hv[j] = (x[q][j] * rstd) * gg * s1 + b1;
                    am = fmaxf(am, fmaxf(fmaxf(fabsf(hv[j].x), fabsf(hv[j].y)), fmaxf(fabsf(hv[j].z), fabsf(hv[j].w))));
                    float* d = fl + tr * 1025 + e; d[0] = hv[j].x; d[1] = hv[j].y; d[2] = hv[j].z; d[3] = hv[j].w;
                }
                am = wave_max(am);
                const float qs = (am > 0.f) ? am * (1.0f / 127.0f) : 1.0f, qi = 1.0f / qs;
                rsc[q] = qs;
#pragma unroll
                for (int j = 0; j < 4; ++j) pq[q][j] = pack_i8x4(hv[j].x * qi, hv[j].y * qi, hv[j].z * qi, hv[j].w * qi);
            }
        }
        if (tid < 32) lcnt[tid] = 0;
        __syncthreads();
        {
            f32x16 acc;
#pragma unroll
            for (int i = 0; i < 16; ++i) acc[i] = 0.f;
            const int kb = 128 * wid + 64 * h;
            const float* wrow = WRT + (size_t)r * 1024 + kb;
            const float* frow = fl + r * 1025 + kb;
            f32x4 wv[16];
#pragma unroll
            for (int c = 0; c < 16; ++c) wv[c] = *(const f32x4*)(wrow + 4 * c);
#pragma unroll
            for (int c = 0; c < 16; ++c) {
                acc = __builtin_amdgcn_mfma_f32_32x32x2f32(frow[4 * c + 0], wv[c].x, acc, 0, 0, 0);
                acc = __builtin_amdgcn_mfma_f32_32x32x2f32(frow[4 * c + 1], wv[c].y, acc, 0, 0, 0);
                acc = __builtin_amdgcn_mfma_f32_32x32x2f32(frow[4 * c + 2], wv[c].z, acc, 0, 0, 0);
                acc = __builtin_amdgcn_mfma_f32_32x32x2f32(frow[4 * c + 3], wv[c].w, acc, 0, 0, 0);
            }
            if (extra) {
                const float* fx = fl + 32 * 1025 + kb; float a = 0.f;
#pragma unroll
                for (int c = 0; c < 16; ++c) a += fx[4 * c] * wv[c].x + fx[4 * c + 1] * wv[c].y + fx[4 * c + 2] * wv[c].z + fx[4 * c + 3] * wv[c].w;
                part2[(2 * wid + h) * 32 + r] = a;
            }
            __syncthreads();
#pragma unroll
            for (int i = 0; i < 16; ++i) { const int tok = (i & 3) + 8 * (i >> 2) + 4 * h; part[(wid * 32 + tok) * 33 + r] = acc[i]; }
            if (extra && wid == 1 && lane < 32) { float a = 0.f;
#pragma unroll
                for (int w = 0; w < 16; ++w) a += part2[w * 32 + lane];
                lgx[lane] = a; }
        }
        __syncthreads();
        if (wid == 0) {
            int te[4] = {0, 0, 0, 0}; float tg[4] = {0.f, 0.f, 0.f, 0.f}; int lr[4] = {0, 0, 0, 0};
            const bool act = lane < 32 || (extra && lane == 32);
            const int t = (lane < 32) ? (t0 + lane) : tx;
            if (act) {
                float lg[32];
                const float* lsrc = (lane < 32) ? (part + lane * 33) : lgx; const int lstr = (lane < 32) ? 32 * 33 : 33;
#pragma unroll
                for (int e = 0; e < 32; ++e) { float s = P.in[31][l * 32 + e];
#pragma unroll
                    for (int w = 0; w < 8; ++w) s += lsrc[w * lstr + e];
                    lg[e] = s; }
                float tv[4];
#pragma unroll
                for (int k = 0; k < 4; ++k) {
                    float best = -3.0e38f; int bi = 0;
#pragma unroll
                    for (int e = 0; e < 32; ++e) { const bool better = lg[e] > best; best = better ? lg[e] : best; bi = better ? e : bi; }
                    te[k] = bi; tv[k] = best;
#pragma unroll
                    for (int e = 0; e < 32; ++e) lg[e] = (e == bi) ? -3.0e38f : lg[e];
                }
                float se = 0.f;
#pragma unroll
                for (int k = 0; k < 4; ++k) { tg[k] = __expf(tv[k] - tv[0]); se += tg[k]; }
                const float inv = 1.0f / se;
#pragma unroll
                for (int k = 0; k < 4; ++k) { tg[k] *= inv; lr[k] = atomicAdd(lcnt + te[k], 1); }
            }
            if (lane < 32) { const int c = lcnt[lane]; lbase[lane] = c ? atomicAdd(ecnt + lane * ECS, c) : 0; }
            if (act) {
                int* tope = (int*)(ws + WS_TOPE) + (size_t)t * 4;
                int* topp = (int*)(ws + WS_TOPP) + (size_t)t * 4;
                float* topg = (float*)(ws + WS_TOPG) + (size_t)t * 4;
#pragma unroll
                for (int k = 0; k < 4; ++k) {
                    const int pos = lbase[te[k]] + lr[k];
                    tope[k] = te[k]; topp[k] = pos; topg[k] = tg[k];
                    dst[lane * 4 + k] = te[k] * T + pos;
                }
            }
        }
        __syncthreads();
        {
            signed char* XG = (signed char*)(ws + WS_XG); float* XGS = (float*)(ws + WS_XGS);
#pragma unroll
            for (int q = 0; q < 5; ++q) { if (q == 4 && !(extra && wid == 0)) continue;
                const int tr = (q < 4) ? (wid * 4 + q) : 32;
#pragma unroll
                for (int k = 0; k < 4; ++k) { const int drow = dst[tr * 4 + k]; signed char* d = XG + (size_t)drow * 1024 + 4 * lane;
#pragma unroll
                    for (int j = 0; j < 4; ++j) *(unsigned*)(d + 256 * j) = pq[q][j];
                    if (lane == 0) XGS[drow] = rsc[q]; } }
        }
        __syncthreads();
    }
}


struct EpiIn {
    bf16_t* U; float* DTR; const float* bg; const float* hs; const float* wins;
    DI void operator()(const g8::AccI& acc, const g8::Unit& u, int wr, int wc, int fr, int fq) const {
        const bool gate = u.t1 >= (U_G / 256);
        float sa_[2][4];
#pragma unroll
        for (int ai = 0; ai < 2; ++ai)
#pragma unroll
            for (int m = 0; m < 4; ++m) sa_[ai][m] = hs[u.t0 * 256 + 128 * ai + 64 * wr + 16 * m + fr];
        __builtin_amdgcn_sched_barrier(0);
#pragma unroll
        for (int bj = 0; bj < 2; ++bj) {
            const int col = u.t1 * 256 + 128 * bj + 32 * wc + 8 * fq;
            const f32x4 w0 = *(const f32x4*)(wins + col), w1 = *(const f32x4*)(wins + col + 4);
            f32x4 b0 = {0.f, 0.f, 0.f, 0.f}, b1 = {0.f, 0.f, 0.f, 0.f};
            if (gate) { b0 = *(const f32x4*)(bg + col - U_G); b1 = *(const f32x4*)(bg + col - U_G + 4); }
#pragma unroll
            for (int ai = 0; ai < 2; ++ai)
#pragma unroll
                for (int m = 0; m < 4; ++m) {
                    const int row = u.t0 * 256 + 128 * ai + 64 * wr + 16 * m + fr;
                    const float sa = sa_[ai][m];
                    const i32x4 a0 = acc[ai][bj][m][0], a1 = acc[ai][bj][m][1];
                    f32x4 v0 = {(float)a0.x * (sa * w0.x), (float)a0.y * (sa * w0.y), (float)a0.z * (sa * w0.z), (float)a0.w * (sa * w0.w)};
                    f32x4 v1 = {(float)a1.x * (sa * w1.x), (float)a1.y * (sa * w1.y), (float)a1.z * (sa * w1.z), (float)a1.w * (sa * w1.w)};
                    if (gate) {
                        v0.x = sigmoidf_(v0.x + b0.x); v0.y = sigmoidf_(v0.y + b0.y); v0.z = sigmoidf_(v0.z + b0.z); v0.w = sigmoidf_(v0.w + b0.w);
                        v1.x = sigmoidf_(v1.x + b1.x); v1.y = sigmoidf_(v1.y + b1.y); v1.z = sigmoidf_(v1.z + b1.z); v1.w = sigmoidf_(v1.w + b1.w);
                    } else if (col >= U_DT && col < U_DT + 16) {
                        *(f32x4*)(DTR + (size_t)row * 16 + (col - U_DT)) = v0; *(f32x4*)(DTR + (size_t)row * 16 + (col - U_DT) + 4) = v1;
                    }
                    u32x4 w; w.x = pk2(v0.x, v0.y); w.y = pk2(v0.z, v0.w); w.z = pk2(v1.x, v1.y); w.w = pk2(v1.z, v1.w);
                    *(u32x4*)(U + (size_t)row * NIN + col) = w;
                }
        }
    }
};
DI void phase_gemm_in(const Params& P, int l, char* lds) {
    unsigned char* ws = P.ws;
    g8::GridSched<NQB, NIN / 256> S; S.init(ws + WS_H, 512, ws + WS_WIN + l * SZ_WIN, 512);
    EpiIn E{(bf16_t*)(ws + WS_U), (float*)(ws + WS_DTR), P.in[9] + (size_t)l * 3072, (const float*)(ws + WS_HS), (const float*)(ws + WS_WINS) + (size_t)l * NIN};
    g8::gemm_phase<true, true>((LAS unsigned char*)lds, 512, 512, S, E);
}

struct EpiBf16Plain {
    bf16_t* C; int ldc;
    DI void operator()(const g8::Acc& acc, const g8::Unit& u, int wr, int wc, int fr, int fq) const {
#pragma unroll
        for (int ai = 0; ai < 2; ++ai)
#pragma unroll
            for (int m = 0; m < 4; ++m) {
                const int row = u.t0 * 256 + 128 * ai + 64 * wr + 16 * m + fr;
#pragma unroll
                for (int bj = 0; bj < 2; ++bj) {
                    const int col = u.t1 * 256 + 128 * bj + 32 * wc + 8 * fq;
                    const f32x4 v0 = acc[ai][bj][m][0], v1 = acc[ai][bj][m][1];
                    u32x4 w; w.x = pk2(v0.x, v0.y); w.y = pk2(v0.z, v0.w); w.z = pk2(v1.x, v1.y); w.w = pk2(v1.z, v1.w);
                    *(u32x4*)(C + (size_t)row * ldc + col) = w;
                }
            }
    }
};

template <int NI>
DI void gemm_store_bf16(const GemmAcc<NI>& acc, bf16_t* C, size_t ldc, int row0, int col0) {
    const int tid = opaque_tid(), lane = tid & 63, wid = tid >> 6, wr = wid >> 2, wc = wid & 3, r = lane & 31, h = lane >> 5;
#pragma unroll
    for (int mi = 0; mi < 4; ++mi)
#pragma unroll
        for (int ni = 0; ni < NI; ++ni) {
            float v[16];
#pragma unroll
            for (int i = 0; i < 16; ++i) v[i] = acc.a[mi][ni][i];
            st_bf16x16(C + (size_t)(row0 + wr * 128 + mi * 32 + r) * ldc + col0 + wc * 32 * NI + ni * 32 + 16 * h, v);
        }
}

DI void phase_gemm_merge(const Params& P, int l, char* lds) {
    unsigned char* ws = P.ws;
    const int G = GRID;
    const bf16_t* U = (const bf16_t*)(ws + WS_U);
    const bf16_t* WUP = (const bf16_t*)(ws + WS_WUP + l * SZ_WUP);
    bf16_t* MRG = (bf16_t*)(ws + WS_MRG);
    const int nu = (NQB - 1) * 8;
    const int bx_ = opaque_bid() & 7, by_ = opaque_bid() >> 3;
    for (int k_ = 0; ; ++k_) {
        const int rt = k_ * 32 + bx_ * 4 + (by_ >> 3), ct = by_ & 7;
        if (rt * 8 >= nu) break;
        const int tid = opaque_tid(), lane = tid & 63, wid = tid >> 6, wr = wid >> 2, wc = wid & 3, r = lane & 31, h = lane >> 5; (void)tid; (void)wr; (void)wc; (void)r; (void)h;
        float tot[4][16];
#pragma unroll
        for (int mi = 0; mi < 4; ++mi)
#pragma unroll
            for (int i = 0; i < 16; ++i) tot[mi][i] = 0.f;
#pragma unroll 1
        for (int br = 0; br < 3; ++br) {
            const bf16_t* Y = (const bf16_t*)(ws + (br == 0 ? WS_YA : (br == 1 ? WS_YB : WS_YC)));
            GemmAcc<1> acc;
            gemm_tile<1>(lds, ARowPlain{Y + (size_t)rt * 256 * 512, 512}, WUP + (size_t)br * 1024 * 512 + (size_t)ct * 128 * 512, 512, 512, acc);
            u32x4 gg0[4], gg1[4];
#pragma unroll
            for (int mi = 0; mi < 4; ++mi) { const bf16_t* gp = U + (size_t)(rt * 256 + wr * 128 + mi * 32 + r) * NIN + U_G + br * 1024 + ct * 128 + wc * 32 + 16 * h;
                gg0[mi] = *(const u32x4*)gp; gg1[mi] = *(const u32x4*)(gp + 8); }
            __builtin_amdgcn_sched_barrier(0);
#pragma unroll
            for (int mi = 0; mi < 4; ++mi) {
                const u32x4 g0 = gg0[mi], g1 = gg1[mi];
                const unsigned gw[8] = {g0.x, g0.y, g0.z, g0.w, g1.x, g1.y, g1.z, g1.w};
#pragma unroll
                for (int q = 0; q < 8; ++q) { tot[mi][2 * q] += bflo(gw[q]) * acc.a[mi][0][2 * q]; tot[mi][2 * q + 1] += bfhi(gw[q]) * acc.a[mi][0][2 * q + 1]; }
            }
        }
#pragma unroll
        for (int mi = 0; mi < 4; ++mi)
            st_bf16x16(MRG + (size_t)(rt * 256 + wr * 128 + mi * 32 + r) * 1024 + ct * 128 + wc * 32 + 16 * h, tot[mi]);
    }
    if (l + 1 < NLAYER) {
        const int c_ = opaque_bid();
        if ((c_ & 7) == 0) {
            const int su = c_ >> 3, ct = su & 7, qr = su >> 3;
            const int tid = opaque_tid(), lane = tid & 63, wid = tid >> 6, wr = wid >> 2, wc = wid & 3, r = lane & 31, h = lane >> 5; (void)tid;
            const int row = (NQB - 1) * 256 + qr * 64 + wr * 32 + r;
            float tot[16];
#pragma unroll
            for (int i = 0; i < 16; ++i) tot[i] = 0.f;
#pragma unroll 1
            for (int br = 0; br < 3; ++br) {
                const bf16_t* Y = (const bf16_t*)(ws + (br == 0 ? WS_YA : (br == 1 ? WS_YB : WS_YC)));
                GemmAcc<1> acc;
                gemm_tile<1, ARowPlain, 1>(lds, ARowPlain{Y + (size_t)((NQB - 1) * 256 + qr * 64) * 512, 512}, WUP + (size_t)br * 1024 * 512 + (size_t)ct * 128 * 512, 512, 512, acc);
                const bf16_t* gp = U + (size_t)row * NIN + U_G + br * 1024 + ct * 128 + wc * 32 + 16 * h;
                const u32x4 g0 = *(const u32x4*)gp, g1 = *(const u32x4*)(gp + 8);
                const unsigned gw[8] = {g0.x, g0.y, g0.z, g0.w, g1.x, g1.y, g1.z, g1.w};
#pragma unroll
                for (int q = 0; q < 8; ++q) { tot[2 * q] += bflo(gw[q]) * acc.a[0][0][2 * q]; tot[2 * q + 1] += bfhi(gw[q]) * acc.a[0][0][2 * q + 1]; }
            }
            st_bf16x16(MRG + (size_t)row * 1024 + ct * 128 + wc * 32 + 16 * h, tot);
        } else {
            wdn_units(P, l + 1, 0, XP_WDN_MERGE, c_ - (c_ >> 3) - 1, GRID - 32);
        }
    }
}

struct EpiOut {
    bf16_t* XCUR; const float* MOD; int l;
    DI void operator()(const g8::Acc& acc, const g8::Unit& u, int wr, int wc, int fr, int fq) const {
        const float* gt1 = MOD + ((size_t)l * 2 + (u.t0 == NQB - 1 ? 1 : 0)) * 6144 + 2 * 1024;
        f32x4 g[2][2];
#pragma unroll
        for (int bj = 0; bj < 2; ++bj)
#pragma unroll
            for (int n = 0; n < 2; ++n) g[bj][n] = *(const f32x4*)(gt1 + u.t1 * 256 + 128 * bj + 32 * wc + 16 * n + 4 * fq);
#pragma unroll
        for (int ai = 0; ai < 2; ++ai)
#pragma unroll
            for (int mp = 0; mp < 4; mp += 2) {
                u32x2 w[2][2][2];
#pragma unroll
                for (int mm = 0; mm < 2; ++mm) { const int row = u.t0 * 256 + 128 * ai + 64 * wr + 16 * (mp + mm) + fr;
#pragma unroll
                    for (int bj = 0; bj < 2; ++bj)
#pragma unroll
                        for (int n = 0; n < 2; ++n) w[mm][bj][n] = *(const u32x2*)(XCUR + (size_t)row * 1024 + u.t1 * 256 + 128 * bj + 32 * wc + 16 * n + 4 * fq); }
                __builtin_amdgcn_sched_barrier(0);
#pragma unroll
                for (int mm = 0; mm < 2; ++mm) { const int row = u.t0 * 256 + 128 * ai + 64 * wr + 16 * (mp + mm) + fr;
#pragma unroll
                    for (int bj = 0; bj < 2; ++bj)
#pragma unroll
                        for (int n = 0; n < 2; ++n) {
                            const u32x2 ww = w[mm][bj][n];
                            const f32x4 v = (f32x4){bflo(ww.x), bfhi(ww.x), bflo(ww.y), bfhi(ww.y)} + g[bj][n] * acc[ai][bj][mp + mm][n];
                            u32x2 o2; o2.x = pk2(v.x, v.y); o2.y = pk2(v.z, v.w);
                            *(u32x2*)(XCUR + (size_t)row * 1024 + u.t1 * 256 + 128 * bj + 32 * wc + 16 * n + 4 * fq) = o2;
                        } }
                __builtin_amdgcn_sched_barrier(0);
            }
    }
};
DI void phase_gemm_out(const Params& P, int l, char* lds) {
    unsigned char* ws = P.ws;
    EpiOut E{(bf16_t*)(ws + WS_XCUR), (const float*)(ws + WS_MOD), l};
    {
        g8::GridSched<NQB - 1, 4> S; S.init(ws + WS_MRG, 1024, ws + WS_WOUT + l * SZ_WOUT, 1024);
        g8::gemm_phase<false>((LAS unsigned char*)lds, 1024, 1024, S, E);
    }
    if (l + 1 < NLAYER) {
        const int c_ = opaque_bid();
        __syncthreads();
        if ((c_ & 7) == 0) {
            const int su = c_ >> 3, ct = su & 7, qr = su >> 3;
            const int tid = opaque_tid(), lane = tid & 63, wid = tid >> 6, wr = wid >> 2, wc = wid & 3, r = lane & 31, h = lane >> 5; (void)tid;
            const int row = (NQB - 1) * 256 + qr * 64 + wr * 32 + r, col = ct * 128 + wc * 32 + 16 * h;
            GemmAcc<1> acc;
            gemm_tile<1, ARowPlain, 1>(lds, ARowPlain{(const bf16_t*)(ws + WS_MRG) + (size_t)((NQB - 1) * 256 + qr * 64) * 1024, 1024}, (const bf16_t*)(ws + WS_WOUT + l * SZ_WOUT) + (size_t)ct * 128 * 1024, 1024, 1024, acc);
            const float* gt1 = (const float*)(ws + WS_MOD) + ((size_t)l * 2 + 1) * 6144 + 2 * 1024 + col;
            bf16_t* xp = (bf16_t*)(ws + WS_XCUR) + (size_t)row * 1024 + col;
            const u32x4 x0 = *(const u32x4*)xp, x1 = *(const u32x4*)(xp + 8);
            const unsigned xw[8] = {x0.x, x0.y, x0.z, x0.w, x1.x, x1.y, x1.z, x1.w};
            float v[16];
#pragma unroll
            for (int q = 0; q < 8; ++q) { v[2 * q] = bflo(xw[q]) + gt1[2 * q] * acc.a[0][0][2 * q]; v[2 * q + 1] = bfhi(xw[q]) + gt1[2 * q + 1] * acc.a[0][0][2 * q + 1]; }
            st_bf16x16(xp, v);
        } else {
            const int rk = c_ - (c_ >> 3) - 1;
            for (int u = rk; u < XP_WDN_OUTN; u += GRID - 32) { const int rr = (u < XP_WDN_DOWN0 - XP_WDN_MERGE) ? (XP_WDN_MERGE + u) : (XP_WDN_DOWN1 + (u - (XP_WDN_DOWN0 - XP_WDN_MERGE)));
                wdn_units(P, l + 1, rr, rr + 1, 0, 1); }
        }
    }
}

constexpr int MOE_TAB_OFF = 131072 + 1024;
DI int moe_build_table(const int* ecnt, char* lds) {
    int* tab = (int*)(lds + MOE_TAB_OFF);
    const int tid = opaque_tid();
    if (tid < 64) {
        const int e = tid & 31;
        const int nb = (tid < 32) ? ((ecnt[e * ECS] + 255) >> 8) : 0;
        int incl = nb;
#pragma unroll
        for (int d = 1; d < 32; d <<= 1) { const int t = __shfl_up(incl, d); if ((tid & 31) >= d) incl += t; }
        if (tid < 32) { const int base = incl - nb; for (int j = 0; j < nb; ++j) tab[1 + base + j] = (e << 16) | j; if (tid == 31) tab[0] = incl; }
    }
    __syncthreads();
    return tab[0];
}
template <int NCT, bool SPARSE, size_t A_EXPERT_STEP, size_t A_BLK_STEP, size_t W_EXPERT_STEP, size_t W_CT_STEP>
struct MoeSched {
    const char* A; const char* W; const int* tab; int nunits; int c;
    DI bool next(int i, g8::Unit& u) const {
        constexpr int RPX = 32 / NCT;
        const int x = c & 7, y = c >> 3;
        const int rb = i * (GRID / NCT) + x * RPX + y / NCT, ct = y % NCT;
        if (rb * NCT >= nunits) return false;
        const int ej = tab[1 + rb], e = ej >> 16, j = ej & 0xffff;
        u.a = SPARSE ? (A + (size_t)e * A_EXPERT_STEP + (size_t)j * A_BLK_STEP) : (A + (size_t)rb * A_BLK_STEP);
        u.b = W + (size_t)e * W_EXPERT_STEP + (size_t)ct * W_CT_STEP; u.t0 = rb; u.t1 = ct | (e << 8); return true;
    }
};
struct EpiGu {
    bf16_t* ACT; const float* bgu_l; const float* xgs; const float* wgs_l; const int* tab;
    DI void operator()(const g8::AccI& acc, const g8::Unit& u, int wr, int wc, int fr, int fq) const {
        const int ct = u.t1 & 255, e = u.t1 >> 8;
        const int j0 = ct * 128 + 32 * wc + 8 * fq;
        const float* bg = bgu_l + (size_t)e * 2048 + j0;
        const f32x4 bg0 = *(const f32x4*)bg, bg1 = *(const f32x4*)(bg + 4), bl0 = *(const f32x4*)(bg + 1024), bl1 = *(const f32x4*)(bg + 1028);
        const float* ws_ = wgs_l + (size_t)e * 2048 + ct * 256 + 32 * wc + 8 * fq;
        const f32x4 sg0 = *(const f32x4*)ws_, sg1 = *(const f32x4*)(ws_ + 4), sl0 = *(const f32x4*)(ws_ + 128), sl1 = *(const f32x4*)(ws_ + 132);
        const int ej = tab[1 + u.t0];
        const float* xs = xgs + (size_t)(ej >> 16) * T + (ej & 0xffff) * 256;
        float sa_[2][4];
#pragma unroll
        for (int ai = 0; ai < 2; ++ai)
#pragma unroll
            for (int m = 0; m < 4; ++m) sa_[ai][m] = xs[128 * ai + 64 * wr + 16 * m + fr];
        __builtin_amdgcn_sched_barrier(0);
#pragma unroll
        for (int ai = 0; ai < 2; ++ai)
#pragma unroll
            for (int m = 0; m < 4; ++m) {
                const int rl = 128 * ai + 64 * wr + 16 * m + fr, row = u.t0 * 256 + rl;
                const float sa = sa_[ai][m];
                float v[8];
#pragma unroll
                for (int q = 0; q < 8; ++q) {
                    float glu = (float)acc[ai][0][m][q >> 2][q & 3] * (sa * ((q < 4) ? sg0[q & 3] : sg1[q & 3])) + ((q < 4) ? bg0[q & 3] : bg1[q & 3]);
                    float lin = (float)acc[ai][1][m][q >> 2][q & 3] * (sa * ((q < 4) ? sl0[q & 3] : sl1[q & 3])) + ((q < 4) ? bl0[q & 3] : bl1[q & 3]);
                    glu = fminf(glu, 7.0f); lin = fminf(fmaxf(lin, -7.0f), 7.0f);
                    v[q] = glu * sigmoidf_(1.702f * glu) * (lin + 1.0f);
                }
                u32x4 w; w.x = pk2(v[0], v[1]); w.y = pk2(v[2], v[3]); w.z = pk2(v[4], v[5]); w.w = pk2(v[6], v[7]);
                *(u32x4*)(ACT + (size_t)row * 1024 + j0) = w;
            }
    }
};
DI void phase_moe_gu(const Params& P, int l, char* lds) {
    unsigned char* ws = P.ws;
    const int* ecnt = (const int*)(ws + WS_CTL) + l * 32 * ECS;
    const int nblk = moe_build_table(ecnt, lds);
    MoeSched<8, true, (size_t)T * 1024, (size_t)256 * 1024, (size_t)2048 * 1024, (size_t)256 * 1024> S{(const char*)(ws + WS_XG), (const char*)(ws + WS_WGU + l * SZ_WGU), (const int*)(lds + MOE_TAB_OFF), nblk * 8, opaque_bid()};
    EpiGu E{(bf16_t*)(ws + WS_ACT), P.in[33] + (size_t)l * 32 * 2048, (const float*)(ws + WS_XGS), (const float*)(ws + WS_WGS) + (size_t)l * 32 * 2048, (const int*)(lds + MOE_TAB_OFF)};
    g8::gemm_phase<true, true>((LAS unsigned char*)lds, 512, 512, S, E);
}
struct EpiDown {
    bf16_t* Y; const float* bd_l;
    DI void operator()(const g8::Acc& acc, const g8::Unit& u, int wr, int wc, int fr, int fq) const {
        const int ct = u.t1 & 255, e = u.t1 >> 8;
#pragma unroll
        for (int bj = 0; bj < 2; ++bj) {
            const int col = ct * 256 + 128 * bj + 32 * wc + 8 * fq;
            const f32x4 b0 = *(const f32x4*)(bd_l + (size_t)e * 1024 + col), b1 = *(const f32x4*)(bd_l + (size_t)e * 1024 + col + 4);
#pragma unroll
            for (int ai = 0; ai < 2; ++ai)
#pragma unroll
                for (int m = 0; m < 4; ++m) {
                    const int row = u.t0 * 256 + 128 * ai + 64 * wr + 16 * m + fr;
                    const f32x4 v0 = acc[ai][bj][m][0] + b0, v1 = acc[ai][bj][m][1] + b1;
                    u32x4 w; w.x = pk2(v0.x, v0.y); w.y = pk2(v0.z, v0.w); w.z = pk2(v1.x, v1.y); w.w = pk2(v1.z, v1.w);
                    *(u32x4*)(Y + (size_t)row * 1024 + col) = w;
                }
        }
    }
};
DI void phase_moe_down(const Params& P, int l, char* lds) {
    unsigned char* ws = P.ws;
    const int* ecnt = (const int*)(ws + WS_CTL) + l * 32 * ECS;
    const int nblk = moe_build_table(ecnt, lds);
    MoeSched<4, false, 0, (size_t)256 * 2048, (size_t)1024 * 2048, (size_t)256 * 2048> S{(const char*)(ws + WS_ACT), (const char*)(ws + WS_WDN + l * SZ_WDN), (const int*)(lds + MOE_TAB_OFF), nblk * 4, opaque_bid()};
    EpiDown E{(bf16_t*)(ws + WS_YMOE), P.in[35] + (size_t)l * 32 * 1024};
    g8::gemm_phase<true>((LAS unsigned char*)lds, 1024, 1024, S, E);
    if (l + 1 < NLAYER) {
        const int m = nblk - ((nblk - 1) >> 6) * 64;
        const int c_ = opaque_bid(), key = ((c_ & 7) * 8 + ((c_ >> 3) >> 2)) * 4 + ((c_ >> 3) & 3);
        if (m == 64) wdn_units(P, l + 1, XP_WDN_DOWN0, XP_WDN_DOWN1, c_, GRID);
        else if (key >= 4 * m) wdn_units(P, l + 1, XP_WDN_DOWN0, XP_WDN_DOWN1, key - 4 * m, GRID - 4 * m);
    }
}

constexpr int P3_SSM = NCHUNK * 2;
constexpr int P3_MLAQ = NQB * 3, P3_MLAKV = NQB * 4;
constexpr int P3_DIF = NT64;

DI const float* rope_tab(const unsigned char* ws) { return (const float*)(ws + WS_TAB); }

DI void dif_prep_unit(const Params& P, int l, int tile, char* lds) {
    unsigned char* ws = P.ws;
    const int tid = opaque_tid(), lane = tid & 63, wid = tid >> 6;
    const bf16_t* U = (const bf16_t*)(ws + WS_U);
    bf16_t* QD = (bf16_t*)(ws + WS_QD); bf16_t* KD = (bf16_t*)(ws + WS_KD); bf16_t* VDT = (bf16_t*)(ws + WS_VDT);
    const float* TABD = rope_tab(ws) + 320 * 16;
    const float* gq = P.in[16] + l * 64; const float* gk = P.in[17] + l * 64;
    const int sub = lane & 3, grp = lane >> 2;
    const float qscale = 0.125f * LOG2E;
    bf16_t* vs = (bf16_t*)lds;
    u32x4 ld0[8], ld1[8], ldv[8];
#pragma unroll
    for (int q = 0; q < 8; ++q) {
        const int t = tile * 64 + wid * 8 + q;
        const bf16_t* src = U + (size_t)t * NIN + U_DQ + grp * 64 + sub * 16;
        ld0[q] = *(const u32x4*)src; ld1[q] = *(const u32x4*)(src + 8);
        ldv[q] = *(const u32x4*)(U + (size_t)t * NIN + U_DV + lane * 8);
    }
#pragma unroll
    for (int q = 0; q < 8; ++q) {
        const int tl_ = wid * 8 + q, t = tile * 64 + tl_;
        const bool lat = t < SEQ;
        const u32x4 w0 = ld0[q], w1 = ld1[q];
        float x[16] = {bflo(w0.x), bfhi(w0.x), bflo(w0.y), bfhi(w0.y), bflo(w0.z), bfhi(w0.z), bflo(w0.w), bfhi(w0.w),
                       bflo(w1.x), bfhi(w1.x), bflo(w1.y), bfhi(w1.y), bflo(w1.z), bfhi(w1.z), bflo(w1.w), bfhi(w1.w)};
        float ss = 0.f;
#pragma unroll
        for (int i = 0; i < 16; ++i) ss += x[i] * x[i];
        ss = quad_sum(ss);
        const float rstd = rsqrtf(ss * (1.0f / 64.0f) + EPS);
        const float* g = (grp < 8 ? gq : gk) + sub * 16;
#pragma unroll
        for (int i = 0; i < 16; ++i) x[i] = x[i] * rstd * g[i];
        if (lat) {
            const int pos = (sub < 2) ? (t >> 6) : (256 + (t & 63));
            const float* cs = TABD + pos * 16; const float* sn = TABD + 320 * 16 + pos * 16;
#pragma unroll
            for (int i = 0; i < 16; ++i) {
                const float other = lane_xor1(x[i]);
                const float c = cs[i], s = sn[i];
                x[i] = (sub & 1) ? (x[i] * c + other * s) : (x[i] * c - other * s);
            }
        }
        if (grp < 8) {
#pragma unroll
            for (int i = 0; i < 16; ++i) x[i] *= qscale;
            st_bf16x16(QD + ((size_t)grp * T + t) * 64 + sub * 16, x);
        } else {
            st_fp8x16((unsigned char*)KD + ((size_t)(grp - 8) * T + t) * 64 + sub * 16, x);
        }
        *(u32x4*)(vs + tl_ * 520 + lane * 8) = ldv[q];
    }
    __syncthreads();
#pragma unroll 1
    for (int it = 0; it < 4; ++it) {
        const int cid = tid + it * NTHR;
        const int rowc = cid >> 2, pc = cid & 3;
        float e[16];
#pragma unroll
        for (int j = 0; j < 16; ++j) { const int key = kperm8(pc * 16 + j); e[j] = bf2f(vs[key * 520 + rowc]); }
        const int head = rowc >> 7, dv = rowc & 127;
        st_fp8x16((unsigned char*)VDT + (((size_t)head * NT64 + tile) * 128 + dv) * 64 + pc * 16, e);
    }
    __syncthreads();
}

DI void ssm_prep_unit(const Params& P, int l, int chunk, int g, char* lds) {
    unsigned char* ws = P.ws;
    const int tid = opaque_tid(), lane = tid & 63, wid = tid >> 6, r = lane & 31, h = lane >> 5;
    const bf16_t* U = (const bf16_t*)(ws + WS_U);
    const float* DTR = (const float*)(ws + WS_DTR);
    bf16_t* XST = (bf16_t*)(ws + WS_XST); bf16_t* BCN = (bf16_t*)(ws + WS_BCN);
    float* DTS = (float*)(ws + WS_DTS); float* CUM = (float*)(ws + WS_CUM); bf16_t* ST = (bf16_t*)(ws + WS_ST); float* DEC = (float*)(ws + WS_DEC);
    const float* cw = P.in[20] + (size_t)l * 5 * 1024; const float* cb = P.in[21] + (size_t)l * 1024;
    const int t0 = chunk * 128;
    const int seq_lo = (t0 < SEQ) ? 0 : SEQ, seq_hi = (t0 < SEQ) ? SEQ : T;
    constexpr int PT = 136;
    bf16_t* xsT = (bf16_t*)lds;
    bf16_t* bT = (bf16_t*)(lds + 69632);
    float* scl = (float*)(lds + 69632 + 34816);
    auto toff = [](int row, int pos) { return row * PT + ((((pos >> 3) ^ ((row >> 3) & 15)) << 3) | (pos & 7)); };
    {
        const int cg = tid & 63, ts = tid >> 6;
        int ch;
        if (cg < 32) ch = 256 * g + 8 * cg; else if (cg < 48) ch = 512 + 128 * g + 8 * (cg - 32); else ch = 768 + 128 * g + 8 * (cg - 48);
        float wv[5][8], bv[8];
#pragma unroll
        for (int k = 0; k < 5; ++k) {
            const f32x4 a = *(const f32x4*)(cw + (size_t)k * 1024 + ch), b2 = *(const f32x4*)(cw + (size_t)k * 1024 + ch + 4);
            wv[k][0] = a.x; wv[k][1] = a.y; wv[k][2] = a.z; wv[k][3] = a.w; wv[k][4] = b2.x; wv[k][5] = b2.y; wv[k][6] = b2.z; wv[k][7] = b2.w;
        }
        { const f32x4 a = *(const f32x4*)(cb + ch), b2 = *(const f32x4*)(cb + ch + 4); bv[0] = a.x; bv[1] = a.y; bv[2] = a.z; bv[3] = a.w; bv[4] = b2.x; bv[5] = b2.y; bv[6] = b2.z; bv[7] = b2.w; }
        const int tb = t0 + ts * 16;
        u32x4 raw[20];
#pragma unroll
        for (int i = 0; i < 20; ++i) { const int t = tb - 2 + i; raw[i] = (t >= seq_lo && t < seq_hi) ? *(const u32x4*)(U + (size_t)t * NIN + U_XS + ch) : (u32x4){0u, 0u, 0u, 0u}; }
#pragma unroll
        for (int q = 0; q < 16; ++q) {
            float y[8];
#pragma unroll
            for (int i = 0; i < 8; ++i) y[i] = bv[i];
#pragma unroll
            for (int k = 0; k < 5; ++k) { const u32x4 w = raw[q + k];
                y[0] += wv[k][0] * bflo(w.x); y[1] += wv[k][1] * bfhi(w.x); y[2] += wv[k][2] * bflo(w.y); y[3] += wv[k][3] * bfhi(w.y);
                y[4] += wv[k][4] * bflo(w.z); y[5] += wv[k][5] * bfhi(w.z); y[6] += wv[k][6] * bflo(w.w); y[7] += wv[k][7] * bfhi(w.w); }
#pragma unroll
            for (int i = 0; i < 8; ++i) y[i] = siluf_(y[i]);
            const int t = tb + q, tl_ = ts * 16 + q;
            u32x4 w; w.x = pk2(y[0], y[1]); w.y = pk2(y[2], y[3]); w.z = pk2(y[4], y[5]); w.w = pk2(y[6], y[7]);
            if (cg < 32) {
                const int pos = (tl_ & ~15) | kperm(tl_ & 15);
#pragma unroll
                for (int i = 0; i < 8; ++i) xsT[toff(8 * cg + i, pos)] = f2bf(y[i]);
            } else if (cg < 48) {
                *(u32x4*)(BCN + (size_t)t * 512 + 128 * g + 8 * (cg - 32)) = w;
#pragma unroll
                for (int i = 0; i < 8; ++i) bT[toff(8 * (cg - 32) + i, tl_)] = f2bf(y[i]);
            } else {
                *(u32x4*)(BCN + (size_t)t * 512 + 256 + 128 * g + 8 * (cg - 48)) = w;
            }
        }
    }
    {
        const int j = wid, d = j >> 2, hh = 4 * g + (j & 3);
        const float a = -__expf(P.in[23][l * 16 + d * 8 + hh]);
        const float bias = P.in[22][l * 16 + d * 8 + hh];
        const int i0 = 2 * lane, i1 = 2 * lane + 1;
        const int k0 = d ? 127 - i0 : i0, k1 = d ? 127 - i1 : i1;
        const float r0 = DTR[(size_t)(t0 + k0) * 16 + d * 8 + hh] + bias, r1 = DTR[(size_t)(t0 + k1) * 16 + d * 8 + hh] + bias;
        const float sp0 = (r0 > 20.f) ? r0 : log1pf(__expf(r0)), sp1 = (r1 > 20.f) ? r1 : log1pf(__expf(r1));
        const float x0 = sp0 * a, x1 = sp1 * a;
        float incl = x0 + x1;
#pragma unroll
        for (int sft = 1; sft < 64; sft <<= 1) { const float tv = __shfl_up(incl, sft); if (lane >= sft) incl += tv; }
        const float c0 = incl - x1, c1 = incl;
        const float tot = __shfl(incl, 63);
        DTS[(size_t)(t0 + k0) * 16 + d * 8 + hh] = sp0; DTS[(size_t)(t0 + k1) * 16 + d * 8 + hh] = sp1;
        CUM[(size_t)(t0 + k0) * 16 + d * 8 + hh] = c0; CUM[(size_t)(t0 + k1) * 16 + d * 8 + hh] = c1;
        if (lane == 0) DEC[(size_t)chunk * 16 + d * 8 + hh] = __expf(tot);
        scl[j * 128 + ((k0 & ~15) | kperm(k0 & 15))] = sp0 * __expf(tot - c0);
        scl[j * 128 + ((k1 & ~15) | kperm(k1 & 15))] = sp1 * __expf(tot - c1);
    }
    __syncthreads();
    for (int i = tid; i < 256 * 16; i += NTHR) {
        const int chl = i >> 4, pc = i & 15;
        *(u32x4*)(XST + ((size_t)chunk * 512 + 256 * g + chl) * 128 + pc * 8) = *(const u32x4*)(xsT + toff(chl, pc * 8));
    }
    {
        const int j = wid, d = j >> 2, hl = j & 3, hh = 4 * g + hl;
        f32x16 acc[4][2];
#pragma unroll
        for (int nb = 0; nb < 4; ++nb)
#pragma unroll
            for (int pb = 0; pb < 2; ++pb)
#pragma unroll
                for (int i = 0; i < 16; ++i) acc[nb][pb][i] = 0.f;
        const int pr = perm32(r);
#pragma unroll 1
        for (int ks = 0; ks < 8; ++ks) {
            const f32x4 s0 = *(const f32x4*)(scl + j * 128 + 16 * ks + 8 * h), s1 = *(const f32x4*)(scl + j * 128 + 16 * ks + 8 * h + 4);
            bf16x8 xf[2];
#pragma unroll
            for (int pb = 0; pb < 2; ++pb) {
                const u32x4 w = *(const u32x4*)(xsT + toff(hl * 64 + pb * 32 + r, 16 * ks + 8 * h));
                u32x4 o; o.x = pk2(bflo(w.x) * s0.x, bfhi(w.x) * s0.y); o.y = pk2(bflo(w.y) * s0.z, bfhi(w.y) * s0.w);
                o.z = pk2(bflo(w.z) * s1.x, bfhi(w.z) * s1.y); o.w = pk2(bflo(w.w) * s1.z, bfhi(w.w) * s1.w);
                xf[pb] = __builtin_bit_cast(bf16x8, o);
            }
#pragma unroll
            for (int nb = 0; nb < 4; ++nb) {
                const u32x2 lo = *(const u32x2*)(bT + toff(nb * 32 + pr, 16 * ks + 4 * h)), hi = *(const u32x2*)(bT + toff(nb * 32 + pr, 16 * ks + 8 + 4 * h));
                u32x4 bw; bw.x = lo.x; bw.y = lo.y; bw.z = hi.x; bw.w = hi.y;
                const bf16x8 bf = __builtin_bit_cast(bf16x8, bw);
#pragma unroll
                for (int pb = 0; pb < 2; ++pb) acc[nb][pb] = MFMA32(bf, xf[pb], acc[nb][pb]);
            }
        }
        bf16_t* dst = ST + (((size_t)chunk * 2 + d) * 8 + hh) * 8192;
#pragma unroll
        for (int nb = 0; nb < 4; ++nb)
#pragma unroll
            for (int pb = 0; pb < 2; ++pb) { float v[16];
#pragma unroll
                for (int i = 0; i < 16; ++i) v[i] = acc[nb][pb][i];
                st_bf16x16(dst + (size_t)(pb * 32 + r) * 128 + nb * 32 + 16 * h, v); }
    }
    __syncthreads();
}

DI int first_unit(int off) { const int G = GRID; int v = opaque_bid() - (off % G); if (v < 0) v += G; return v; }
struct P3Sched {
    g8::GridSched<NQB, 7> G; const char* Bkv; size_t aoff;
    DI bool next(int i, g8::Unit& u) const {
        if (!G.next(i, u)) return false;
        if (u.t1 >= 3) { u.a += aoff; u.b = Bkv + (size_t)(u.t1 - 3) * G.bstep; }
        return true;
    }
};
struct EpiP3 {
    bf16_t* Q; bf16_t* KV;
    DI void operator()(const g8::Acc& acc, const g8::Unit& u, int wr, int wc, int fr, int fq) const {
        g8::Unit v = u;
        if (u.t1 < 3) { EpiBf16Plain e{Q, 768}; e(acc, v, wr, wc, fr, fq); }
        else { v.t1 = u.t1 - 3; EpiBf16Plain e{KV, 1024}; e(acc, v, wr, wc, fr, fq); }
    }
};
DI void phase_p3(const Params& P, int l, char* lds) {
    unsigned char* ws = P.ws;
    const int G = GRID;
    const bf16_t* U = (const bf16_t*)(ws + WS_U);
    for (int v = first_unit(0); v < P3_SSM; v += G) ssm_prep_unit(P, l, v >> 1, v & 1, lds);
    for (int v = first_unit(P3_SSM); v < P3_DIF; v += G) dif_prep_unit(P, l, v, lds);
    { P3Sched S; S.G.init(U + U_CQ, NIN, ws + WS_WUQ + l * SZ_WUQ, 256);
      S.G.gs = GRID - 8; S.G.c = (S.G.c < 8) ? (1 << 20) : (S.G.c - 8);
      S.Bkv = (const char*)(ws + WS_WUKV + l * SZ_WUKV); S.aoff = (size_t)(U_CKV - U_CQ) * 2;
      EpiP3 E{(bf16_t*)(ws + WS_QRAW), (bf16_t*)(ws + WS_KVRAW)};
      g8::gemm_phase<true>((LAS unsigned char*)lds, 256, NIN, S, E); }
}

DI void mla_finalize_unit(const Params& P, int l, int tile, char* lds) {
    unsigned char* ws = P.ws;
    const int tid = opaque_tid(), lane = tid & 63, wid = tid >> 6;
    const bf16_t* U = (const bf16_t*)(ws + WS_U);
    const bf16_t* QRAW = (const bf16_t*)(ws + WS_QRAW); const bf16_t* KVRAW = (const bf16_t*)(ws + WS_KVRAW);
    bf16_t* QM = (bf16_t*)(ws + WS_QM); bf16_t* KM = (bf16_t*)(ws + WS_KM); bf16_t* VMT = (bf16_t*)(ws + WS_VMT);
    const float* TABM = rope_tab(ws);
    const float* gqn = P.in[14] + l * 96; const float* gkn = P.in[15] + l * 96;
    const int head = lane >> 3, sub = lane & 7;
    const bool act = sub < 6;
    const float qscale = 0.10206207261596575f * LOG2E;
    bf16_t* vs = (bf16_t*)lds;
#pragma unroll 1
    for (int qb = 0; qb < 2; ++qb) {
    u32x2 l_cq[4]; unsigned l_ckv[4]; u32x4 l_q0[4], l_q1[4], l_k0[4], l_k1[4], l_v[4];
#pragma unroll
    for (int qq = 0; qq < 4; ++qq) {
        const int t = tile * 64 + wid * 8 + qb * 4 + qq;
        l_cq[qq] = *(const u32x2*)(U + (size_t)t * NIN + U_CQ + lane * 4);
        l_ckv[qq] = *(const unsigned*)(U + (size_t)t * NIN + U_CKV + lane * 2);
        if (act) { const bf16_t* src = QRAW + (size_t)t * 768 + head * 96 + sub * 16; l_q0[qq] = *(const u32x4*)src; l_q1[qq] = *(const u32x4*)(src + 8);
            const bf16_t* ks = (sub < 4) ? (KVRAW + (size_t)t * 1024 + head * 128 + sub * 16) : (U + (size_t)t * NIN + U_KR + (sub - 4) * 16);
            l_k0[qq] = *(const u32x4*)ks; l_k1[qq] = *(const u32x4*)(ks + 8); }
        else { l_q0[qq] = l_q1[qq] = l_k0[qq] = l_k1[qq] = (u32x4){0u, 0u, 0u, 0u}; }
        l_v[qq] = *(const u32x4*)(KVRAW + (size_t)t * 1024 + (lane >> 3) * 128 + 64 + (lane & 7) * 8);
    }
#pragma unroll
    for (int qq = 0; qq < 4; ++qq) {
        const int q = qb * 4 + qq;
        const int tl_ = wid * 8 + q, t = tile * 64 + tl_;
        const bool lat = t < SEQ;
        float rq, rkv;
        { const u32x2 w = l_cq[qq];
          float s = bflo(w.x) * bflo(w.x) + bfhi(w.x) * bfhi(w.x) + bflo(w.y) * bflo(w.y) + bfhi(w.y) * bfhi(w.y);
          s = wave_sum(s); rq = rsqrtf(s * (1.0f / 256.0f) + EPS);
          const unsigned w2 = l_ckv[qq];
          float s2 = bflo(w2) * bflo(w2) + bfhi(w2) * bfhi(w2);
          s2 = wave_sum(s2); rkv = rsqrtf(s2 * (1.0f / 128.0f) + EPS); }
        const int prow = t >> 6, pcol = 256 + (t & 63);
        {
            float x[16];
            { const u32x4 w0 = l_q0[qq], w1 = l_q1[qq];
                const unsigned ww[8] = {w0.x, w0.y, w0.z, w0.w, w1.x, w1.y, w1.z, w1.w};
#pragma unroll
                for (int i = 0; i < 8; ++i) { x[2 * i] = bflo(ww[i]) * rq; x[2 * i + 1] = bfhi(ww[i]) * rq; } }
            float ss = 0.f;
#pragma unroll
            for (int i = 0; i < 16; ++i) ss += x[i] * x[i];
            ss = oct_sum(ss);
            const float rstd = rsqrtf(ss * (1.0f / 96.0f) + EPS);
            if (act) {
#pragma unroll
                for (int i = 0; i < 16; ++i) x[i] = x[i] * rstd * gqn[sub * 16 + i];
                if (lat && sub >= 4) {
                    const int pos = (sub == 4) ? prow : pcol;
                    const float* cs = TABM + pos * 8; const float* sn = TABM + 320 * 8 + pos * 8;
#pragma unroll
                    for (int i = 0; i < 8; ++i) { const float a = x[i], b2 = x[8 + i], c = cs[i], s = sn[i]; x[i] = a * c - b2 * s; x[8 + i] = b2 * c + a * s; }
                }
#pragma unroll
                for (int i = 0; i < 16; ++i) x[i] *= qscale;
                st_bf16x16(QM + ((size_t)head * T + t) * 96 + sub * 16, x);
            }
        }
        {
            float x[16];
            { const float sc = (sub < 4) ? rkv : 1.0f;
                const u32x4 w0 = l_k0[qq], w1 = l_k1[qq];
                const unsigned ww[8] = {w0.x, w0.y, w0.z, w0.w, w1.x, w1.y, w1.z, w1.w};
#pragma unroll
                for (int i = 0; i < 8; ++i) { x[2 * i] = bflo(ww[i]) * sc; x[2 * i + 1] = bfhi(ww[i]) * sc; } }
            float ss = 0.f;
#pragma unroll
            for (int i = 0; i < 16; ++i) ss += x[i] * x[i];
            ss = oct_sum(ss);
            const float rstd = rsqrtf(ss * (1.0f / 96.0f) + EPS);
            if (act) {
#pragma unroll
                for (int i = 0; i < 16; ++i) x[i] = x[i] * rstd * gkn[sub * 16 + i];
                if (lat && sub >= 4) {
                    const int pos = (sub == 4) ? prow : pcol;
                    const float* cs = TABM + pos * 8; const float* sn = TABM + 320 * 8 + pos * 8;
#pragma unroll
                    for (int i = 0; i < 8; ++i) { const float a = x[i], b2 = x[8 + i], c = cs[i], s = sn[i]; x[i] = a * c - b2 * s; x[8 + i] = b2 * c + a * s; }
                }
                st_fp8x16((unsigned char*)KM + ((size_t)head * T + t) * 96 + sub * 16, x);
            }
        }
        {
            const int hh = lane >> 3, dv0 = (lane & 7) * 8;
            const u32x4 w = l_v[qq];
            u32x4 o; o.x = pk2(bflo(w.x) * rkv, bfhi(w.x) * rkv); o.y = pk2(bflo(w.y) * rkv, bfhi(w.y) * rkv); o.z = pk2(bflo(w.z) * rkv, bfhi(w.z) * rkv); o.w = pk2(bflo(w.w) * rkv, bfhi(w.w) * rkv);
            *(u32x4*)(vs + tl_ * 520 + hh * 64 + dv0) = o;
        }
    }
    }
    __syncthreads();
#pragma unroll 1
    for (int it = 0; it < 4; ++it) {
        const int cid = tid + it * NTHR;
        const int rowc = cid >> 2, pc = cid & 3;
        float e[16];
#pragma unroll
        for (int j = 0; j < 16; ++j) { const int key = kperm8(pc * 16 + j); e[j] = bf2f(vs[key * 520 + rowc]); }
        const int hh = rowc >> 6, dv = rowc & 63;
        st_fp8x16((unsigned char*)VMT + (((size_t)hh * NT64 + tile) * 64 + dv) * 64 + pc * 16, e);
    }
    __syncthreads();
}

DI void ssd_scan(const Params& P) {
    unsigned char* ws = P.ws;
    const bf16_t* __restrict__ ST = (const bf16_t*)(ws + WS_ST); const float* __restrict__ DEC = (const float*)(ws + WS_DEC);
    bf16_t* __restrict__ HIN = (bf16_t*)(ws + WS_HIN);
    const int total = 2 * 8 * 8192;
    static_assert(2 * 8 * 8192 == GRID * NTHR, "one element per thread");
    const int bid_ = opaque_bid();
    const int nsh = (bid_ < 4) ? 0 : ((bid_ < 8) ? 2 : 1);
#pragma unroll 1
    for (int sh = 0; sh < nsh; ++sh) {
        const int e = (sh == 0 ? bid_ : bid_ - 4) * NTHR + opaque_tid();
        const int dh = __builtin_amdgcn_readfirstlane(e >> 13), d = dh >> 3;
        float hst = 0.f;
#pragma unroll 1
        for (int b = 0; b < 5; ++b) {
            bf16_t stv[26]; float dcv[26];
#pragma unroll
            for (int j = 0; j < 26; ++j) {
                const int s = b * 26 + j;
                const int c = (d == 0) ? ((s < 2) ? (128 + s) : (s - 2)) : (129 - s);
                stv[j] = ST[(size_t)c * (16 * 8192) + e]; dcv[j] = DEC[c * 16 + dh];
            }
            __builtin_amdgcn_sched_barrier(0);
#pragma unroll
            for (int j = 0; j < 26; ++j) {
                const int s = b * 26 + j;
                const int c = (d == 0) ? ((s < 2) ? (128 + s) : (s - 2)) : (129 - s);
                HIN[(size_t)c * (16 * 8192) + e] = f2bf(hst);
                hst = hst * dcv[j] + bf2f(stv[j]);
            }
            __builtin_amdgcn_sched_barrier(0);
        }
    }
    (void)total;
}

DI void phase_p3b(const Params& P, int l, char* lds) {
    ssd_scan(P);
    for (int u = blockIdx.x; u < NT64; u += GRID) mla_finalize_unit(P, l, u, lds);
}

DI float gain_bound(const float* g, int n) { float m = 0.f; for (int i = 0; i < n; ++i) m = fmaxf(m, fabsf(g[i])); return m; }

DI void mla_attn_unit(const Params& P, int l, int head, int qb, char* lds, float shift) {
    unsigned char* ws = P.ws;
    const int tid = opaque_tid(), lane = tid & 63, wid = tid >> 6, r = lane & 31, h = lane >> 5;
    const bf16_t* QM = (const bf16_t*)(ws + WS_QM) + (size_t)head * T * 96;
    const unsigned char* KM = (const unsigned char*)(ws + WS_KM) + (size_t)head * T * 96;
    const unsigned char* VMT = (const unsigned char*)(ws + WS_VMT) + (size_t)head * T * 64;
    bf16_t* YA = (bf16_t*)(ws + WS_YA);
    const int kt0 = (qb == NQB - 1) ? (SEQ / 64) : 0, kt1 = NT64;
    f32x16 o[2]; float ls;
    attn_core<96, 64>(lds, QM + (size_t)(qb * 256 + wid * 32) * 96, KM, VMT, kt0, kt1, shift, o, ls);
    const float inv = 1.0f / ls;
    const int t = qb * 256 + wid * 32 + r;
#pragma unroll
    for (int db = 0; db < 2; ++db) { float v[16];
#pragma unroll
        for (int i = 0; i < 16; ++i) v[i] = o[db][i] * inv;
        st_bf16x16(YA + (size_t)t * 512 + head * 64 + db * 32 + 16 * h, v); }
}

DI void dif_attn_unit(const Params& P, int l, int head, int qb, char* lds, float shift, float lam, float lam_init) {
    unsigned char* ws = P.ws;
    const int tid = opaque_tid(), lane = tid & 63, wid = tid >> 6, r = lane & 31, h = lane >> 5;
    const unsigned char* VDT = (const unsigned char*)(ws + WS_VDT) + (size_t)head * T * 128;
    bf16_t* YB = (bf16_t*)(ws + WS_YB);
    float* O1 = (float*)(ws + WS_O1) + (size_t)blockIdx.x * 256 * 128;
    const int kt0 = (qb == NQB - 1) ? (SEQ / 64) : 0, kt1 = NT64;
    const int rowl = wid * 32 + r;
    {
        const int vh = head * 2;
        const bf16_t* QD = (const bf16_t*)(ws + WS_QD) + (size_t)vh * T * 64;
        const unsigned char* KD = (const unsigned char*)(ws + WS_KD) + (size_t)vh * T * 64;
        f32x16 o[4]; float ls;
        attn_core<64, 128>(lds, QD + (size_t)(qb * 256 + wid * 32) * 64, KD, VDT, kt0, kt1, shift, o, ls);
        const float inv = 1.0f / ls;
#pragma unroll
        for (int db = 0; db < 4; ++db)
#pragma unroll
            for (int q = 0; q < 4; ++q)
                *(f32x4*)(O1 + (size_t)rowl * 128 + db * 32 + 16 * h + 4 * q) = (f32x4){o[db][4 * q] * inv, o[db][4 * q + 1] * inv, o[db][4 * q + 2] * inv, o[db][4 * q + 3] * inv};
    }
    {
        const int vh = head * 2 + 1;
        const bf16_t* QD = (const bf16_t*)(ws + WS_QD) + (size_t)vh * T * 64;
        const unsigned char* KD = (const unsigned char*)(ws + WS_KD) + (size_t)vh * T * 64;
        f32x16 o[4]; float ls;
        attn_core<64, 128>(lds, QD + (size_t)(qb * 256 + wid * 32) * 64, KD, VDT, kt0, kt1, shift, o, ls);
        const float inv = 1.0f / ls;
        float ss = 0.f;
#pragma unroll
        for (int db = 0; db < 4; ++db)
#pragma unroll
            for (int q = 0; q < 4; ++q) {
                const f32x4 a = *(const f32x4*)(O1 + (size_t)rowl * 128 + db * 32 + 16 * h + 4 * q);
                o[db][4 * q] = a.x - lam * o[db][4 * q] * inv; o[db][4 * q + 1] = a.y - lam * o[db][4 * q + 1] * inv;
                o[db][4 * q + 2] = a.z - lam * o[db][4 * q + 2] * inv; o[db][4 * q + 3] = a.w - lam * o[db][4 * q + 3] * inv;
                ss += o[db][4 * q] * o[db][4 * q] + o[db][4 * q + 1] * o[db][4 * q + 1] + o[db][4 * q + 2] * o[db][4 * q + 2] + o[db][4 * q + 3] * o[db][4 * q + 3];
            }
        ss += __shfl_xor(ss, 32);
        const float rstd = rsqrtf(ss * (1.0f / 128.0f) + EPS) * (1.0f - lam_init);
        const float* gs = P.in[19] + l * 128;
        const int t = qb * 256 + rowl;
#pragma unroll
        for (int db = 0; db < 4; ++db) { float v[16];
#pragma unroll
            for (int i = 0; i < 16; ++i) v[i] = o[db][i] * rstd * gs[db * 32 + 16 * h + i];
            st_bf16x16(YB + (size_t)t * 512 + head * 128 + db * 32 + 16 * h, v); }
    }
}

DI void ssd_out_unit(const Params& P, int l, int chunk, int hf, int g, char* lds) {
    unsigned char* ws = P.ws;
    const int tid = opaque_tid(), lane = tid & 63, wid = tid >> 6, r = lane & 31, h = lane >> 5;
    const bf16_t* U = (const bf16_t*)(ws + WS_U);
    const bf16_t* XST = (const bf16_t*)(ws + WS_XST); const bf16_t* BCN = (const bf16_t*)(ws + WS_BCN);
    const float* DTS = (const float*)(ws + WS_DTS); const float* CUM = (const float*)(ws + WS_CUM);
    const bf16_t* HIN = (const bf16_t*)(ws + WS_HIN);
    bf16_t* YC = (bf16_t*)(ws + WS_YC);
    const int t0 = chunk * 128;
    char* Bs = lds; char* Cs = lds + 32768; char* Xs = lds + 49152;
    float* dt0 = (float*)(lds + 114688);
    float* dt1 = dt0 + 512; float* cm0 = dt1 + 512; float* cm1 = cm0 + 512;
    float* ssq = cm1 + 512;
    bf16x8 hq[2][8];
    { const int hl_ = wid >> 1, hh_ = 4 * g + hl_, pr_ = perm32(r);
      const bf16_t* hp_ = HIN + (((size_t)chunk * 2 + 0) * 8 + hh_) * 8192;
#pragma unroll
      for (int pb = 0; pb < 2; ++pb)
#pragma unroll
          for (int ks = 0; ks < 8; ++ks) hq[pb][ks] = *(const bf16x8*)(hp_ + (size_t)(pb * 32 + pr_) * 128 + 16 * ks + 8 * h); }
    {
        u32x4 tb_[4], tc_[2], tx_[8]; float ts_[4];
#pragma unroll
        for (int j = 0; j < 4; ++j) { const int i = tid + j * NTHR, row = i >> 4, c = i & 15; tb_[j] = *(const u32x4*)(BCN + (size_t)(t0 + row) * 512 + 128 * g + c * 8); }
#pragma unroll
        for (int j = 0; j < 2; ++j) { const int i = tid + j * NTHR, row = i >> 4, c = i & 15; tc_[j] = *(const u32x4*)(BCN + (size_t)(t0 + hf * 64 + row) * 512 + 256 + 128 * g + c * 8); }
#pragma unroll
        for (int j = 0; j < 8; ++j) { const int i = tid + j * NTHR, row = i >> 4, c = i & 15; tx_[j] = *(const u32x4*)(XST + ((size_t)chunk * 512 + 256 * g + row) * 128 + c * 8); }
        { const int hl_ = tid >> 7, s_ = tid & 127, hh_ = 4 * g + hl_; const size_t b_ = (size_t)(t0 + s_) * 16;
          ts_[0] = DTS[b_ + hh_]; ts_[1] = DTS[b_ + 8 + hh_]; ts_[2] = CUM[b_ + hh_]; ts_[3] = CUM[b_ + 8 + hh_]; }
#pragma unroll
        for (int j = 0; j < 4; ++j) { const int i = tid + j * NTHR, row = i >> 4, c = i & 15; *(u32x4*)(Bs + row * 256 + ((c ^ (row & 15)) << 4)) = tb_[j]; }
#pragma unroll
        for (int j = 0; j < 2; ++j) { const int i = tid + j * NTHR, row = i >> 4, c = i & 15; *(u32x4*)(Cs + row * 256 + ((c ^ (row & 15)) << 4)) = tc_[j]; }
#pragma unroll
        for (int j = 0; j < 8; ++j) { const int i = tid + j * NTHR, row = i >> 4, c = i & 15; *(u32x4*)(Xs + row * 256 + ((c ^ (row & 15)) << 4)) = tx_[j]; }
        dt0[tid] = ts_[0]; dt1[tid] = ts_[1]; cm0[tid] = ts_[2]; cm1[tid] = ts_[3];
    }
    __syncthreads();
    const int hl = wid >> 1, lb = wid & 1, hh = 4 * g + hl;
    const int lrow = hf * 64 + lb * 32 + r;
    const int pr = perm32(r);
    bf16x8 cf[8];
    { const int crow_ = lb * 32 + r;
#pragma unroll
      for (int ks = 0; ks < 8; ++ks) cf[ks] = *(const bf16x8*)(Cs + crow_ * 256 + (((2 * ks + h) ^ (crow_ & 15)) << 4)); }
    const float c0l = cm0[hl * 128 + lrow], c1l = cm1[hl * 128 + lrow];
    f32x16 y[2];
#pragma unroll
    for (int pb = 0; pb < 2; ++pb)
#pragma unroll
        for (int i = 0; i < 16; ++i) y[pb][i] = 0.f;
#define SSD_OFFDIAG(d) do { f32x16 a_[2]; \
        _Pragma("unroll") for (int pb = 0; pb < 2; ++pb) _Pragma("unroll") for (int i = 0; i < 16; ++i) a_[pb][i] = 0.f; \
        _Pragma("unroll") for (int ks = 0; ks < 8; ++ks) _Pragma("unroll") for (int pb = 0; pb < 2; ++pb) a_[pb] = MFMA32(hq[pb][ks], cf[ks], a_[pb]); \
        const float e_ = __expf((d) == 0 ? c0l : c1l); \
        _Pragma("unroll") for (int pb = 0; pb < 2; ++pb) _Pragma("unroll") for (int i = 0; i < 16; ++i) y[pb][i] += e_ * a_[pb][i]; } while (0)
#define SSD_LDH(d) do { const bf16_t* hp_ = HIN + (((size_t)chunk * 2 + (d)) * 8 + hh) * 8192; \
        _Pragma("unroll") for (int pb = 0; pb < 2; ++pb) _Pragma("unroll") for (int ks = 0; ks < 8; ++ks) hq[pb][ks] = *(const bf16x8*)(hp_ + (size_t)(pb * 32 + pr) * 128 + 16 * ks + 8 * h); } while (0)
    SSD_OFFDIAG(0);
    SSD_LDH(1);
#pragma unroll 1
    for (int sb = 0; sb < 4; ++sb) {
        f32x16 x;
#pragma unroll
        for (int i = 0; i < 16; ++i) x[i] = 0.f;
        const int brow = sb * 32 + r;
#pragma unroll
        for (int ks = 0; ks < 8; ++ks) {
            const bf16x8 bf = *(const bf16x8*)(Bs + brow * 256 + (((2 * ks + h) ^ (brow & 15)) << 4));
            x = MFMA32(bf, cf[ks], x);
        }
        float m[16];
#pragma unroll
        for (int q4 = 0; q4 < 4; ++q4) {
            const int s0 = sb * 32 + 8 * q4 + 4 * h;
            const f32x4 vc0 = *(const f32x4*)(cm0 + hl * 128 + s0), vc1 = *(const f32x4*)(cm1 + hl * 128 + s0);
            const f32x4 vd0 = *(const f32x4*)(dt0 + hl * 128 + s0), vd1 = *(const f32x4*)(dt1 + hl * 128 + s0);
#pragma unroll
            for (int jj = 0; jj < 4; ++jj) {
                const int s = s0 + jj;
                const float w0 = (s <= lrow) ? __expf(fminf(c0l - vc0[jj], 0.f)) * vd0[jj] : 0.f;
                const float w1 = (s >= lrow) ? __expf(fminf(c1l - vc1[jj], 0.f)) * vd1[jj] : 0.f;
                m[4 * q4 + jj] = x[4 * q4 + jj] * (w0 + w1);
            }
        }
#pragma unroll
        for (int s2 = 0; s2 < 2; ++s2) {
            u32x4 w; w.x = pk2(m[8 * s2 + 0], m[8 * s2 + 1]); w.y = pk2(m[8 * s2 + 2], m[8 * s2 + 3]); w.z = pk2(m[8 * s2 + 4], m[8 * s2 + 5]); w.w = pk2(m[8 * s2 + 6], m[8 * s2 + 7]);
            const bf16x8 mf = __builtin_bit_cast(bf16x8, w);
#pragma unroll
            for (int pb = 0; pb < 2; ++pb) {
                const int xrow = hl * 64 + pb * 32 + pr, c = 2 * (2 * sb + s2) + h;
                const bf16x8 xf = *(const bf16x8*)(Xs + xrow * 256 + ((c ^ (xrow & 15)) << 4));
                y[pb] = MFMA32(xf, mf, y[pb]);
            }
        }
    }
    SSD_OFFDIAG(1);
#undef SSD_OFFDIAG
#undef SSD_LDH
    const int t = t0 + lrow;
    const float dsk = P.in[24][l * 16 + hh] + P.in[24][l * 16 + 8 + hh];
    float ss = 0.f;
#pragma unroll
    for (int pb = 0; pb < 2; ++pb) {
        const int ch = hh * 64 + pb * 32 + 16 * h;
        const u32x4 z0 = *(const u32x4*)(U + (size_t)t * NIN + U_Z + ch), z1 = *(const u32x4*)(U + (size_t)t * NIN + U_Z + ch + 8);
        const unsigned zw[8] = {z0.x, z0.y, z0.z, z0.w, z1.x, z1.y, z1.z, z1.w};
        const int xpos = (lrow & ~15) | kperm(lrow & 15);
#pragma unroll
        for (int q = 0; q < 8; ++q) {
            const int xr0 = hl * 64 + pb * 32 + 16 * h + 2 * q, xr1 = xr0 + 1;
            const float xa = bf2f(*(const bf16_t*)(Xs + xr0 * 256 + (((xpos >> 3) ^ (xr0 & 15)) << 4) + (xpos & 7) * 2));
            const float xb = bf2f(*(const bf16_t*)(Xs + xr1 * 256 + (((xpos >> 3) ^ (xr1 & 15)) << 4) + (xpos & 7) * 2));
            float v0 = y[pb][2 * q] + dsk * xa, v1 = y[pb][2 * q + 1] + dsk * xb;
            v0 *= siluf_(bflo(zw[q])); v1 *= siluf_(bfhi(zw[q]));
            y[pb][2 * q] = v0; y[pb][2 * q + 1] = v1; ss += v0 * v0 + v1 * v1;
        }
    }
    ss += __shfl_xor(ss, 32);
    if (h == 0) ssq[hl * 64 + lb * 32 + r] = ss;
    __syncthreads();
    const int rr = lb * 32 + r;
    const float tot = ssq[rr] + ssq[64 + rr] + ssq[128 + rr] + ssq[192 + rr];
    const float rstd = rsqrtf(tot * (1.0f / 256.0f) + EPS);
    const float* gn = P.in[25] + l * 512;
#pragma unroll
    for (int pb = 0; pb < 2; ++pb) { const int ch = hh * 64 + pb * 32 + 16 * h; float v[16];
#pragma unroll
        for (int i = 0; i < 16; ++i) v[i] = y[pb][i] * rstd * gn[ch + i];
        st_bf16x16(YC + (size_t)t * 512 + ch, v); }
    __syncthreads();
}

constexpr int P4_DIF = 4 * NQB, P4_MLA = 8 * NQB, P4_SSD = NCHUNK * 4;

DI void phase_p4(const Params& P, int l, char* lds) {
    const int G = GRID;
    const float* ac_ = (const float*)((const int*)(P.ws + WS_CTL) + l * 32 * ECS + 40);
    const float sh_m = ac_[0], sh_d = ac_[1];
    float lam = ac_[2];
    const float lam_init = 0.8f - 0.6f * __expf(-0.3f * (float)l);
    lam += lam_init;
    const bool lastl = (l == NLAYER - 1);
    const int ndif = lastl ? 4 * (NQB - 1) : P4_DIF, nmla = lastl ? 8 * (NQB - 1) : P4_MLA, nssd = lastl ? (NCHUNK - 2) * 4 : P4_SSD;
    for (int v = first_unit(0); v < ndif; v += G) dif_attn_unit(P, l, v & 3, v >> 2, lds, sh_d, lam, lam_init);
    for (int v = first_unit(P4_DIF); v < nmla; v += G) mla_attn_unit(P, l, v & 7, v >> 3, lds, sh_m);
    {
        int* wq = (int*)(P.ws + WS_CTL) + l * 32 * ECS + 32;
        int* sl = (int*)(lds + 160000);
        for (;;) {
            __syncthreads();
            if (opaque_tid() == 0) *sl = __hip_atomic_fetch_add(wq, 1, __ATOMIC_RELAXED, __HIP_MEMORY_SCOPE_AGENT);
            __syncthreads();
            const int v = __builtin_amdgcn_readfirstlane(*sl);
            if (v >= nssd) break;
            ssd_out_unit(P, l, v >> 2, (v >> 1) & 1, v & 1, lds);
        }
    }
}

constexpr int N_PHASES = 2 + 10 * NLAYER;
#ifndef MK_PER_PHASE
#define MK_PER_PHASE 0
#endif

template <bool FUSED>
__global__ void __launch_bounds__(NTHR, 2) mega_fwd(Params P0) {
    extern __shared__ __attribute__((aligned(16))) char lds[];
    const int lo = FUSED ? 0 : P0.ph_lo, hi = FUSED ? N_PHASES : P0.ph_hi;
    constexpr bool fused = FUSED;
    volatile LAS unsigned* xbw = (volatile LAS unsigned*)(lds + LDS_BYTES - 16);
    XcdBarrier bar; bar.bar = (unsigned*)(P0.ws + WS_BAR); bar.x = 0; bar.st = xbw;
    if (fused) {
        if (threadIdx.x == 0) { xbw[0] = 0u; xbw[1] = 0u; xbw[2] = 0u; xbw[3] = 0u; }
        __syncthreads();
        bar = xcd_barrier_post((unsigned*)(P0.ws + WS_BAR), xbw);
    }
#define IN(k) (FUSED || (lo <= (k) && (k) < hi))
#define SEAM(k) do { if (FUSED) { if ((k) + 1 < N_PHASES) { XcdBarrier b2_ = bar; b2_.x = xb_xcc_id(); xcd_barrier(b2_); } } } while (0)
    if (IN(0)) phase_prologue(P0, lds);
    SEAM(0);
    if (IN(1)) phase_rows_norm1(P0, -1, 0);
    SEAM(1);
#pragma unroll 1
    for (int l = 0; l < NLAYER; ++l) {
        const int b = 2 + 10 * l;
        Params Q = P0; { int z = 0; asm volatile("" : "+s"(z)); Q.ws = P0.ws + z; }
        if (IN(b + 0)) phase_gemm_in(Q, l, lds);
        SEAM(b + 0);
        if (IN(b + 1)) phase_p3(Q, l, lds);
        SEAM(b + 1);
        if (IN(b + 2)) phase_p3b(Q, l, lds);
        SEAM(b + 2);
        if (IN(b + 3)) phase_p4(Q, l, lds);
        SEAM(b + 3);
        if (IN(b + 4)) phase_gemm_merge(Q, l, lds);
        SEAM(b + 4);
        if (IN(b + 5)) phase_gemm_out(Q, l, lds);
        SEAM(b + 5);
        if (IN(b + 6)) phase_router(Q, l, lds);
        SEAM(b + 6);
        if (IN(b + 7)) phase_moe_gu(Q, l, lds);
        SEAM(b + 7);
        if (IN(b + 8)) phase_moe_down(Q, l, lds);
        SEAM(b + 8);
        if (IN(b + 9)) phase_rows_norm1(Q, l, l + 1);
        SEAM(b + 9);
    }
#undef IN
#undef SEAM
}


extern "C" void kernel_launch(void* const* d_in, const int* in_sizes, int n_in, void* d_out, int out_size, void* d_ws, size_t ws_size, hipStream_t stream) {
    static int grid = 0;
    if (grid == 0) {
        if (n_in != 36 || ws_size < WS_END) { fprintf(stderr, "kernel_launch: unexpected n_in %d or ws_size %zu (< %zu)\n", n_in, ws_size, (size_t)WS_END); grid = -1; return; }
        int dev = 0, cus = 0;
        if (hipGetDevice(&dev) != hipSuccess || hipDeviceGetAttribute(&cus, hipDeviceAttributeMultiprocessorCount, dev) != hipSuccess) { grid = -1; return; }
        if (hipFuncSetAttribute((const void*)mega_fwd<MK_PER_PHASE == 0>, hipFuncAttributeMaxDynamicSharedMemorySize, LDS_BYTES) != hipSuccess) { fprintf(stderr, "kernel_launch: hipFuncSetAttribute failed\n"); grid = -1; return; }
        int per_cu = 0;
        if (hipOccupancyMaxActiveBlocksPerMultiprocessor(&per_cu, (const void*)mega_fwd<MK_PER_PHASE == 0>, NTHR, LDS_BYTES) != hipSuccess || per_cu < 1) { fprintf(stderr, "kernel_launch: occupancy query says %d\n", per_cu); }
        (void)hipGetLastError();
        if (cus < GRID) { fprintf(stderr, "kernel_launch: built for a %d-CU device, found %d CUs; nothing launched\n", GRID, cus); grid = -1; return; }
        grid = GRID;
    }
    if (grid < 0) return;
    (void)hipMemsetAsync((char*)d_ws + WS_BAR, 0, WS_MOD - WS_BAR, stream);
    Params p{};
    for (int i = 0; i < 36; ++i) p.in[i] = (const float*)d_in[i];
    p.out = (float*)d_out; p.ws = (unsigned char*)d_ws;
#if MK_PER_PHASE
    for (int k = 0; k < N_PHASES; ++k) { p.ph_lo = k; p.ph_hi = k + 1; hipLaunchKernelGGL(mega_fwd<MK_PER_PHASE == 0>, dim3(grid), dim3(NTHR), LDS_BYTES, stream, p); }
#else
    p.ph_lo = 0; p.ph_hi = N_PHASES;
    hipLaunchKernelGGL(mega_fwd<MK_PER_PHASE == 0>, dim3(grid), dim3(NTHR), LDS_BYTES, stream, p);
#endif
}
```

```cpp
#include <hip/hip_runtime.h>
#include <stdint.h>
#include <stdio.h>

#define DI __device__ __forceinline__
#define LAS __attribute__((address_space(3)))
typedef unsigned short bf16_t;
typedef short bf16x8 __attribute__((ext_vector_type(8)));
typedef float f32x16 __attribute__((ext_vector_type(16)));
typedef float f32x4 __attribute__((ext_vector_type(4)));
typedef float f32x2 __attribute__((ext_vector_type(2)));
typedef unsigned u32x4 __attribute__((ext_vector_type(4)));
typedef unsigned u32x2 __attribute__((ext_vector_type(2)));
typedef __bf16 bf16x2v __attribute__((ext_vector_type(2)));
typedef int i32x4 __attribute__((ext_vector_type(4)));

DI unsigned pk2(float a, float b) { f32x2 v = {a, b}; return __builtin_bit_cast(unsigned, __builtin_convertvector(v, bf16x2v)); }
typedef int i32x8 __attribute__((ext_vector_type(8)));
DI unsigned pk_fp8x4(float a, float b, float c, float d) { int v = __builtin_amdgcn_cvt_pk_fp8_f32(a, b, 0, false); v = __builtin_amdgcn_cvt_pk_fp8_f32(c, d, v, true); return (unsigned)v; }
DI unsigned pk_bf8x4(float a, float b, float c, float d) { int v = __builtin_amdgcn_cvt_pk_bf8_f32(a, b, 0, false); v = __builtin_amdgcn_cvt_pk_bf8_f32(c, d, v, true); return (unsigned)v; }
typedef short s16x2 __attribute__((ext_vector_type(2)));
DI unsigned pk_bf8x4s(float a, float b, float c, float d, float sc) {
    s16x2 r; asm volatile("" : "=v"(r));
    r = __builtin_amdgcn_cvt_scalef32_pk_bf8_f32(r, a, b, sc, false); r = __builtin_amdgcn_cvt_scalef32_pk_bf8_f32(r, c, d, sc, true); return __builtin_bit_cast(unsigned, r); }
DI void st_fp8x16(unsigned char* p, const float* v) {
    u32x4 w; w.x = pk_fp8x4(v[0], v[1], v[2], v[3]); w.y = pk_fp8x4(v[4], v[5], v[6], v[7]); w.z = pk_fp8x4(v[8], v[9], v[10], v[11]); w.w = pk_fp8x4(v[12], v[13], v[14], v[15]);
    *(u32x4*)p = w;
}
DI bf16_t f2bf(float a) { return (bf16_t)(pk2(a, 0.f) & 0xffffu); }
DI float bf2f(bf16_t v) { return __uint_as_float(((unsigned)v) << 16); }
DI float bflo(unsigned w) { return __uint_as_float(w << 16); }
DI float bfhi(unsigned w) { return __uint_as_float(w & 0xffff0000u); }
template <int CTRL, int RM> DI float dpp_add(float v) { const int y = __builtin_amdgcn_update_dpp(0, __float_as_int(v), CTRL, RM, 0xF, false); return v + __int_as_float(y); }
DI float quad_sum(float v) { v = dpp_add<0xB1, 0xF>(v); v = dpp_add<0x4E, 0xF>(v); return v; }
DI float oct_sum(float v) { v = quad_sum(v); v = dpp_add<0x141, 0xF>(v); return v; }
DI float wave_sum(float v) { v = oct_sum(v); v = dpp_add<0x140, 0xF>(v); v = dpp_add<0x142, 0xA>(v); v = dpp_add<0x143, 0xC>(v);
    return __int_as_float(__builtin_amdgcn_readlane(__float_as_int(v), 63)); }
template <int CTRL, int RM> DI float dpp_max(float v) { const int y = __builtin_amdgcn_update_dpp(__float_as_int(v), __float_as_int(v), CTRL, RM, 0xF, false); return fmaxf(v, __int_as_float(y)); }
DI float wave_max(float v) { v = dpp_max<0xB1, 0xF>(v); v = dpp_max<0x4E, 0xF>(v); v = dpp_max<0x141, 0xF>(v); v = dpp_max<0x140, 0xF>(v); v = dpp_max<0x142, 0xA>(v); v = dpp_max<0x143, 0xC>(v);
    return __int_as_float(__builtin_amdgcn_readlane(__float_as_int(v), 63)); }
DI unsigned pack_i8x4(float a, float b, float c, float d) {
    const int ia = (int)fminf(fmaxf(rintf(a), -127.f), 127.f), ib = (int)fminf(fmaxf(rintf(b), -127.f), 127.f), ic = (int)fminf(fmaxf(rintf(c), -127.f), 127.f), id = (int)fminf(fmaxf(rintf(d), -127.f), 127.f);
    return (unsigned)(ia & 0xff) | ((unsigned)(ib & 0xff) << 8) | ((unsigned)(ic & 0xff) << 16) | ((unsigned)(id & 0xff) << 24); }
DI float lane_xor1(float v) { return __int_as_float(__builtin_amdgcn_update_dpp(0, __float_as_int(v), 0xB1, 0xF, 0xF, false)); }
DI int opaque_tid() { int t = threadIdx.x; asm volatile("" : "+v"(t)); return t; }
DI int opaque_bid() { int b = blockIdx.x; asm volatile("" : "+s"(b)); return b; }
DI float fexp2(float x) { return __builtin_amdgcn_exp2f(x); }
DI float fexp(float x) { return __builtin_amdgcn_exp2f(x * 1.4426950408889634f); }
DI float frcp(float x) { return __builtin_amdgcn_rcpf(x); }
DI float sigmoidf_(float x) { return __builtin_amdgcn_rcpf(1.0f + __builtin_amdgcn_exp2f(-1.4426950408889634f * x)); }
DI float siluf_(float x) { return x * sigmoidf_(x); }

#define XB_TMO      128
#define XB_XCNT(j)  (256  + 64 * (j))
#define XB_XSUB(j)  (1280 + 64 * (j))
#define XB_XGEN(j)  (2304 + 64 * (j))
#define XB_TOP      3328
#define XB_TOPGEN   3392
#define XCD_BAR_WORDS 3456
#define XB_SPIN_CAP (1u << 18)
__device__ __forceinline__ unsigned xb_ld(unsigned* p)              { return __hip_atomic_load(p, __ATOMIC_RELAXED, __HIP_MEMORY_SCOPE_AGENT); }
__device__ __forceinline__ unsigned xb_add(unsigned* p, unsigned v) { return __hip_atomic_fetch_add(p, v, __ATOMIC_RELAXED, __HIP_MEMORY_SCOPE_AGENT); }
__device__ __forceinline__ unsigned xb_xcc_id() { return (unsigned)__builtin_amdgcn_s_getreg((3 << 11) | 20) & 0xFu; }
#define XB_SPIN(cond, bar) do { unsigned _sp = 0; while (cond) { __builtin_amdgcn_s_sleep(1); \
    if ((++_sp & 255u) == 0u) { if (xb_ld(&(bar)[XB_TMO])) break; if (_sp > XB_SPIN_CAP) { atomicAdd(&(bar)[XB_TMO], 1u); break; } } } } while (0)
struct XcdBarrier { unsigned* bar; unsigned x; volatile LAS unsigned* st; };
__device__ __forceinline__ XcdBarrier xcd_barrier_post(unsigned* bar, volatile LAS unsigned* st) {
    XcdBarrier b; b.bar = bar; b.x = xb_xcc_id(); b.st = st;
    if (threadIdx.x == 0) (void)xb_add(&bar[XB_XCNT(b.x)], 1u);
    return b;
}
__device__ __forceinline__ void xcd_barrier_complete(unsigned* bar, unsigned x, unsigned& nloc, unsigned& nx) {
    const unsigned G = gridDim.x * gridDim.y * gridDim.z;
    unsigned sum, cnt, mine, sp = 0u;
    for (;;) {
        sum = 0u; cnt = 0u; mine = 0u;
#pragma unroll
        for (unsigned j = 0; j < 16; ++j) { const unsigned c = xb_ld(&bar[XB_XCNT(j)]); sum += c; cnt += (c > 0u) ? 1u : 0u; mine = (j == x) ? c : mine; }
        if (sum == G) break;
        __builtin_amdgcn_s_sleep(1);
        if ((++sp & 255u) == 0u) { if (xb_ld(&bar[XB_TMO])) break; if (sp > XB_SPIN_CAP) { atomicAdd(&bar[XB_TMO], 1u); break; } }
    }
    nloc = mine > 0u ? mine : 1u; nx = cnt > 0u ? cnt : 1u;
}
__device__ __forceinline__ void xcd_barrier(const XcdBarrier& b) {
    asm volatile("s_waitcnt vmcnt(0)" ::: "memory");
    __syncthreads();
    if (threadIdx.x == 0) {
        unsigned* bar = b.bar;
        __builtin_amdgcn_s_waitcnt(0);
        unsigned nloc = b.st[0], nx = b.st[1];
        if (nloc == 0u) { xcd_barrier_complete(bar, b.x, nloc, nx); b.st[0] = nloc; b.st[1] = nx; }
        const unsigned old = xb_add(&bar[XB_XSUB(b.x)], 1u);
        const unsigned gen = old / nloc;
        if (old + 1u == (gen + 1u) * nloc) {
            __builtin_amdgcn_fence(__ATOMIC_RELEASE, "agent");
            asm volatile("s_waitcnt vmcnt(0)" ::: "memory");
            const unsigned og = xb_add(&bar[XB_TOP], 1u);
            const unsigned tg = og / nx;
            if (og + 1u == (tg + 1u) * nx) xb_add(&bar[XB_TOPGEN], 1u);
            else XB_SPIN(xb_ld(&bar[XB_TOPGEN]) == tg, bar);
            __builtin_amdgcn_fence(__ATOMIC_ACQUIRE, "agent");
            xb_add(&bar[XB_XGEN(b.x)], 1u);
            asm volatile("s_waitcnt vmcnt(0)" ::: "memory");
        } else {
            XB_SPIN(xb_ld(&bar[XB_XGEN(b.x)]) == gen, bar);
            __builtin_amdgcn_fence(__ATOMIC_ACQUIRE, "agent");
            asm volatile("s_waitcnt vmcnt(0)" ::: "memory");
        }
    }
    __syncthreads();
}

constexpr int DM = 1024, SEQ = 16384, CTXN = 256, T = SEQ + CTXN, NLAYER = 4;
constexpr int NIN = 6912;
constexpr int U_CQ = 0, U_CKV = 256, U_KR = 384, U_DQ = 512, U_DK = 1024, U_DV = 1536, U_Z = 2048, U_XS = 2560, U_B = 3072, U_C = 3328, U_DT = 3584, U_G = 3840;
constexpr int NT64 = T / 64, NCHUNK = T / 128, NQB = T / 256;
constexpr int NEXP = 32, DFF = 1024;
constexpr int MOE_ROWS = 74752;
constexpr float EPS = 1e-6f;
constexpr float LOG2E = 1.4426950408889634f;
constexpr int NTHR = 512;
constexpr int GRID = 256;
constexpr int LDS_BYTES = 160 * 1024 - 256;

constexpr size_t al256(size_t x) { return (x + 255) & ~(size_t)255; }
constexpr size_t WS_BAR   = 0;
constexpr size_t WS_CTL   = al256(WS_BAR + XCD_BAR_WORDS * 4);
constexpr int ECS = 64;
constexpr size_t WS_MOD   = al256(WS_CTL + (size_t)NLAYER * 32 * ECS * 4);
constexpr size_t WS_TAB   = al256(WS_MOD + (size_t)NLAYER * 2 * 6144 * 4);
constexpr size_t TAB_FLOATS = (256 + 64) * 8 * 2 + (256 + 64) * 16 * 2;
constexpr size_t WS_WRT   = al256(WS_TAB + TAB_FLOATS * 4);
constexpr size_t WS_WIN   = al256(WS_WRT + (size_t)NLAYER * 32 * 1024 * 4);
constexpr size_t SZ_WIN   = (size_t)NIN * 1024;
constexpr size_t WS_WUQ   = al256(WS_WIN + NLAYER * SZ_WIN);
constexpr size_t SZ_WUQ   = (size_t)768 * 256 * 2;
constexpr size_t WS_WUKV  = al256(WS_WUQ + NLAYER * SZ_WUQ);
constexpr size_t SZ_WUKV  = (size_t)1024 * 256 * 2;
constexpr size_t WS_WUP   = al256(WS_WUKV + NLAYER * SZ_WUKV);
constexpr size_t SZ_WUP   = (size_t)3 * 1024 * 512 * 2;
constexpr size_t WS_WOUT  = al256(WS_WUP + NLAYER * SZ_WUP);
constexpr size_t SZ_WOUT  = (size_t)1024 * 1024 * 2;
constexpr size_t WS_WGU   = al256(WS_WOUT + NLAYER * SZ_WOUT);
constexpr size_t SZ_WGU   = (size_t)32 * 2048 * 1024;
constexpr size_t WS_WDN   = al256(WS_WGU + NLAYER * SZ_WGU);
constexpr size_t SZ_WDN   = (size_t)32 * 1024 * 1024 * 2;
constexpr size_t WS_XCUR  = al256(WS_WDN + NLAYER * SZ_WDN);
constexpr size_t WS_H     = al256(WS_XCUR + (size_t)T * 1024 * 4);
constexpr size_t WS_U     = al256(WS_H + (size_t)T * 1024 * 2);
constexpr size_t WS_DTR   = al256(WS_U + (size_t)T * NIN * 2);
constexpr size_t WS_QRAW  = al256(WS_DTR + (size_t)T * 16 * 4);
constexpr size_t WS_KVRAW = al256(WS_QRAW + (size_t)T * 768 * 2);
constexpr size_t WS_QM    = al256(WS_KVRAW + (size_t)T * 1024 * 2);
constexpr size_t WS_KM    = al256(WS_QM + (size_t)8 * T * 96 * 2);
constexpr size_t WS_VMT   = al256(WS_KM + (size_t)8 * T * 96 * 2);
constexpr size_t WS_QD    = al256(WS_VMT + (size_t)8 * T * 64 * 2);
constexpr size_t WS_KD    = al256(WS_QD + (size_t)8 * T * 64 * 2);
constexpr size_t WS_VDT   = al256(WS_KD + (size_t)8 * T * 64 * 2);
constexpr size_t WS_XSN   = al256(WS_VDT + (size_t)4 * T * 128 * 2);
constexpr size_t WS_XST   = al256(WS_XSN + (size_t)T * 512 * 2);
constexpr size_t WS_BCN   = al256(WS_XST + (size_t)T * 512 * 2);
constexpr size_t WS_DTS   = al256(WS_BCN + (size_t)T * 512 * 2);
constexpr size_t WS_CUM   = al256(WS_DTS + (size_t)T * 16 * 4);
constexpr size_t WS_ST    = al256(WS_CUM + (size_t)T * 16 * 4);
constexpr size_t WS_DEC   = al256(WS_ST + (size_t)NCHUNK * 16 * 8192 * 2);
constexpr size_t WS_HIN   = al256(WS_DEC + (size_t)NCHUNK * 16 * 4);
constexpr size_t WS_YA    = al256(WS_HIN + (size_t)NCHUNK * 16 * 8192 * 2);
constexpr size_t WS_YB    = al256(WS_YA + (size_t)T * 512 * 2);
constexpr size_t WS_YC    = al256(WS_YB + (size_t)T * 512 * 2);
constexpr size_t WS_O1    = al256(WS_YC + (size_t)T * 512 * 2);
constexpr size_t WS_MRG   = al256(WS_O1 + (size_t)320 * 256 * 128 * 4);
constexpr size_t WS_TOPE  = al256(WS_MRG + (size_t)T * 1024 * 2);
constexpr size_t WS_TOPP  = al256(WS_TOPE + (size_t)T * 16);
constexpr size_t WS_TOPG  = al256(WS_TOPP + (size_t)T * 16);
constexpr size_t WS_ELIST = al256(WS_TOPG + (size_t)T * 16);
constexpr size_t WS_ACT   = al256(WS_ELIST + (size_t)32 * T * 4);
constexpr size_t WS_YMOE  = al256(WS_ACT + (size_t)MOE_ROWS * 1024 * 2);
constexpr size_t WS_XG    = al256(WS_YMOE + (size_t)MOE_ROWS * 1024 * 2);
constexpr size_t WS_XGS   = al256(WS_XG + (size_t)32 * T * 1024);
constexpr size_t WS_WGS   = al256(WS_XGS + (size_t)32 * T * 4);
constexpr size_t WS_WINS  = al256(WS_WGS + (size_t)NLAYER * 32 * 2048 * 4);
constexpr size_t WS_HS    = al256(WS_WINS + (size_t)NLAYER * NIN * 4);
constexpr size_t WS_END   = al256(WS_HS + (size_t)T * 4);

struct Params {
    const float* in[36];
    float* out;
    unsigned char* ws;
    int ph_lo, ph_hi;
};

DI int perm32(int r) { return 16 * ((r >> 2) & 1) + 4 * (r >> 3) + (r & 3); }
DI int swz128(int row, int chunk) { return row * 128 + ((chunk ^ ((row >> 1) & 7)) << 4); }

#define MFMA32(a, b, c) __builtin_amdgcn_mfma_f32_32x32x16_bf16((a), (b), (c), 0, 0, 0)

template <int NI> struct GemmAcc { f32x16 a[4][NI]; };

template <int NI, class ARow, int MI = 4>
DI void gemm_tile(char* lds, const ARow& arow, const bf16_t* __restrict__ Bt, int ldb, int K, GemmAcc<NI>& acc) {
    const int tid = opaque_tid(), lane = tid & 63, wid = tid >> 6, wr = wid >> 2, wc = wid & 3, r = lane & 31, h = lane >> 5;
    const int lrow = tid >> 3, lc = tid & 7;
    constexpr int NB = 2 * NI;
    constexpr int STG = 32768 + 16384 * NI;
    const bf16_t* ap[MI];
#pragma unroll
    for (int i = 0; i < MI; ++i) ap[i] = arow(lrow + 64 * i) + lc * 8;
    const bf16_t* bp = Bt + (size_t)lrow * ldb + lc * 8;
    const int woff = swz128(lrow, lc);
#pragma unroll
    for (int mi = 0; mi < MI; ++mi)
#pragma unroll
        for (int ni = 0; ni < NI; ++ni)
#pragma unroll
            for (int i = 0; i < 16; ++i) acc.a[mi][ni][i] = 0.f;
    u32x4 ra0[MI], rb0[NB], ra1[MI], rb1[NB];
#define GT_LOAD(RA, RB, ko) do { _Pragma("unroll") for (int i = 0; i < MI; ++i) RA[i] = *(const u32x4*)(ap[i] + (ko)); \
        _Pragma("unroll") for (int i = 0; i < NB; ++i) RB[i] = *(const u32x4*)(bp + (size_t)i * 64 * ldb + (ko)); } while (0)
#define GT_STORE(RA, RB, so) do { _Pragma("unroll") for (int i = 0; i < MI; ++i) *(u32x4*)(lds + (so) + woff + i * 8192) = RA[i]; \
        _Pragma("unroll") for (int i = 0; i < NB; ++i) *(u32x4*)(lds + (so) + 32768 + woff + i * 8192) = RB[i]; } while (0)
    const int nk = K >> 6;
    const int xsw = (r >> 1) & 7;
    const int pr = perm32(r), wsw = (pr >> 1) & 7;
    const int xbase = (wr * 32 * MI + r) * 128, wbase = 32768 + (wc * 32 * NI + pr) * 128;
#define GT_COMPUTE(st) do { _Pragma("unroll") for (int ks = 0; ks < 4; ++ks) { bf16x8 wf[NI], xf[MI]; \
        _Pragma("unroll") for (int ni = 0; ni < NI; ++ni) wf[ni] = *(const bf16x8*)(lds + (st) + wbase + ni * 4096 + (((2 * ks + h) ^ wsw) << 4)); \
        _Pragma("unroll") for (int mi = 0; mi < MI; ++mi) xf[mi] = *(const bf16x8*)(lds + (st) + xbase + mi * 4096 + (((2 * ks + h) ^ xsw) << 4)); \
        _Pragma("unroll") for (int mi = 0; mi < MI; ++mi) _Pragma("unroll") for (int ni = 0; ni < NI; ++ni) acc.a[mi][ni] = MFMA32(wf[ni], xf[mi], acc.a[mi][ni]); } } while (0)
    GT_LOAD(ra0, rb0, 0);
    GT_STORE(ra0, rb0, 0);
    GT_LOAD(ra1, rb1, 64);
    __syncthreads();
    for (int kt = 0; kt < nk; kt += 2) {
        if (kt + 2 < nk) GT_LOAD(ra0, rb0, (kt + 2) * 64);
        GT_COMPUTE(0);
        GT_STORE(ra1, rb1, STG);
        __syncthreads();
        if (kt + 3 < nk) GT_LOAD(ra1, rb1, (kt + 3) * 64);
        GT_COMPUTE(STG);
        if (kt + 2 < nk) GT_STORE(ra0, rb0, 0);
        __syncthreads();
    }
#undef GT_LOAD
#undef GT_STORE
#undef GT_COMPUTE
}

struct ARowPlain { const bf16_t* base; size_t ld; DI const bf16_t* operator()(int row) const { return base + (size_t)row * ld; } };
struct ARowGather { const bf16_t* base; const int* idx; DI const bf16_t* operator()(int row) const { return base + (size_t)idx[row] * 1024; } };

DI void st_bf16x16(bf16_t* p, const float* v) {
    u32x4 a, b;
    a.x = pk2(v[0], v[1]); a.y = pk2(v[2], v[3]); a.z = pk2(v[4], v[5]); a.w = pk2(v[6], v[7]);
    b.x = pk2(v[8], v[9]); b.y = pk2(v[10], v[11]); b.z = pk2(v[12], v[13]); b.w = pk2(v[14], v[15]);
    *(u32x4*)p = a; *(u32x4*)(p + 8) = b;
}

namespace g8 {
constexpr int BK = 64, HALF = 128, HTB = HALF * BK * 2, STAGE_BYTES = 8 * HTB;
DI int lds_byte(int r, int c) { const int st = (r >> 4) * 2 + (c >> 5), rr = r & 15, cc = c & 31, ob = rr * 64 + cc * 2; return st * 1024 + (ob ^ (((ob >> 9) & 1) << 5)); }
DI void stage_rc(int b, int& R, int& C) { const int st = b / 1024, sb = b % 1024, swz = sb ^ (((sb >> 9) & 1) << 5); R = (st >> 1) * 16 + swz / 64; C = (st & 1) * 32 + (swz % 64) / 2; }
DI int perm32g(int rho) { const int n = rho >> 4, i = rho & 15; return 8 * (i >> 2) + 4 * n + (i & 3); }
struct Unit { const char* a; const char* b; int t0, t1; };
typedef f32x4 Acc[2][2][4][2];
typedef i32x4 AccI[2][2][4][2];
template <bool I8> struct AccSel { typedef f32x4 T; };
template <> struct AccSel<true> { typedef i32x4 T; };

template <bool PERM, bool I8 = false, class Sched, class Epi>
DI void gemm_phase(LAS unsigned char* lds, const int K, const int lda, const Sched& S, const Epi& E) {
    typedef typename AccSel<I8>::T AT_;
    const int tid = opaque_tid(), wid = __builtin_amdgcn_readfirstlane(tid >> 6), lane = tid & 63, wr = wid >> 2, wc = wid & 3, fr = lane & 15, fq = lane >> 4;
    const int nt = K / BK;
    unsigned voffA[2], voffB[2];
#pragma unroll
    for (int i = 0; i < 2; ++i) { int R, C; stage_rc(tid * 16 + i * 8192, R, C); const int Rb = PERM ? ((R & ~31) + perm32g(R & 31)) : R;
        voffA[i] = (unsigned)(R * lda + C) * 2u; voffB[i] = (unsigned)(Rb * K + C) * 2u; }
    const size_t kstep = (size_t)(BK * 2);
    const size_t hstepA = (size_t)HALF * lda * 2, hstepB = (size_t)HALF * K * 2;
    const unsigned ldsw = (unsigned)wid * 1024u;
    const int aoff = lds_byte(wr * 64 + fr, fq * 8), boff = lds_byte(wc * 32 + fr, fq * 8);
#define G8_SA(b, h) (((b) * 2 + (h)) * HTB)
#define G8_SB(b, h) ((4 + (b) * 2 + (h)) * HTB)
#define G8_STAGE(bufoff, gbase, voff) do { _Pragma("unroll") for (int _i = 0; _i < 2; ++_i) \
        __builtin_amdgcn_global_load_lds((const unsigned*)((const char*)(gbase) + (voff)[_i]), (LAS unsigned*)(lds + (bufoff) + ldsw + _i * 8192), 16, 0, 0); } while (0)
#define G8_LDA(dst, b, h) do { _Pragma("unroll") for (int m = 0; m < 4; ++m) _Pragma("unroll") for (int k = 0; k < 2; ++k) dst[m][k] = *(const LAS bf16x8*)(lds + G8_SA(b, h) + aoff + m * 2048 + k * 1024); } while (0)
#define G8_LDB(dst, b, h) do { _Pragma("unroll") for (int n = 0; n < 2; ++n) _Pragma("unroll") for (int k = 0; k < 2; ++k) dst[n][k] = *(const LAS bf16x8*)(lds + G8_SB(b, h) + boff + n * 2048 + k * 1024); } while (0)
#define G8_MMA(ai, bj, At, Bt) do { __builtin_amdgcn_s_setprio(1); _Pragma("unroll") for (int m = 0; m < 4; ++m) _Pragma("unroll") for (int n = 0; n < 2; ++n) _Pragma("unroll") for (int k = 0; k < 2; ++k) \
        { if constexpr (I8) acc[ai][bj][m][n] = __builtin_amdgcn_mfma_i32_16x16x64_i8(__builtin_bit_cast(i32x4, Bt[n][k]), __builtin_bit_cast(i32x4, At[m][k]), acc[ai][bj][m][n], 0, 0, 0); \
          else acc[ai][bj][m][n] = __builtin_amdgcn_mfma_f32_16x16x32_bf16(Bt[n][k], At[m][k], acc[ai][bj][m][n], 0, 0, 0); } __builtin_amdgcn_s_setprio(0); } while (0)
#define G8_WAIT_V(n) asm volatile("s_waitcnt vmcnt(" #n ")" ::: "memory")
#define G8_WAIT_L(n) asm volatile("s_waitcnt lgkmcnt(" #n ")" ::: "memory")
#define G8_BAR __builtin_amdgcn_s_barrier()
#define G8_SCHED __builtin_amdgcn_sched_barrier(0)
    Unit cur, nxt; int ui = 0;
    if (!S.next(0, cur)) return;
    AT_ acc[2][2][4][2];
#pragma unroll
    for (int a = 0; a < 2; ++a)
#pragma unroll
        for (int b = 0; b < 2; ++b)
#pragma unroll
            for (int m = 0; m < 4; ++m)
#pragma unroll
                for (int n = 0; n < 2; ++n) acc[a][b][m][n] = AT_{};
    bf16x8 At[4][2], B0[2][2], B1[2][2];
    const char* cA = cur.a; const char* cB = cur.b;
    G8_STAGE(G8_SB(0, 0), cB, voffB); G8_STAGE(G8_SA(0, 0), cA, voffA); G8_STAGE(G8_SB(0, 1), cB + hstepB, voffB); G8_STAGE(G8_SA(0, 1), cA + hstepA, voffA);
    if (wr == 1) G8_BAR;
    G8_WAIT_V(4); G8_BAR;
    G8_STAGE(G8_SB(1, 0), cB + kstep, voffB); G8_STAGE(G8_SA(1, 0), cA + kstep, voffA); G8_STAGE(G8_SB(1, 1), cB + hstepB + kstep, voffB);
    G8_WAIT_V(6); G8_BAR;
    for (;;) {
        const bool has_next = S.next(ui + 1, nxt);
        const char* nA = has_next ? nxt.a : cA; const char* nB = has_next ? nxt.b : cB;
        for (int t = 0; t < nt; t += 2) {
            const bool last = (t == nt - 2);
            const char* a1 = cA + (size_t)(t + 1) * kstep;
            const char* a2 = last ? nA : cA + (size_t)(t + 2) * kstep; const char* b2 = last ? nB : cB + (size_t)(t + 2) * kstep;
            const char* a3 = a2 + kstep; const char* b3 = b2 + kstep;
            G8_LDB(B0, 0, 0); G8_SCHED; G8_LDA(At, 0, 0); G8_STAGE(G8_SA(1, 1), a1 + hstepA, voffA);
            G8_WAIT_L(8); G8_BAR; G8_WAIT_L(0); G8_MMA(0, 0, At, B0); G8_BAR; G8_SCHED;
            G8_LDB(B1, 0, 1); G8_STAGE(G8_SB(0, 0), b2, voffB);
            G8_BAR; G8_WAIT_L(0); G8_MMA(0, 1, At, B1); G8_BAR;
            G8_LDA(At, 0, 1); G8_STAGE(G8_SA(0, 0), a2, voffA);
            G8_BAR; G8_WAIT_L(0); G8_MMA(1, 0, At, B0); G8_BAR; G8_SCHED;
            G8_STAGE(G8_SB(0, 1), b2 + hstepB, voffB);
            G8_WAIT_V(6); G8_BAR; G8_MMA(1, 1, At, B1); G8_BAR;
            G8_LDB(B0, 1, 0); G8_SCHED; G8_LDA(At, 1, 0); G8_STAGE(G8_SA(0, 1), a2 + hstepA, voffA);
            G8_WAIT_L(8); G8_BAR; G8_WAIT_L(0); G8_MMA(0, 0, At, B0); G8_BAR; G8_SCHED;
            G8_LDB(B1, 1, 1); G8_STAGE(G8_SB(1, 0), b3, voffB);
            G8_BAR; G8_WAIT_L(0); G8_MMA(0, 1, At, B1); G8_BAR;
            G8_LDA(At, 1, 1); G8_STAGE(G8_SA(1, 0), a3, voffA);
            G8_BAR; G8_WAIT_L(0); G8_MMA(1, 0, At, B0); G8_BAR; G8_SCHED;
            G8_STAGE(G8_SB(1, 1), b3 + hstepB, voffB);
            G8_WAIT_V(6); G8_BAR; G8_MMA(1, 1, At, B1); G8_BAR;
        }
        E(acc, cur, wr, wc, fr, fq);
        if (!has_next) break;
#pragma unroll
        for (int a = 0; a < 2; ++a)
#pragma unroll
            for (int b = 0; b < 2; ++b)
#pragma unroll
                for (int m = 0; m < 4; ++m)
#pragma unroll
                    for (int n = 0; n < 2; ++n) acc[a][b][m][n] = AT_{};
        cur = nxt; cA = nA; cB = nB; ++ui;
    }
    G8_WAIT_V(0);
    if (wr == 0) G8_BAR;
    G8_BAR;
#undef G8_SA
#undef G8_SB
#undef G8_STAGE
#undef G8_LDA
#undef G8_LDB
#undef G8_MMA
#undef G8_WAIT_V
#undef G8_WAIT_L
#undef G8_BAR
#undef G8_SCHED
}

template <int nM, int nN>
struct GridSched {
    const char* A; const char* Bt; size_t astep, bstep; int c; int gs;
    DI void init(const void* A_, size_t lda, const void* Bt_, int K) { A = (const char*)A_; Bt = (const char*)Bt_; astep = 256 * lda * 2; bstep = (size_t)256 * K * 2; c = blockIdx.x; asm volatile("" : "+s"(c)); gs = GRID; }
    DI bool next(int i, Unit& u) const {
        constexpr int nwg = nM * nN;
        const int L = i * gs + c; if (L >= nwg) return false;
        int wgid = L; { constexpr int q = nwg / 8, r = nwg % 8; const int xcd = wgid % 8, off = wgid / 8; wgid = (xcd < r ? xcd * (q + 1) : r * (q + 1) + (xcd - r) * q) + off; }
        constexpr int nig = 8 * nN; const int gid = wgid / nig, fm = gid * 8, gsz = (nM - fm) < 8 ? (nM - fm) : 8;
        const int rem = wgid % nig;
        static_assert((nM % 8) == 0 || (nM % 8) == 1 || (nM % 8) == 2 || (nM % 8) == 4, "partial row-tile group must be a power of two");
        const int sh = __builtin_ctz(gsz);
        const int pm = fm + (rem & (gsz - 1)), pn = rem >> sh;
        u.a = A + (size_t)pm * astep; u.b = Bt + (size_t)pn * bstep; u.t0 = pm; u.t1 = pn; return true;
    }
};
}

template <int DK, int DV>
DI void attn_core(char* lds, const bf16_t* __restrict__ Qrows  , const unsigned char* __restrict__ Kt, const unsigned char* __restrict__ Vt,
                  int kt0, int kt1, float shift, f32x16 (&o)[DV / 32], float& lsum_out) {
    constexpr int KCH = DK / 16;
    constexpr int KROWB = (DK == 96) ? 128 : 64;
    constexpr int KSTG = 64 * KROWB, VSTG = DV * 64;
    constexpr int VBASE = 8 * KSTG;
    constexpr int NKP = KSTG / 1024, NVP = VSTG / 1024;
    constexpr int KTILEB = 64 * DK, VTILEB = DV * 64;
    const int tid = opaque_tid(), lane = tid & 63, r = lane & 31, h = lane >> 5;
    const int wid = __builtin_amdgcn_readfirstlane(tid >> 6);
    i32x8 qf8[(DK + 63) / 64];
    {
        const bf16_t* qp = Qrows + (size_t)r * DK;
#pragma unroll
        for (int st = 0; st < (DK + 63) / 64; ++st) {
            const int e0 = (st == 0) ? 32 * h : 64;
            unsigned d[8];
#pragma unroll
            for (int j = 0; j < 4; ++j) { const u32x4 w = *(const u32x4*)(qp + e0 + 8 * j);
                d[2 * j] = pk_fp8x4(bflo(w.x) * 8.0f, bfhi(w.x) * 8.0f, bflo(w.y) * 8.0f, bfhi(w.y) * 8.0f);
                d[2 * j + 1] = pk_fp8x4(bflo(w.z) * 8.0f, bfhi(w.z) * 8.0f, bflo(w.w) * 8.0f, bfhi(w.w) * 8.0f); }
            if (st == 1 && h == 1) {
#pragma unroll
                for (int j = 0; j < 8; ++j) d[j] = 0u;
            }
            qf8[st] = (i32x8){(int)d[0], (int)d[1], (int)d[2], (int)d[3], (int)d[4], (int)d[5], (int)d[6], (int)d[7]};
        }
    }
#define MFMA8(a, b, c) __builtin_amdgcn_mfma_scale_f32_32x32x64_f8f6f4((a), (b), (c), 0, 0, 0, 0x7F7F7F7F, 0, 0x7C7C7C7C)
#pragma unroll
    for (int db = 0; db < DV / 32; ++db)
#pragma unroll
        for (int i = 0; i < 16; ++i) o[db][i] = 0.f;
    const f32x16 cvec = {0.f, 0.f, 0.f, 0.f, 0.f, 0.f, 0.f, 0.f, 0.f, 0.f, 0.f, 0.f, 0.f, 0.f, 0.f, 0.f};
    const int csh = __builtin_amdgcn_readfirstlane((int)ceilf(fmaxf(shift - 15.0f, 0.f)));
    const float psc = __int_as_float((127 + csh) << 23);
    const int pvs = 127 + csh;
    float lsum = 0.f;
    const char* kg = (const char*)Kt + (size_t)kt0 * KTILEB;
    const char* vg = (const char*)Vt + (size_t)kt0 * VTILEB;
    LAS unsigned char* l3 = (LAS unsigned char*)lds;
    const int n = kt1 - kt0;
#define AT_DMAK(slot) do { if (wid < NKP) { const int b_ = wid * 1024 + lane * 16; const int row_ = b_ / KROWB, cs_ = (b_ % KROWB) >> 4; \
        const int c_ = (DK == 96) ? (cs_ ^ ((row_ >> 1) & 7)) : (cs_ ^ ((row_ >> 2) & 3)); \
        if (c_ < KCH) __builtin_amdgcn_global_load_lds((const unsigned*)(kg + (row_ * DK + c_ * 16)), (LAS unsigned*)(l3 + (slot) * KSTG + wid * 1024), 16, 0, 0); } kg += KTILEB; } while (0)
#define AT_DMAV(slot) do { const int pv_ = wid - (8 - NVP); if (pv_ >= 0) { const int b_ = pv_ * 1024 + lane * 16; const int row_ = b_ >> 6, cs_ = (b_ & 63) >> 4; const int c_ = cs_ ^ ((row_ >> 2) & 3) ^ ((row_ >> 4) & 1); \
        __builtin_amdgcn_global_load_lds((const unsigned*)(vg + (row_ * 64 + c_ * 16)), (LAS unsigned*)(l3 + VBASE + (slot) * VSTG + pv_ * 1024), 16, 0, 0); } vg += VTILEB; } while (0)
    const int pr = perm32(r), vsw = ((pr >> 2) & 3) ^ ((pr >> 4) & 1);
    const int onev = (((lane & 15) == 0 && ((lane >> 4) & 1) == 0) || ((lane & 15) == 1 && ((lane >> 4) & 1) == 1)) ? 0x38383838 : 0;
    f32x4 ol = {0.f, 0.f, 0.f, 0.f};
#define MFMA8S(b, c) __builtin_amdgcn_mfma_scale_f32_16x16x128_f8f6f4(((i32x8){onev, onev, onev, onev, onev, onev, onev, onev}), (b), (c), 0, 1, 0, 0x7F7F7F7F, 0, pvs)
    const int ksw = (DK == 96) ? ((r >> 1) & 7) : ((r >> 2) & 3);
#define MFMA8V(a, b, c) __builtin_amdgcn_mfma_scale_f32_32x32x64_f8f6f4((a), (b), (c), 0, 1, 0, 0x7F7F7F7F, 0, pvs)
#define AT_LD32(dst, rowp, c0, sw) do { const u32x4 a0_ = *(const u32x4*)((rowp) + ((((c0)) ^ (sw)) << 4)), a1_ = *(const u32x4*)((rowp) + ((((c0) + 1) ^ (sw)) << 4)); \
        dst = (i32x8){(int)a0_.x, (int)a0_.y, (int)a0_.z, (int)a0_.w, (int)a1_.x, (int)a1_.y, (int)a1_.z, (int)a1_.w}; } while (0)
#define AT_KROW(slot, kb) (lds + (slot) * KSTG + ((kb) * 32 + r) * KROWB)
#define AT_VROW(slot, db) (lds + VBASE + (slot) * VSTG + ((db) * 32 + pr) * 64)
#define AT_EXP(S, kb, a, b) do { _Pragma("unroll") for (int i_ = (a); i_ < (b); ++i_) S[kb][i_] = fexp2(S[kb][i_]); } while (0)
#define AT_ADD(S, kb, a, b) do { _Pragma("unroll") for (int i_ = (a); i_ < (b); ++i_) lsum += S[kb][i_]; } while (0)
#define AT_CVT(S, kb, d) do { _Pragma("unroll") for (int q_ = 0; q_ < 4; ++q_) d[4 * (kb) + q_] = pk_bf8x4s(S[kb][4 * q_], S[kb][4 * q_ + 1], S[kb][4 * q_ + 2], S[kb][4 * q_ + 3], psc); } while (0)
#define AT_SB __builtin_amdgcn_sched_barrier(0)
#define AT_QK(S, slot) do { _Pragma("unroll") for (int kb = 0; kb < 2; ++kb) { i32x8 kf; AT_LD32(kf, AT_KROW(slot, kb), 2 * h, ksw); S[kb] = MFMA8(kf, qf8[0], cvec); \
        if (DK == 96) { AT_LD32(kf, AT_KROW(slot, kb), 4, ksw); S[kb] = MFMA8(kf, qf8[(DK + 63) / 64 - 1], S[kb]); } } } while (0)
    i32x8 kc0, kc1;
#define AT_STEP(S, SN, ks, vs, PRE, NXT) do { unsigned d_[8]; \
        if (DK == 96) { i32x8 k1_, k3_, v0_, v1_; \
            if (!(PRE)) { AT_LD32(kc0, AT_KROW(ks, 0), 2 * h, ksw); AT_LD32(kc1, AT_KROW(ks, 1), 2 * h, ksw); } AT_SB; \
            SN[0] = MFMA8(kc0, qf8[0], cvec); AT_LD32(k1_, AT_KROW(ks, 0), 4, ksw); AT_EXP(S, 0, 0, 8); AT_SB; \
            SN[1] = MFMA8(kc1, qf8[0], cvec); AT_LD32(k3_, AT_KROW(ks, 1), 4, ksw); AT_EXP(S, 0, 8, 16); AT_SB; \
            SN[0] = MFMA8(k1_, qf8[(DK + 63) / 64 - 1], SN[0]); AT_LD32(v0_, AT_VROW(vs, 0), 2 * h, vsw); AT_EXP(S, 1, 0, 8); AT_SB; \
            SN[1] = MFMA8(k3_, qf8[(DK + 63) / 64 - 1], SN[1]); AT_LD32(v1_, AT_VROW(vs, 1), 2 * h, vsw); AT_EXP(S, 1, 8, 16); AT_SB; \
            o[0] = MFMA8V(v0_, pf8, o[0]); if (NXT) AT_LD32(kc0, AT_KROW(((ks) + 1) & 7, 0), 2 * h, ksw); AT_CVT(S, 0, d_); AT_SB; \
            o[1] = MFMA8V(v1_, pf8, o[1]); if (NXT) AT_LD32(kc1, AT_KROW(((ks) + 1) & 7, 1), 2 * h, ksw); AT_CVT(S, 1, d_); AT_SB; \
            ol = MFMA8S(pf8, ol); AT_SB; \
        } else { i32x8 v0_, v1_, v2_, v3_; \
            AT_LD32(kc0, AT_KROW(ks, 0), 2 * h, ksw); AT_LD32(kc1, AT_KROW(ks, 1), 2 * h, ksw); AT_SB;        \
            SN[0] = MFMA8(kc0, qf8[0], cvec); AT_LD32(v0_, AT_VROW(vs, 0), 2 * h, vsw); AT_EXP(S, 0, 0, 8); AT_SB; \
            SN[1] = MFMA8(kc1, qf8[0], cvec); AT_LD32(v1_, AT_VROW(vs, 1), 2 * h, vsw); AT_EXP(S, 0, 8, 16); AT_SB; \
            o[0] = MFMA8V(v0_, pf8, o[0]); AT_LD32(v2_, AT_VROW(vs, DV / 32 - 2), 2 * h, vsw); AT_EXP(S, 1, 0, 8); AT_SB; \
            o[1] = MFMA8V(v1_, pf8, o[1]); AT_LD32(v3_, AT_VROW(vs, DV / 32 - 1), 2 * h, vsw); AT_EXP(S, 1, 8, 16); AT_SB; \
            o[DV / 32 - 2] = MFMA8V(v2_, pf8, o[DV / 32 - 2]); AT_CVT(S, 0, d_); AT_SB; \
            o[DV / 32 - 1] = MFMA8V(v3_, pf8, o[DV / 32 - 1]); AT_CVT(S, 1, d_); AT_SB; \
            ol = MFMA8S(pf8, ol); AT_SB; \
        } \
        pf8 = (i32x8){(int)d_[0], (int)d_[1], (int)d_[2], (int)d_[3], (int)d_[4], (int)d_[5], (int)d_[6], (int)d_[7]}; } while (0)
    AT_DMAK(0); AT_DMAK(1); AT_DMAK(2); AT_DMAK(3); if (n > 4) AT_DMAK(4);
    AT_DMAV(7); vg -= VTILEB; AT_DMAV(0); AT_DMAV(1); AT_DMAV(2);
    asm volatile("s_waitcnt vmcnt(0)" ::: "memory");
    __syncthreads();
    f32x16 sa[2], sb[2];
    i32x8 pf8 = {0, 0, 0, 0, 0, 0, 0, 0};
    AT_QK(sa, 0);
    __syncthreads();
    for (int p = 0; p < n; p += 8) {
        if (p + 5 < n) { AT_DMAK(5); AT_DMAK(6); AT_DMAK(7); AT_DMAK(0); }
        AT_DMAV(3); if (p + 4 < n) { AT_DMAV(4); AT_DMAV(5); AT_DMAV(6); }
        AT_STEP(sa, sb, 1, 7, 0, 1); AT_STEP(sb, sa, 2, 0, 1, 1); AT_STEP(sa, sb, 3, 1, 1, 1); AT_STEP(sb, sa, 4, 2, 1, 0);
        asm volatile("s_waitcnt vmcnt(0)" ::: "memory");
        __syncthreads();
        if (p + 4 >= n) break;
        if (p + 9 < n) { AT_DMAK(1); AT_DMAK(2); AT_DMAK(3); AT_DMAK(4); }
        AT_DMAV(7); if (p + 8 < n) { AT_DMAV(0); AT_DMAV(1); AT_DMAV(2); }
        AT_STEP(sa, sb, 5, 3, 0, 1); AT_STEP(sb, sa, 6, 4, 1, 1); AT_STEP(sa, sb, 7, 5, 1, 1); AT_STEP(sb, sa, 0, 6, 1, 0);
        asm volatile("s_waitcnt vmcnt(0)" ::: "memory");
        __syncthreads();
    }
#pragma unroll
    for (int db = 0; db < DV / 32; ++db) { i32x8 vf; AT_LD32(vf, AT_VROW((n - 1) & 7, db), 2 * h, vsw); o[db] = MFMA8V(vf, pf8, o[db]); }
    ol = MFMA8S(pf8, ol);
#undef AT_DMAK
#undef AT_DMAV
#undef AT_QK
#undef AT_STEP
#undef AT_LD32
#undef AT_KROW
#undef AT_VROW
#undef AT_EXP
#undef AT_ADD
#undef AT_CVT
#undef AT_SB
#undef MFMA8
#undef MFMA8V
#undef MFMA8S
    { const float s0 = __shfl(ol[0], lane & 15), s1 = __shfl(ol[1], lane & 15); lsum_out = ((lane & 16) ? s1 : s0) + lsum; }
}
DI int kperm8(int pos) { const int h = pos >> 5, j = pos & 31; return ((j >> 4) << 5) | (((j >> 2) & 3) << 3) | (h << 2) | (j & 3); }
DI int kperm(int k) { return (k & ~12) | ((k & 4) << 1) | ((k & 8) >> 1); }


DI int win_src_col(int n) {
    if (n < 416) return n;
    if (n < 512) return -1;
    if (n < 3600) return n - 96;
    if (n < 3840) return -1;
    return n - 336;
}
DI int wgu_src_col(int rr) {
    const int ct = rr >> 8, half = (rr >> 7) & 1, jj = rr & 127;
    return half * 1024 + ct * 128 + jj;
}
template <int MAP>
DI void xpose_unit(float* tl, const float* __restrict__ src, int ld_src, int k0, int n0, bf16_t* __restrict__ dst, int ld_dst, const float* __restrict__ kscale) {
    (void)tl;
    const int tid = opaque_tid(), lane = tid & 63, wid = tid >> 6;
    const int n4 = (wid & 3) * 32 + (lane & 7) * 4, k8 = (wid >> 2) * 64 + (lane >> 3) * 8;
    const int nn = n0 + n4;
    const int sc = (MAP == 0) ? nn : (MAP == 1 ? win_src_col(nn) : wgu_src_col(nn));
    f32x4 v[8];
#pragma unroll
    for (int j = 0; j < 8; ++j)
        v[j] = (sc >= 0) ? __builtin_nontemporal_load((const f32x4*)(src + (size_t)(k0 + k8 + j) * ld_src + sc)) : (f32x4){0.f, 0.f, 0.f, 0.f};
    if (kscale) {
        const f32x4 s0 = *(const f32x4*)(kscale + k0 + k8), s1 = *(const f32x4*)(kscale + k0 + k8 + 4);
        v[0] = v[0] * s0.x; v[1] = v[1] * s0.y; v[2] = v[2] * s0.z; v[3] = v[3] * s0.w; v[4] = v[4] * s1.x; v[5] = v[5] * s1.y; v[6] = v[6] * s1.z; v[7] = v[7] * s1.w;
    }
    bf16_t* d = dst + (size_t)(n0 + n4) * ld_dst + k0 + k8;
    { u32x4 w;
      w.x = pk2(v[0].x, v[1].x); w.y = pk2(v[2].x, v[3].x); w.z = pk2(v[4].x, v[5].x); w.w = pk2(v[6].x, v[7].x); *(u32x4*)d = w;
      w.x = pk2(v[0].y, v[1].y); w.y = pk2(v[2].y, v[3].y); w.z = pk2(v[4].y, v[5].y); w.w = pk2(v[6].y, v[7].y); *(u32x4*)(d + ld_dst) = w;
      w.x = pk2(v[0].z, v[1].z); w.y = pk2(v[2].z, v[3].z); w.z = pk2(v[4].z, v[5].z); w.w = pk2(v[6].z, v[7].z); *(u32x4*)(d + 2 * (size_t)ld_dst) = w;
      w.x = pk2(v[0].w, v[1].w); w.y = pk2(v[2].w, v[3].w); w.z = pk2(v[4].w, v[5].w); w.w = pk2(v[6].w, v[7].w); *(u32x4*)(d + 3 * (size_t)ld_dst) = w; }
}

template <int MAP, int LDS_>
DI void quant_rows_unit(char* ldsb, const float* __restrict__ src  , int nt, signed char* __restrict__ dst  , float* __restrict__ scales  ) {
    const int tid = threadIdx.x;
    const int nb = tid & 7, kb = tid >> 3;
    const int n0 = nt * 32, n4 = nb * 4;
    const int sc = (MAP == 1) ? win_src_col(n0 + n4) : wgu_src_col(n0 + n4);
    float* am = (float*)ldsb;
    f32x4 v[16];
#pragma unroll
    for (int j = 0; j < 16; ++j) v[j] = (sc >= 0) ? __builtin_nontemporal_load((const f32x4*)(src + (size_t)(kb * 16 + j) * LDS_ + sc)) : (f32x4){0.f, 0.f, 0.f, 0.f};
    f32x4 mx = {0.f, 0.f, 0.f, 0.f};
#pragma unroll
    for (int j = 0; j < 16; ++j) { mx.x = fmaxf(mx.x, fabsf(v[j].x)); mx.y = fmaxf(mx.y, fabsf(v[j].y)); mx.z = fmaxf(mx.z, fabsf(v[j].z)); mx.w = fmaxf(mx.w, fabsf(v[j].w)); }
    *(f32x4*)(am + kb * 32 + n4) = mx;
    __syncthreads();
    if (tid < 32) { float m = 0.f;
#pragma unroll
        for (int q = 0; q < 64; ++q) m = fmaxf(m, am[q * 32 + tid]);
        const float sc_ = (m > 0.f) ? m * (1.0f / 127.0f) : 1.0f;
        scales[n0 + tid] = sc_; am[2048 + tid] = 1.0f / sc_; }
    __syncthreads();
    const f32x4 inv = *(const f32x4*)(am + 2048 + n4);
    signed char* d = dst + (size_t)(n0 + n4) * 1024 + kb * 16;
    { u32x4 w;
      w.x = pack_i8x4(v[0].x * inv.x, v[1].x * inv.x, v[2].x * inv.x, v[3].x * inv.x); w.y = pack_i8x4(v[4].x * inv.x, v[5].x * inv.x, v[6].x * inv.x, v[7].x * inv.x);
      w.z = pack_i8x4(v[8].x * inv.x, v[9].x * inv.x, v[10].x * inv.x, v[11].x * inv.x); w.w = pack_i8x4(v[12].x * inv.x, v[13].x * inv.x, v[14].x * inv.x, v[15].x * inv.x);
      *(u32x4*)d = w;
      w.x = pack_i8x4(v[0].y * inv.y, v[1].y * inv.y, v[2].y * inv.y, v[3].y * inv.y); w.y = pack_i8x4(v[4].y * inv.y, v[5].y * inv.y, v[6].y * inv.y, v[7].y * inv.y);
      w.z = pack_i8x4(v[8].y * inv.y, v[9].y * inv.y, v[10].y * inv.y, v[11].y * inv.y); w.w = pack_i8x4(v[12].y * inv.y, v[13].y * inv.y, v[14].y * inv.y, v[15].y * inv.y);
      *(u32x4*)(d + 1024) = w;
      w.x = pack_i8x4(v[0].z * inv.z, v[1].z * inv.z, v[2].z * inv.z, v[3].z * inv.z); w.y = pack_i8x4(v[4].z * inv.z, v[5].z * inv.z, v[6].z * inv.z, v[7].z * inv.z);
      w.z = pack_i8x4(v[8].z * inv.z, v[9].z * inv.z, v[10].z * inv.z, v[11].z * inv.z); w.w = pack_i8x4(v[12].z * inv.z, v[13].z * inv.z, v[14].z * inv.z, v[15].z * inv.z);
      *(u32x4*)(d + 2048) = w;
      w.x = pack_i8x4(v[0].w * inv.w, v[1].w * inv.w, v[2].w * inv.w, v[3].w * inv.w); w.y = pack_i8x4(v[4].w * inv.w, v[5].w * inv.w, v[6].w * inv.w, v[7].w * inv.w);
      w.z = pack_i8x4(v[8].w * inv.w, v[9].w * inv.w, v[10].w * inv.w, v[11].w * inv.w); w.w = pack_i8x4(v[12].w * inv.w, v[13].w * inv.w, v[14].w * inv.w, v[15].w * inv.w);
      *(u32x4*)(d + 3072) = w; }
    __syncthreads();
}

constexpr int XP_WIN = NIN / 32  , XP_WUQ = 2 * 6, XP_WUKV = 2 * 8, XP_WUP = 3 * 4 * 8, XP_WOUT = 8 * 8, XP_WGU = 32 * 64  , XP_WDN = 32 * 8 * 8;
constexpr int XP_LAYER = XP_WIN + XP_WUQ + XP_WUKV + XP_WUP + XP_WOUT + XP_WGU + XP_WDN;
constexpr int N_MODU = NLAYER * 96;

constexpr int XP_WDN_MERGE = 3 * (GRID - 32);
constexpr int XP_WDN_DOWN0 = XP_WDN_MERGE + 512, XP_WDN_DOWN1 = XP_WDN_DOWN0 + 512;
constexpr int XP_WDN_ROWS0 = XP_WDN - 336;
constexpr int XP_WDN_OUTN = (XP_WDN_DOWN0 - XP_WDN_MERGE) + (XP_WDN_ROWS0 - XP_WDN_DOWN1);
DI void wdn_units(const Params& P, int l, int u0, int u1, int rk, int nb) {
    unsigned char* ws = P.ws;
    for (int rr = u0 + rk; rr < u1; rr += nb) { const int e = rr / 64, q = rr % 64, kt = q & 7, nt = q >> 3;
        xpose_unit<0>(nullptr, P.in[34] + ((size_t)l * 32 + e) * 1024 * 1024, 1024, kt * 128, nt * 128, (bf16_t*)(ws + WS_WDN + l * SZ_WDN) + (size_t)e * 1024 * 1024, 1024, nullptr); }
}
DI void phase_prologue(const Params& P, char* lds) {
    float* tl = (float*)lds;
    unsigned char* ws = P.ws;
    const int G = GRID, b = blockIdx.x, tid = threadIdx.x;
    for (int u = b; u < NLAYER * XP_LAYER; u += G) {
        const int l = NLAYER - 1 - u / XP_LAYER; int rr = u % XP_LAYER;
        if (rr < XP_WIN) { quant_rows_unit<1, 6576>(lds, P.in[8] + (size_t)l * 1024 * 6576, rr, (signed char*)(ws + WS_WIN + l * SZ_WIN), (float*)(ws + WS_WINS) + (size_t)l * NIN); continue; }
        rr -= XP_WIN;
        if (rr < XP_WUQ) { const int kt = rr & 1, nt = rr >> 1;
            xpose_unit<0>(tl, P.in[11] + (size_t)l * 256 * 768, 768, kt * 128, nt * 128, (bf16_t*)(ws + WS_WUQ + l * SZ_WUQ), 256, P.in[10] + l * 256); continue; }
        rr -= XP_WUQ;
        if (rr < XP_WUKV) { const int kt = rr & 1, nt = rr >> 1;
            if (kt == 0) xpose_unit<0>(tl, P.in[13] + (size_t)l * 128 * 1024, 1024, 0, nt * 128, (bf16_t*)(ws + WS_WUKV + l * SZ_WUKV), 256, P.in[12] + l * 128);
            else { bf16_t* d = (bf16_t*)(ws + WS_WUKV + l * SZ_WUKV) + (size_t)(nt * 128 + (tid >> 2)) * 256 + 128 + (tid & 3) * 32;
#pragma unroll
                for (int q = 0; q < 4; ++q) *(u32x4*)(d + 8 * q) = (u32x4){0u, 0u, 0u, 0u}; }
            continue; }
        rr -= XP_WUKV;
        if (rr < XP_WUP) { const int br = rr / 32, q = rr % 32, kt = q & 3, nt = q >> 2;
            xpose_unit<0>(tl, P.in[26 + br] + (size_t)l * 512 * 1024, 1024, kt * 128, nt * 128, (bf16_t*)(ws + WS_WUP + l * SZ_WUP) + (size_t)br * 1024 * 512, 512, nullptr); continue; }
        rr -= XP_WUP;
        if (rr < XP_WOUT) { const int kt = rr & 7, nt = rr >> 3;
            xpose_unit<0>(tl, P.in[29] + (size_t)l * 1024 * 1024, 1024, kt * 128, nt * 128, (bf16_t*)(ws + WS_WOUT + l * SZ_WOUT), 1024, nullptr); continue; }
        rr -= XP_WOUT;
        if (rr < XP_WGU) { const int e = rr >> 6, nt = rr & 63;
            quant_rows_unit<2, 2048>(lds, P.in[32] + ((size_t)l * 32 + e) * 1024 * 2048, nt, (signed char*)(ws + WS_WGU + l * SZ_WGU) + (size_t)e * 2048 * 1024, (float*)(ws + WS_WGS) + ((size_t)l * 32 + e) * 2048); continue; }
        rr -= XP_WGU;
        if (l == 0) { const int e = rr / 64, q = rr % 64, kt = q & 7, nt = q >> 3;
            xpose_unit<0>(tl, P.in[34] + ((size_t)l * 32 + e) * 1024 * 1024, 1024, kt * 128, nt * 128, (bf16_t*)(ws + WS_WDN + l * SZ_WDN) + (size_t)e * 1024 * 1024, 1024, nullptr); }
    }
    __syncthreads();
    {
        float* sv = (float*)lds;
        float* red = sv + 2048;
        for (int i = tid; i < 2048; i += NTHR) { const float x = (i < 1024) ? P.in[1][i] : P.in[3][i - 1024]; sv[i] = siluf_(x); }
        __syncthreads();
        float* MOD = (float*)(ws + WS_MOD);
        for (int u = b; u < N_MODU; u += G) {
            const int l = u / 96, cg = u % 96, col = cg * 64 + (tid & 63), kp = tid >> 6;
            const float* w = P.in[4] + (size_t)l * 1024 * 6144 + col;
            float a0 = 0.f, a1 = 0.f;
#pragma unroll 16
            for (int k = kp * 128; k < kp * 128 + 128; ++k) { const float wv = w[(size_t)k * 6144]; a0 += sv[k] * wv; a1 += sv[1024 + k] * wv; }
            red[(kp * 64 + (tid & 63)) * 2 + 0] = a0; red[(kp * 64 + (tid & 63)) * 2 + 1] = a1;
            __syncthreads();
            if (tid < 128) { const int c = tid & 63, wsel = tid >> 6; float s = 0.f;
#pragma unroll
                for (int q = 0; q < 8; ++q) s += red[(q * 64 + c) * 2 + wsel];
                MOD[((size_t)l * 2 + wsel) * 6144 + cg * 64 + c] = s + P.in[5][(size_t)l * 6144 + cg * 64 + c]; }
            __syncthreads();
        }
    }
    if (b == G - 1) {
        float* TAB = (float*)(ws + WS_TAB);
        for (int i = tid; i < 320 * 8; i += NTHR) { const int pos = i >> 3, f = i & 7; const float p = (float)(pos < 256 ? pos : pos - 256);
            const float inv = exp2f(-((float)(2 * f) / 16.0f) * 13.287712379549449f); const float ang = p * inv;
            TAB[i] = cosf(ang); TAB[320 * 8 + i] = sinf(ang); }
        for (int i = tid; i < 320 * 16; i += NTHR) { const int pos = i >> 4, f = i & 15; const float p = (float)(pos < 256 ? pos : pos - 256);
            const float inv = exp2f(-((float)(2 * f) / 32.0f) * 13.287712379549449f); const float ang = p * inv;
            TAB[320 * 16 + i] = cosf(ang); TAB[320 * 16 + 320 * 16 + i] = sinf(ang); }
    }
    if (b == G - 2 && tid < NLAYER) {
        const int l = tid;
        float gq = 0.f, gk = 0.f, dq = 0.f, dk = 0.f;
        for (int i = 0; i < 96; ++i) { gq = fmaxf(gq, fabsf(P.in[14][l * 96 + i])); gk = fmaxf(gk, fabsf(P.in[15][l * 96 + i])); }
        for (int i = 0; i < 64; ++i) { dq = fmaxf(dq, fabsf(P.in[16][l * 64 + i])); dk = fmaxf(dk, fabsf(P.in[17][l * 64 + i])); }
        const float* lp = P.in[18] + l * 256;
        float s1 = 0.f, s2 = 0.f;
        for (int i = 0; i < 64; ++i) { s1 += lp[i] * lp[64 + i]; s2 += lp[128 + i] * lp[192 + i]; }
        float* ac_ = (float*)((int*)(ws + WS_CTL) + l * 32 * ECS + 40);
        ac_[0] = 9.797958971132712f * gq * gk * LOG2E * 1.02f;
        ac_[1] = 8.0f * dq * dk * LOG2E * 1.02f;
        ac_[2] = __expf(s1) - __expf(s2);
    }
    if (b < NLAYER) {
        float* WRT = (float*)(ws + WS_WRT) + (size_t)b * 32 * 1024;
        const float* src = P.in[30] + (size_t)b * 1024 * 32;
        for (int i = tid; i < 32 * 1024; i += NTHR) { const int k = i >> 5, e = i & 31; WRT[e * 1024 + k] = src[i]; }
    }
}

DI void phase_rows_norm1(const Params& P, int lprev  , int nl  ) {
    unsigned char* ws = P.ws;
    const int G = GRID, tid = opaque_tid(), lane = tid & 63, wid = tid >> 6;
    bf16_t* XCUR = (bf16_t*)(ws + WS_XCUR);
    signed char* H = (signed char*)(ws + WS_H); float* HS = (float*)(ws + WS_HS);
    const float* MOD = (const float*)(ws + WS_MOD);
    const int* ctl = (const int*)(ws + WS_CTL);
    int offs_lane = 0;
    if (lprev >= 0) {
        const int c = (lane < 32) ? ctl[(lprev * 32 + lane) * ECS] : 0;
        const int nb = (c + 255) >> 8;
        int incl = nb;
#pragma unroll
        for (int d = 1; d < 32; d <<= 1) { const int t = __shfl_up(incl, d); if ((lane & 31) >= d) incl += t; }
        offs_lane = (incl - nb) * 256;
    }
    f32x4 Lg1[4], Lsc[4], Lsh[4], Lgt2[4];
#pragma unroll
    for (int j = 0; j < 4; ++j) { const int e = 256 * j + 4 * lane;
        if (nl < NLAYER) { Lg1[j] = *(const f32x4*)(P.in[6] + (size_t)nl * 1024 + e); Lsh[j] = *(const f32x4*)(MOD + ((size_t)nl * 2) * 6144 + e); Lsc[j] = *(const f32x4*)(MOD + ((size_t)nl * 2) * 6144 + 1024 + e); }
        else { Lg1[j] = Lsh[j] = Lsc[j] = (f32x4){0.f, 0.f, 0.f, 0.f}; }
        if (lprev >= 0) Lgt2[j] = *(const f32x4*)(MOD + ((size_t)lprev * 2) * 6144 + 5 * 1024 + e); else Lgt2[j] = (f32x4){0.f, 0.f, 0.f, 0.f}; }
    for (int tb = blockIdx.x * 8 + wid; tb < T; tb += G * 16) {
        int tt[2]; bool ok[2]; int isc[2];
        f32x4 x[2][4];
        int te[2][4], tp[2][4]; float tg[2][4];
#pragma unroll
        for (int q = 0; q < 2; ++q) {
            tt[q] = tb + q * G * 8; ok[q] = tt[q] < T; const int t = ok[q] ? tt[q] : tb; isc[q] = t >= SEQ;
            if (lprev < 0) {
                const float* src = isc[q] ? (P.in[2] + (size_t)(t - SEQ) * 1024) : (P.in[0] + (size_t)t * 1024);
#pragma unroll
                for (int j = 0; j < 4; ++j) x[q][j] = *(const f32x4*)(src + 256 * j + 4 * lane);
            } else {
#pragma unroll
                for (int j = 0; j < 4; ++j) { const u32x2 w = *(const u32x2*)(XCUR + (size_t)t * 1024 + 256 * j + 4 * lane); x[q][j] = (f32x4){bflo(w.x), bfhi(w.x), bflo(w.y), bfhi(w.y)}; }
            }
            if (lprev >= 0) {
                const int* tope = (const int*)(ws + WS_TOPE) + (size_t)t * 4; const int* topp = (const int*)(ws + WS_TOPP) + (size_t)t * 4; const float* topg = (const float*)(ws + WS_TOPG) + (size_t)t * 4;
#pragma unroll
                for (int k = 0; k < 4; ++k) { te[q][k] = tope[k]; tp[q][k] = topp[k]; tg[q][k] = topg[k]; }
            }
        }
        if (lprev >= 0) {
            const bf16_t* Y = (const bf16_t*)(ws + WS_YMOE);
            u32x2 yw[2][4][4];
#pragma unroll
            for (int q = 0; q < 2; ++q)
#pragma unroll
                for (int k = 0; k < 4; ++k) { const int row = __shfl(offs_lane, te[q][k]) + tp[q][k]; const bf16_t* yr = Y + (size_t)row * 1024;
#pragma unroll
                    for (int j = 0; j < 4; ++j) yw[q][k][j] = *(const u32x2*)(yr + 256 * j + 4 * lane); }
#pragma unroll
            for (int q = 0; q < 2; ++q) {
                const float* gt2 = MOD + ((size_t)lprev * 2 + isc[q]) * 6144 + 5 * 1024;
#pragma unroll
                for (int j = 0; j < 4; ++j) { f32x4 y = {0.f, 0.f, 0.f, 0.f};
#pragma unroll
                    for (int k = 0; k < 4; ++k) { const u32x2 w = yw[q][k][j]; const float g = tg[q][k]; y.x += g * bflo(w.x); y.y += g * bfhi(w.x); y.z += g * bflo(w.y); y.w += g * bfhi(w.y); }
                    const f32x4 gg = isc[q] ? *(const f32x4*)(gt2 + 256 * j + 4 * lane) : Lgt2[j]; x[q][j] = x[q][j] + gg * y; }
            }
        }
#pragma unroll
        for (int q = 0; q < 2; ++q) {
            if (!ok[q]) continue;
            const int t = tt[q];
            if (nl < NLAYER) {
#pragma unroll
                for (int j = 0; j < 4; ++j) { u32x2 w; w.x = pk2(x[q][j].x, x[q][j].y); w.y = pk2(x[q][j].z, x[q][j].w); *(u32x2*)(XCUR + (size_t)t * 1024 + 256 * j + 4 * lane) = w; }
                float ss = 0.f;
#pragma unroll
                for (int j = 0; j < 4; ++j) ss += x[q][j].x * x[q][j].x + x[q][j].y * x[q][j].y + x[q][j].z * x[q][j].z + x[q][j].w * x[q][j].w;
                ss = wave_sum(ss);
                const float rstd = rsqrtf(ss * (1.0f / 1024.0f) + EPS);
                const float* sh = MOD + ((size_t)nl * 2 + isc[q]) * 6144;
                const float* sc = sh + 1024;
                f32x4 hv[4]; float am = 0.f;
#pragma unroll
                for (int j = 0; j < 4; ++j) {
                    const int e = 256 * j + 4 * lane;
                    const f32x4 gg = Lg1[j], s1 = isc[q] ? *(const f32x4*)(sc + e) : Lsc[j], b1 = isc[q] ? *(const f32x4*)(sh + e) : Lsh[j];
                    hv[j] = (x[q][j] * rstd) * gg * (s1 + 1.0f) + b1;
                    am = fmaxf(am, fmaxf(fmaxf(fabsf(hv[j].x), fabsf(hv[j].y)), fmaxf(fabsf(hv[j].z), fabsf(hv[j].w))));
                }
                am = wave_max(am);
                const float qs = (am > 0.f) ? am * (1.0f / 127.0f) : 1.0f, qi = 1.0f / qs;
#pragma unroll
                for (int j = 0; j < 4; ++j) *(unsigned*)(H + (size_t)t * 1024 + 256 * j + 4 * lane) = pack_i8x4(hv[j].x * qi, hv[j].y * qi, hv[j].z * qi, hv[j].w * qi);
                if (lane == 0) HS[t] = qs;
            } else if (!isc[q]) {
#pragma unroll
                for (int j = 0; j < 4; ++j) *(f32x4*)(P.out + (size_t)t * 1024 + 256 * j + 4 * lane) = x[q][j];
            }
        }
    }
    if (lprev >= 0 && nl < NLAYER && blockIdx.x >= 32) wdn_units(P, nl, XP_WDN_ROWS0, XP_WDN, (int)blockIdx.x - 32, GRID - 32);
}

DI void phase_router(const Params& P, int l, char* lds) {
    unsigned char* ws = P.ws;
    const bf16_t* XCUR = (const bf16_t*)(ws + WS_XCUR);
    const float* MOD = (const float*)(ws + WS_MOD);
    const float* WRT = (const float*)(ws + WS_WRT) + (size_t)l * 32 * 1024;
    int* ecnt = (int*)(ws + WS_CTL) + l * 32 * ECS;
    float* fl = (float*)lds;
    float* part = fl;
    float* part2 = (float*)(lds + 135424);
    float* lgx = part2 + 512;
    int* dst = (int*)(lds + 135424 + 2048 + 1056);
    int* lcnt = dst + 33 * 4;
    int* lbase = lcnt + 32;
    const float* g2 = P.in[7] + (size_t)l * 1024;
    f32x4 Rg2[4], Rsc[4], Rsh[4];
    { const int lane_ = opaque_tid() & 63;
#pragma unroll
      for (int j = 0; j < 4; ++j) { const int e = 256 * j + 4 * lane_; Rg2[j] = *(const f32x4*)(g2 + e);
          Rsh[j] = *(const f32x4*)(MOD + ((size_t)l * 2) * 6144 + 3 * 1024 + e); Rsc[j] = *(const f32x4*)(MOD + ((size_t)l * 2) * 6144 + 4 * 1024 + e) + 1.0f; } }
    for (int i = opaque_tid(); i < 8 * 33; i += NTHR) lgx[i] = 0.f;
#pragma unroll 1
    for (int pass = 0; pass < 2; ++pass) {
        const int tbase = (int)blockIdx.x * 65;
        const int t0 = tbase + 32 * pass;
        const bool extra = pass == 0;
        const int tx = tbase + 64;
        const int tid = opaque_tid(), lane = tid & 63, wid = tid >> 6, r = lane & 31, h = lane >> 5; (void)tid;
        unsigned pq[5][4]; float rsc[5];
        {
            f32x4 x[5][4]; float ss[5];
#pragma unroll
            for (int q = 0; q < 5; ++q) { const int t = (q < 4) ? (t0 + wid * 4 + q) : tx;
#pragma unroll
                for (int j = 0; j < 4; ++j) { const u32x2 w = *(const u32x2*)(XCUR + (size_t)t * 1024 + 256 * j + 4 * lane); x[q][j] = (f32x4){bflo(w.x), bfhi(w.x), bflo(w.y), bfhi(w.y)}; } }
#pragma unroll
            for (int q = 0; q < 5; ++q) { float s = 0.f;
#pragma unroll
                for (int j = 0; j < 4; ++j) s += x[q][j].x * x[q][j].x + x[q][j].y * x[q][j].y + x[q][j].z * x[q][j].z + x[q][j].w * x[q][j].w;
                ss[q] = wave_sum(s); }
#pragma unroll
            for (int q = 0; q < 5; ++q) {
                if (q == 4 && !(extra && wid == 0)) continue;
                const int t = (q < 4) ? (t0 + wid * 4 + q) : tx, tr = (q < 4) ? (wid * 4 + q) : 32;
                const int isctx = t >= SEQ;
                const float* sh = MOD + ((size_t)l * 2 + isctx) * 6144 + 3 * 1024;
                const float* sc = sh + 1024;
                const float rstd = rsqrtf(ss[q] * (1.0f / 1024.0f) + EPS);
                f32x4 hv[4]; float am = 0.f;
#pragma unroll
                for (int j = 0; j < 4; ++j) {
                    const int e = 256 * j + 4 * lane;
                    const f32x4 gg = Rg2[j], s1 = isctx ? (*(const f32x4*)(sc + e) + 1.0f) : Rsc[j], b1 = isctx ? *(const f32x4*)(sh + e) : Rsh[j];
                    hv[j] = (x[q][j] * rstd) * gg * s1 + b1;
                    am = fmaxf(am, fmaxf(fmaxf(fabsf(hv[j].x), fabsf(hv[j].y)), fmaxf(fabsf(hv[j].z), fabsf(hv[j].w))));
                    float* d = fl + tr * 1025 + e; d[0] = hv[j].x; d[1] = hv[j].y; d[2] = hv[j].z; d[3] = hv[j].w;
                }
                am = wave_max(am);
                const float qs = (am > 0.f) ? am * (1.0f / 127.0f) : 1.0f, qi = 1.0f / qs;
                rsc[q] = qs;
#pragma unroll
                for (int j = 0; j < 4; ++j) pq[q][j] = pack_i8x4(hv[j].x * qi, hv[j].y * qi, hv[j].z * qi, hv[j].w * qi);
            }
        }
        if (tid < 32) lcnt[tid] = 0;
        __syncthreads();
        {
            f32x16 acc;
#pragma unroll
            for (int i = 0; i < 16; ++i) acc[i] = 0.f;
            const int kb = 128 * wid + 64 * h;
            const float* wrow = WRT + (size_t)r * 1024 + kb;
            const float* frow = fl + r * 1025 + kb;
            f32x4 wv[16];
#pragma unroll
            for (int c = 0; c < 16; ++c) wv[c] = *(const f32x4*)(wrow + 4 * c);
#pragma unroll
            for (int c = 0; c < 16; ++c) {
                acc = __builtin_amdgcn_mfma_f32_32x32x2f32(frow[4 * c + 0], wv[c].x, acc, 0, 0, 0);
                acc = __builtin_amdgcn_mfma_f32_32x32x2f32(frow[4 * c + 1], wv[c].y, acc, 0, 0, 0);
                acc = __builtin_amdgcn_mfma_f32_32x32x2f32(frow[4 * c + 2], wv[c].z, acc, 0, 0, 0);
                acc = __builtin_amdgcn_mfma_f32_32x32x2f32(frow[4 * c + 3], wv[c].w, acc, 0, 0, 0);
            }
            if (extra) {
                const float* fx = fl + 32 * 1025 + kb; float a = 0.f;
#pragma unroll
                for (int c = 0; c < 16; ++c) a += fx[4 * c] * wv[c].x + fx[4 * c + 1] * wv[c].y + fx[4 * c + 2] * wv[c].z + fx[4 * c + 3] * wv[c].w;
                part2[(2 * wid + h) * 32 + r] = a;
            }
            __syncthreads();
#pragma unroll
            for (int i = 0; i < 16; ++i) { const int tok = (i & 3) + 8 * (i >> 2) + 4 * h; part[(wid * 32 + tok) * 33 + r] = acc[i]; }
            if (extra && wid == 1 && lane < 32) { float a = 0.f;
#pragma unroll
                for (int w = 0; w < 16; ++w) a += part2[w * 32 + lane];
                lgx[lane] = a; }
        }
        __syncthreads();
        if (wid == 0) {
            int te[4] = {0, 0, 0, 0}; float tg[4] = {0.f, 0.f, 0.f, 0.f}; int lr[4] = {0, 0, 0, 0};
            const bool act = lane < 32 || (extra && lane == 32);
            const int t = (lane < 32) ? (t0 + lane) : tx;
            if (act) {
                float lg[32];
                const float* lsrc = (lane < 32) ? (part + lane * 33) : lgx; const int lstr = (lane < 32) ? 32 * 33 : 33;
#pragma unroll
                for (int e = 0; e < 32; ++e) { float s = P.in[31][l * 32 + e];
#pragma unroll
                    for (int w = 0; w < 8; ++w) s += lsrc[w * lstr + e];
                    lg[e] = s; }
                float tv[4];
#pragma unroll
                for (int k = 0; k < 4; ++k) {
                    float best = -3.0e38f; int bi = 0;
#pragma unroll
                    for (int e = 0; e < 32; ++e) { const bool better = lg[e] > best; best = better ? lg[e] : best; bi = better ? e : bi; }
                    te[k] = bi; tv[k] = best;
#pragma unroll
                    for (int e = 0; e < 32; ++e) lg[e] = (e == bi) ? -3.0e38f : lg[e];
                }
                float se = 0.f;
#pragma unroll
                for (int k = 0; k < 4; ++k) { tg[k] = __expf(tv[k] - tv[0]); se += tg[k]; }
                const float inv = 1.0f / se;
#pragma unroll
                for (int k = 0; k < 4; ++k) { tg[k] *= inv; lr[k] = atomicAdd(lcnt + te[k], 1); }
            }
            if (lane < 32) { const int c = lcnt[lane]; lbase[lane] = c ? atomicAdd(ecnt + lane * ECS, c) : 0; }
            if (act) {
                int* tope = (int*)(ws + WS_TOPE) + (size_t)t * 4;
                int* topp = (int*)(ws + WS_TOPP) + (size_t)t * 4;
                float* topg = (float*)(ws + WS_TOPG) + (size_t)t * 4;
#pragma unroll
                for (int k = 0; k < 4; ++k) {
                    const int pos = lbase[te[k]] + lr[k];
                    tope[k] = te[k]; topp[k] = pos; topg[k] = tg[k];
                    dst[lane * 4 + k] = te[k] * T + pos;
                }
            }
        }
        __syncthreads();
        {
            signed char* XG = (signed char*)(ws + WS_XG); float* XGS = (float*)(ws + WS_XGS);
#pragma unroll
            for (int q = 0; q < 5; ++q) { if (q == 4 && !(extra && wid == 0)) continue;
                const int tr = (q < 4) ? (wid * 4 + q) : 32;
#pragma unroll
                for (int k = 0; k < 4; ++k) { const int drow = dst[tr * 4 + k]; signed char* d = XG + (size_t)drow * 1024 + 4 * lane;
#pragma unroll
                    for (int j = 0; j < 4; ++j) *(unsigned*)(d + 256 * j) = pq[q][j];
                    if (lane == 0) XGS[drow] = rsc[q]; } }
        }
        __syncthreads();
    }
}


struct EpiIn {
    bf16_t* U; float* DTR; const float* bg; const float* hs; const float* wins;
    DI void operator()(const g8::AccI& acc, const g8::Unit& u, int wr, int wc, int fr, int fq) const {
        const bool gate = u.t1 >= (U_G / 256);
        float sa_[2][4];
#pragma unroll
        for (int ai = 0; ai < 2; ++ai)
#pragma unroll
            for (int m = 0; m < 4; ++m) sa_[ai][m] = hs[u.t0 * 256 + 128 * ai + 64 * wr + 16 * m + fr];
        __builtin_amdgcn_sched_barrier(0);
#pragma unroll
        for (int bj = 0; bj < 2; ++bj) {
            const int col = u.t1 * 256 + 128 * bj + 32 * wc + 8 * fq;
            const f32x4 w0 = *(const f32x4*)(wins + col), w1 = *(const f32x4*)(wins + col + 4);
            f32x4 b0 = {0.f, 0.f, 0.f, 0.f}, b1 = {0.f, 0.f, 0.f, 0.f};
            if (gate) { b0 = *(const f32x4*)(bg + col - U_G); b1 = *(const f32x4*)(bg + col - U_G + 4); }
#pragma unroll
            for (int ai = 0; ai < 2; ++ai)
#pragma unroll
                for (int m = 0; m < 4; ++m) {
                    const int row = u.t0 * 256 + 128 * ai + 64 * wr + 16 * m + fr;
                    const float sa = sa_[ai][m];
                    const i32x4 a0 = acc[ai][bj][m][0], a1 = acc[ai][bj][m][1];
                    f32x4 v0 = {(float)a0.x * (sa * w0.x), (float)a0.y * (sa * w0.y), (float)a0.z * (sa * w0.z), (float)a0.w * (sa * w0.w)};
                    f32x4 v1 = {(float)a1.x * (sa * w1.x), (float)a1.y * (sa * w1.y), (float)a1.z * (sa * w1.z), (float)a1.w * (sa * w1.w)};
                    if (gate) {
                        v0.x = sigmoidf_(v0.x + b0.x); v0.y = sigmoidf_(v0.y + b0.y); v0.z = sigmoidf_(v0.z + b0.z); v0.w = sigmoidf_(v0.w + b0.w);
                        v1.x = sigmoidf_(v1.x + b1.x); v1.y = sigmoidf_(v1.y + b1.y); v1.z = sigmoidf_(v1.z + b1.z); v1.w = sigmoidf_(v1.w + b1.w);
                    } else if (col >= U_DT && col < U_DT + 16) {
                        *(f32x4*)(DTR + (size_t)row * 16 + (col - U_DT)) = v0; *(f32x4*)(DTR + (size_t)row * 16 + (col - U_DT) + 4) = v1;
                    }
                    u32x4 w; w.x = pk2(v0.x, v0.y); w.y = pk2(v0.z, v0.w); w.z = pk2(v1.x, v1.y); w.w = pk2(v1.z, v1.w);
                    *(u32x4*)(U + (size_t)row * NIN + col) = w;
                }
        }
    }
};
DI void phase_gemm_in(const Params& P, int l, char* lds) {
    unsigned char* ws = P.ws;
    g8::GridSched<NQB, NIN / 256> S; S.init(ws + WS_H, 512, ws + WS_WIN + l * SZ_WIN, 512);
    EpiIn E{(bf16_t*)(ws + WS_U), (float*)(ws + WS_DTR), P.in[9] + (size_t)l * 3072, (const float*)(ws + WS_HS), (const float*)(ws + WS_WINS) + (size_t)l * NIN};
    g8::gemm_phase<true, true>((LAS unsigned char*)lds, 512, 512, S, E);
}

struct EpiBf16Plain {
    bf16_t* C; int ldc;
    DI void operator()(const g8::Acc& acc, const g8::Unit& u, int wr, int wc, int fr, int fq) const {
#pragma unroll
        for (int ai = 0; ai < 2; ++ai)
#pragma unroll
            for (int m = 0; m < 4; ++m) {
                const int row = u.t0 * 256 + 128 * ai + 64 * wr + 16 * m + fr;
#pragma unroll
                for (int bj = 0; bj < 2; ++bj) {
                    const int col = u.t1 * 256 + 128 * bj + 32 * wc + 8 * fq;
                    const f32x4 v0 = acc[ai][bj][m][0], v1 = acc[ai][bj][m][1];
                    u32x4 w; w.x = pk2(v0.x, v0.y); w.y = pk2(v0.z, v0.w); w.z = pk2(v1.x, v1.y); w.w = pk2(v1.z, v1.w);
                    *(u32x4*)(C + (size_t)row * ldc + col) = w;
                }
            }
    }
};

template <int NI>
DI void gemm_store_bf16(const GemmAcc<NI>& acc, bf16_t* C, size_t ldc, int row0, int col0) {
    const int tid = opaque_tid(), lane = tid & 63, wid = tid >> 6, wr = wid >> 2, wc = wid & 3, r = lane & 31, h = lane >> 5;
#pragma unroll
    for (int mi = 0; mi < 4; ++mi)
#pragma unroll
        for (int ni = 0; ni < NI; ++ni) {
            float v[16];
#pragma unroll
            for (int i = 0; i < 16; ++i) v[i] = acc.a[mi][ni][i];
            st_bf16x16(C + (size_t)(row0 + wr * 128 + mi * 32 + r) * ldc + col0 + wc * 32 * NI + ni * 32 + 16 * h, v);
        }
}

DI void phase_gemm_merge(const Params& P, int l, char* lds) {
    unsigned char* ws = P.ws;
    const int G = GRID;
    const bf16_t* U = (const bf16_t*)(ws + WS_U);
    const bf16_t* WUP = (const bf16_t*)(ws + WS_WUP + l * SZ_WUP);
    bf16_t* MRG = (bf16_t*)(ws + WS_MRG);
    const int nu = (NQB - 1) * 8;
    const int bx_ = opaque_bid() & 7, by_ = opaque_bid() >> 3;
    for (int k_ = 0; ; ++k_) {
        const int rt = k_ * 32 + bx_ * 4 + (by_ >> 3), ct = by_ & 7;
        if (rt * 8 >= nu) break;
        const int tid = opaque_tid(), lane = tid & 63, wid = tid >> 6, wr = wid >> 2, wc = wid & 3, r = lane & 31, h = lane >> 5; (void)tid; (void)wr; (void)wc; (void)r; (void)h;
        float tot[4][16];
#pragma unroll
        for (int mi = 0; mi < 4; ++mi)
#pragma unroll
            for (int i = 0; i < 16; ++i) tot[mi][i] = 0.f;
#pragma unroll 1
        for (int br = 0; br < 3; ++br) {
            const bf16_t* Y = (const bf16_t*)(ws + (br == 0 ? WS_YA : (br == 1 ? WS_YB : WS_YC)));
            GemmAcc<1> acc;
            gemm_tile<1>(lds, ARowPlain{Y + (size_t)rt * 256 * 512, 512}, WUP + (size_t)br * 1024 * 512 + (size_t)ct * 128 * 512, 512, 512, acc);
            u32x4 gg0[4], gg1[4];
#pragma unroll
            for (int mi = 0; mi < 4; ++mi) { const bf16_t* gp = U + (size_t)(rt * 256 + wr * 128 + mi * 32 + r) * NIN + U_G + br * 1024 + ct * 128 + wc * 32 + 16 * h;
                gg0[mi] = *(const u32x4*)gp; gg1[mi] = *(const u32x4*)(gp + 8); }
            __builtin_amdgcn_sched_barrier(0);
#pragma unroll
            for (int mi = 0; mi < 4; ++mi) {
                const u32x4 g0 = gg0[mi], g1 = gg1[mi];
                const unsigned gw[8] = {g0.x, g0.y, g0.z, g0.w, g1.x, g1.y, g1.z, g1.w};
#pragma unroll
                for (int q = 0; q < 8; ++q) { tot[mi][2 * q] += bflo(gw[q]) * acc.a[mi][0][2 * q]; tot[mi][2 * q + 1] += bfhi(gw[q]) * acc.a[mi][0][2 * q + 1]; }
            }
        }
#pragma unroll
        for (int mi = 0; mi < 4; ++mi)
            st_bf16x16(MRG + (size_t)(rt * 256 + wr * 128 + mi * 32 + r) * 1024 + ct * 128 + wc * 32 + 16 * h, tot[mi]);
    }
    if (l + 1 < NLAYER) {
        const int c_ = opaque_bid();
        if ((c_ & 7) == 0) {
            const int su = c_ >> 3, ct = su & 7, qr = su >> 3;
            const int tid = opaque_tid(), lane = tid & 63, wid = tid >> 6, wr = wid >> 2, wc = wid & 3, r = lane & 31, h = lane >> 5; (void)tid;
            const int row = (NQB - 1) * 256 + qr * 64 + wr * 32 + r;
            float tot[16];
#pragma unroll
            for (int i = 0; i < 16; ++i) tot[i] = 0.f;
#pragma unroll 1
            for (int br = 0; br < 3; ++br) {
                const bf16_t* Y = (const bf16_t*)(ws + (br == 0 ? WS_YA : (br == 1 ? WS_YB : WS_YC)));
                GemmAcc<1> acc;
                gemm_tile<1, ARowPlain, 1>(lds, ARowPlain{Y + (size_t)((NQB - 1) * 256 + qr * 64) * 512, 512}, WUP + (size_t)br * 1024 * 512 + (size_t)ct * 128 * 512, 512, 512, acc);
                const bf16_t* gp = U + (size_t)row * NIN + U_G + br * 1024 + ct * 128 + wc * 32 + 16 * h;
                const u32x4 g0 = *(const u32x4*)gp, g1 = *(const u32x4*)(gp + 8);
                const unsigned gw[8] = {g0.x, g0.y, g0.z, g0.w, g1.x, g1.y, g1.z, g1.w};
#pragma unroll
                for (int q = 0; q < 8; ++q) { tot[2 * q] += bflo(gw[q]) * acc.a[0][0][2 * q]; tot[2 * q + 1] += bfhi(gw[q]) * acc.a[0][0][2 * q + 1]; }
            }
            st_bf16x16(MRG + (size_t)row * 1024 + ct * 128 + wc * 32 + 16 * h, tot);
        } else {
            wdn_units(P, l + 1, 0, XP_WDN_MERGE, c_ - (c_ >> 3) - 1, GRID - 32);
        }
    }
}

struct EpiOut {
    bf16_t* XCUR; const float* MOD; int l;
    DI void operator()(const g8::Acc& acc, const g8::Unit& u, int wr, int wc, int fr, int fq) const {
        const float* gt1 = MOD + ((size_t)l * 2 + (u.t0 == NQB - 1 ? 1 : 0)) * 6144 + 2 * 1024;
        f32x4 g[2][2];
#pragma unroll
        for (int bj = 0; bj < 2; ++bj)
#pragma unroll
            for (int n = 0; n < 2; ++n) g[bj][n] = *(const f32x4*)(gt1 + u.t1 * 256 + 128 * bj + 32 * wc + 16 * n + 4 * fq);
#pragma unroll
        for (int ai = 0; ai < 2; ++ai)
#pragma unroll
            for (int mp = 0; mp < 4; mp += 2) {
                u32x2 w[2][2][2];
#pragma unroll
                for (int mm = 0; mm < 2; ++mm) { const int row = u.t0 * 256 + 128 * ai + 64 * wr + 16 * (mp + mm) + fr;
#pragma unroll
                    for (int bj = 0; bj < 2; ++bj)
#pragma unroll
                        for (int n = 0; n < 2; ++n) w[mm][bj][n] = *(const u32x2*)(XCUR + (size_t)row * 1024 + u.t1 * 256 + 128 * bj + 32 * wc + 16 * n + 4 * fq); }
                __builtin_amdgcn_sched_barrier(0);
#pragma unroll
                for (int mm = 0; mm < 2; ++mm) { const int row = u.t0 * 256 + 128 * ai + 64 * wr + 16 * (mp + mm) + fr;
#pragma unroll
                    for (int bj = 0; bj < 2; ++bj)
#pragma unroll
                        for (int n = 0; n < 2; ++n) {
                            const u32x2 ww = w[mm][bj][n];
                            const f32x4 v = (f32x4){bflo(ww.x), bfhi(ww.x), bflo(ww.y), bfhi(ww.y)} + g[bj][n] * acc[ai][bj][mp + mm][n];
                            u32x2 o2; o2.x = pk2(v.x, v.y); o2.y = pk2(v.z, v.w);
                            *(u32x2*)(XCUR + (size_t)row * 1024 + u.t1 * 256 + 128 * bj + 32 * wc + 16 * n + 4 * fq) = o2;
                        } }
                __builtin_amdgcn_sched_barrier(0);
            }
    }
};
DI void phase_gemm_out(const Params& P, int l, char* lds) {
    unsigned char* ws = P.ws;
    EpiOut E{(bf16_t*)(ws + WS_XCUR), (const float*)(ws + WS_MOD), l};
    {
        g8::GridSched<NQB - 1, 4> S; S.init(ws + WS_MRG, 1024, ws + WS_WOUT + l * SZ_WOUT, 1024);
        g8::gemm_phase<false>((LAS unsigned char*)lds, 1024, 1024, S, E);
    }
    if (l + 1 < NLAYER) {
        const int c_ = opaque_bid();
        __syncthreads();
        if ((c_ & 7) == 0) {
            const int su = c_ >> 3, ct = su & 7, qr = su >> 3;
            const int tid = opaque_tid(), lane = tid & 63, wid = tid >> 6, wr = wid >> 2, wc = wid & 3, r = lane & 31, h = lane >> 5; (void)tid;
            const int row = (NQB - 1) * 256 + qr * 64 + wr * 32 + r, col = ct * 128 + wc * 32 + 16 * h;
            GemmAcc<1> acc;
            gemm_tile<1, ARowPlain, 1>(lds, ARowPlain{(const bf16_t*)(ws + WS_MRG) + (size_t)((NQB - 1) * 256 + qr * 64) * 1024, 1024}, (const bf16_t*)(ws + WS_WOUT + l * SZ_WOUT) + (size_t)ct * 128 * 1024, 1024, 1024, acc);
            const float* gt1 = (const float*)(ws + WS_MOD) + ((size_t)l * 2 + 1) * 6144 + 2 * 1024 + col;
            bf16_t* xp = (bf16_t*)(ws + WS_XCUR) + (size_t)row * 1024 + col;
            const u32x4 x0 = *(const u32x4*)xp, x1 = *(const u32x4*)(xp + 8);
            const unsigned xw[8] = {x0.x, x0.y, x0.z, x0.w, x1.x, x1.y, x1.z, x1.w};
            float v[16];
#pragma unroll
            for (int q = 0; q < 8; ++q) { v[2 * q] = bflo(xw[q]) + gt1[2 * q] * acc.a[0][0][2 * q]; v[2 * q + 1] = bfhi(xw[q]) + gt1[2 * q + 1] * acc.a[0][0][2 * q + 1]; }
            st_bf16x16(xp, v);
        } else {
            const int rk = c_ - (c_ >> 3) - 1;
            for (int u = rk; u < XP_WDN_OUTN; u += GRID - 32) { const int rr = (u < XP_WDN_DOWN0 - XP_WDN_MERGE) ? (XP_WDN_MERGE + u) : (XP_WDN_DOWN1 + (u - (XP_WDN_DOWN0 - XP_WDN_MERGE)));
                wdn_units(P, l + 1, rr, rr + 1, 0, 1); }
        }
    }
}

constexpr int MOE_TAB_OFF = 131072 + 1024;
DI int moe_build_table(const int* ecnt, char* lds) {
    int* tab = (int*)(lds + MOE_TAB_OFF);
    const int tid = opaque_tid();
    if (tid < 64) {
        const int e = tid & 31;
        const int nb = (tid < 32) ? ((ecnt[e * ECS] + 255) >> 8) : 0;
        int incl = nb;
#pragma unroll
        for (int d = 1; d < 32; d <<= 1) { const int t = __shfl_up(incl, d); if ((tid & 31) >= d) incl += t; }
        if (tid < 32) { const int base = incl - nb; for (int j = 0; j < nb; ++j) tab[1 + base + j] = (e << 16) | j; if (tid == 31) tab[0] = incl; }
    }
    __syncthreads();
    return tab[0];
}
template <int NCT, bool SPARSE, size_t A_EXPERT_STEP, size_t A_BLK_STEP, size_t W_EXPERT_STEP, size_t W_CT_STEP>
struct MoeSched {
    const char* A; const char* W; const int* tab; int nunits; int c;
    DI bool next(int i, g8::Unit& u) const {
        constexpr int RPX = 32 / NCT;
        const int x = c & 7, y = c >> 3;
        const int rb = i * (GRID / NCT) + x * RPX + y / NCT, ct = y % NCT;
        if (rb * NCT >= nunits) return false;
        const int ej = tab[1 + rb], e = ej >> 16, j = ej & 0xffff;
        u.a = SPARSE ? (A + (size_t)e * A_EXPERT_STEP + (size_t)j * A_BLK_STEP) : (A + (size_t)rb * A_BLK_STEP);
        u.b = W + (size_t)e * W_EXPERT_STEP + (size_t)ct * W_CT_STEP; u.t0 = rb; u.t1 = ct | (e << 8); return true;
    }
};
struct EpiGu {
    bf16_t* ACT; const float* bgu_l; const float* xgs; const float* wgs_l; const int* tab;
    DI void operator()(const g8::AccI& acc, const g8::Unit& u, int wr, int wc, int fr, int fq) const {
        const int ct = u.t1 & 255, e = u.t1 >> 8;
        const int j0 = ct * 128 + 32 * wc + 8 * fq;
        const float* bg = bgu_l + (size_t)e * 2048 + j0;
        const f32x4 bg0 = *(const f32x4*)bg, bg1 = *(const f32x4*)(bg + 4), bl0 = *(const f32x4*)(bg + 1024), bl1 = *(const f32x4*)(bg + 1028);
        const float* ws_ = wgs_l + (size_t)e * 2048 + ct * 256 + 32 * wc + 8 * fq;
        const f32x4 sg0 = *(const f32x4*)ws_, sg1 = *(const f32x4*)(ws_ + 4), sl0 = *(const f32x4*)(ws_ + 128), sl1 = *(const f32x4*)(ws_ + 132);
        const int ej = tab[1 + u.t0];
        const float* xs = xgs + (size_t)(ej >> 16) * T + (ej & 0xffff) * 256;
        float sa_[2][4];
#pragma unroll
        for (int ai = 0; ai < 2; ++ai)
#pragma unroll
            for (int m = 0; m < 4; ++m) sa_[ai][m] = xs[128 * ai + 64 * wr + 16 * m + fr];
        __builtin_amdgcn_sched_barrier(0);
#pragma unroll
        for (int ai = 0; ai < 2; ++ai)
#pragma unroll
            for (int m = 0; m < 4; ++m) {
                const int rl = 128 * ai + 64 * wr + 16 * m + fr, row = u.t0 * 256 + rl;
                const float sa = sa_[ai][m];
                float v[8];
#pragma unroll
                for (int q = 0; q < 8; ++q) {
                    float glu = (float)acc[ai][0][m][q >> 2][q & 3] * (sa * ((q < 4) ? sg0[q & 3] : sg1[q & 3])) + ((q < 4) ? bg0[q & 3] : bg1[q & 3]);
                    float lin = (float)acc[ai][1][m][q >> 2][q & 3] * (sa * ((q < 4) ? sl0[q & 3] : sl1[q & 3])) + ((q < 4) ? bl0[q & 3] : bl1[q & 3]);
                    glu = fminf(glu, 7.0f); lin = fminf(fmaxf(lin, -7.0f), 7.0f);
                    v[q] = glu * sigmoidf_(1.702f * glu) * (lin + 1.0f);
                }
                u32x4 w; w.x = pk2(v[0], v[1]); w.y = pk2(v[2], v[3]); w.z = pk2(v[4], v[5]); w.w = pk2(v[6], v[7]);
                *(u32x4*)(ACT + (size_t)row * 1024 + j0) = w;
            }
    }
};
DI void phase_moe_gu(const Params& P, int l, char* lds) {
    unsigned char* ws = P.ws;
    const int* ecnt = (const int*)(ws + WS_CTL) + l * 32 * ECS;
    const int nblk = moe_build_table(ecnt, lds);
    MoeSched<8, true, (size_t)T * 1024, (size_t)256 * 1024, (size_t)2048 * 1024, (size_t)256 * 1024> S{(const char*)(ws + WS_XG), (const char*)(ws + WS_WGU + l * SZ_WGU), (const int*)(lds + MOE_TAB_OFF), nblk * 8, opaque_bid()};
    EpiGu E{(bf16_t*)(ws + WS_ACT), P.in[33] + (size_t)l * 32 * 2048, (const float*)(ws + WS_XGS), (const float*)(ws + WS_WGS) + (size_t)l * 32 * 2048, (const int*)(lds + MOE_TAB_OFF)};
    g8::gemm_phase<true, true>((LAS unsigned char*)lds, 512, 512, S, E);
}
struct EpiDown {
    bf16_t* Y; const float* bd_l;
    DI void operator()(const g8::Acc& acc, const g8::Unit& u, int wr, int wc, int fr, int fq) const {
        const int ct = u.t1 & 255, e = u.t1 >> 8;
#pragma unroll
        for (int bj = 0; bj < 2; ++bj) {
            const int col = ct * 256 + 128 * bj + 32 * wc + 8 * fq;
            const f32x4 b0 = *(const f32x4*)(bd_l + (size_t)e * 1024 + col), b1 = *(const f32x4*)(bd_l + (size_t)e * 1024 + col + 4);
#pragma unroll
            for (int ai = 0; ai < 2; ++ai)
#pragma unroll
                for (int m = 0; m < 4; ++m) {
                    const int row = u.t0 * 256 + 128 * ai + 64 * wr + 16 * m + fr;
                    const f32x4 v0 = acc[ai][bj][m][0] + b0, v1 = acc[ai][bj][m][1] + b1;
                    u32x4 w; w.x = pk2(v0.x, v0.y); w.y = pk2(v0.z, v0.w); w.z = pk2(v1.x, v1.y); w.w = pk2(v1.z, v1.w);
                    *(u32x4*)(Y + (size_t)row * 1024 + col) = w;
                }
        }
    }
};
DI void phase_moe_down(const Params& P, int l, char* lds) {
    unsigned char* ws = P.ws;
    const int nblk = ((const int*)(lds + MOE_TAB_OFF))[0];
    MoeSched<4, false, 0, (size_t)256 * 2048, (size_t)1024 * 2048, (size_t)256 * 2048> S{(const char*)(ws + WS_ACT), (const char*)(ws + WS_WDN + l * SZ_WDN), (const int*)(lds + MOE_TAB_OFF), nblk * 4, opaque_bid()};
    EpiDown E{(bf16_t*)(ws + WS_YMOE), P.in[35] + (size_t)l * 32 * 1024};
    g8::gemm_phase<true>((LAS unsigned char*)lds, 1024, 1024, S, E);
    if (l + 1 < NLAYER) {
        const int m = nblk - ((nblk - 1) >> 6) * 64;
        const int c_ = opaque_bid(), key = ((c_ & 7) * 8 + ((c_ >> 3) >> 2)) * 4 + ((c_ >> 3) & 3);
        if (m == 64) wdn_units(P, l + 1, XP_WDN_DOWN0, XP_WDN_DOWN1, c_, GRID);
        else if (key >= 4 * m) wdn_units(P, l + 1, XP_WDN_DOWN0, XP_WDN_DOWN1, key - 4 * m, GRID - 4 * m);
    }
}

constexpr int P3_SSM = NCHUNK * 2;
constexpr int P3_MLAQ = NQB * 3, P3_MLAKV = NQB * 4;
constexpr int P3_DIF = NT64;

DI const float* rope_tab(const unsigned char* ws) { return (const float*)(ws + WS_TAB); }

DI void dif_prep_unit(const Params& P, int l, int tile, char* lds) {
    unsigned char* ws = P.ws;
    const int tid = opaque_tid(), lane = tid & 63, wid = tid >> 6;
    const bf16_t* U = (const bf16_t*)(ws + WS_U);
    bf16_t* QD = (bf16_t*)(ws + WS_QD); bf16_t* KD = (bf16_t*)(ws + WS_KD); bf16_t* VDT = (bf16_t*)(ws + WS_VDT);
    const float* TABD = rope_tab(ws) + 320 * 16;
    const float* gq = P.in[16] + l * 64; const float* gk = P.in[17] + l * 64;
    const int sub = lane & 3, grp = lane >> 2;
    const float qscale = 0.125f * LOG2E;
    bf16_t* vs = (bf16_t*)lds;
    u32x4 ld0[8], ld1[8], ldv[8];
#pragma unroll
    for (int q = 0; q < 8; ++q) {
        const int t = tile * 64 + wid * 8 + q;
        const bf16_t* src = U + (size_t)t * NIN + U_DQ + grp * 64 + sub * 16;
        ld0[q] = *(const u32x4*)src; ld1[q] = *(const u32x4*)(src + 8);
        ldv[q] = *(const u32x4*)(U + (size_t)t * NIN + U_DV + lane * 8);
    }
#pragma unroll
    for (int q = 0; q < 8; ++q) {
        const int tl_ = wid * 8 + q, t = tile * 64 + tl_;
        const bool lat = t < SEQ;
        const u32x4 w0 = ld0[q], w1 = ld1[q];
        float x[16] = {bflo(w0.x), bfhi(w0.x), bflo(w0.y), bfhi(w0.y), bflo(w0.z), bfhi(w0.z), bflo(w0.w), bfhi(w0.w),
                       bflo(w1.x), bfhi(w1.x), bflo(w1.y), bfhi(w1.y), bflo(w1.z), bfhi(w1.z), bflo(w1.w), bfhi(w1.w)};
        float ss = 0.f;
#pragma unroll
        for (int i = 0; i < 16; ++i) ss += x[i] * x[i];
        ss = quad_sum(ss);
        const float rstd = rsqrtf(ss * (1.0f / 64.0f) + EPS);
        const float* g = (grp < 8 ? gq : gk) + sub * 16;
#pragma unroll
        for (int i = 0; i < 16; ++i) x[i] = x[i] * rstd * g[i];
        if (lat) {
            const int pos = (sub < 2) ? (t >> 6) : (256 + (t & 63));
            const float* cs = TABD + pos * 16; const float* sn = TABD + 320 * 16 + pos * 16;
#pragma unroll
            for (int i = 0; i < 16; ++i) {
                const float other = lane_xor1(x[i]);
                const float c = cs[i], s = sn[i];
                x[i] = (sub & 1) ? (x[i] * c + other * s) : (x[i] * c - other * s);
            }
        }
        if (grp < 8) {
#pragma unroll
            for (int i = 0; i < 16; ++i) x[i] *= qscale;
            st_bf16x16(QD + ((size_t)grp * T + t) * 64 + sub * 16, x);
        } else {
            st_fp8x16((unsigned char*)KD + ((size_t)(grp - 8) * T + t) * 64 + sub * 16, x);
        }
        *(u32x4*)(vs + tl_ * 520 + lane * 8) = ldv[q];
    }
    __syncthreads();
#pragma unroll 1
    for (int it = 0; it < 4; ++it) {
        const int cid = tid + it * NTHR;
        const int rowc = cid >> 2, pc = cid & 3;
        float e[16];
#pragma unroll
        for (int j = 0; j < 16; ++j) { const int key = kperm8(pc * 16 + j); e[j] = bf2f(vs[key * 520 + rowc]); }
        const int head = rowc >> 7, dv = rowc & 127;
        st_fp8x16((unsigned char*)VDT + (((size_t)head * NT64 + tile) * 128 + dv) * 64 + pc * 16, e);
    }
    __syncthreads();
}

DI void ssm_prep_unit(const Params& P, int l, int chunk, int g, char* lds) {
    unsigned char* ws = P.ws;
    const int tid = opaque_tid(), lane = tid & 63, wid = tid >> 6, r = lane & 31, h = lane >> 5;
    const bf16_t* U = (const bf16_t*)(ws + WS_U);
    const float* DTR = (const float*)(ws + WS_DTR);
    bf16_t* XST = (bf16_t*)(ws + WS_XST); bf16_t* BCN = (bf16_t*)(ws + WS_BCN);
    float* DTS = (float*)(ws + WS_DTS); float* CUM = (float*)(ws + WS_CUM); bf16_t* ST = (bf16_t*)(ws + WS_ST); float* DEC = (float*)(ws + WS_DEC);
    const float* cw = P.in[20] + (size_t)l * 5 * 1024; const float* cb = P.in[21] + (size_t)l * 1024;
    const int t0 = chunk * 128;
    const int seq_lo = (t0 < SEQ) ? 0 : SEQ, seq_hi = (t0 < SEQ) ? SEQ : T;
    constexpr int PT = 136;
    bf16_t* xsT = (bf16_t*)lds;
    bf16_t* bT = (bf16_t*)(lds + 69632);
    float* scl = (float*)(lds + 69632 + 34816);
    auto toff = [](int row, int pos) { return row * PT + ((((pos >> 3) ^ ((row >> 3) & 15)) << 3) | (pos & 7)); };
    {
        const int cg = tid & 63, ts = tid >> 6;
        int ch;
        if (cg < 32) ch = 256 * g + 8 * cg; else if (cg < 48) ch = 512 + 128 * g + 8 * (cg - 32); else ch = 768 + 128 * g + 8 * (cg - 48);
        float wv[5][8], bv[8];
#pragma unroll
        for (int k = 0; k < 5; ++k) {
            const f32x4 a = *(const f32x4*)(cw + (size_t)k * 1024 + ch), b2 = *(const f32x4*)(cw + (size_t)k * 1024 + ch + 4);
            wv[k][0] = a.x; wv[k][1] = a.y; wv[k][2] = a.z; wv[k][3] = a.w; wv[k][4] = b2.x; wv[k][5] = b2.y; wv[k][6] = b2.z; wv[k][7] = b2.w;
        }
        { const f32x4 a = *(const f32x4*)(cb + ch), b2 = *(const f32x4*)(cb + ch + 4); bv[0] = a.x; bv[1] = a.y; bv[2] = a.z; bv[3] = a.w; bv[4] = b2.x; bv[5] = b2.y; bv[6] = b2.z; bv[7] = b2.w; }
        const int tb = t0 + ts * 16;
        u32x4 raw[20];
#pragma unroll
        for (int i = 0; i < 20; ++i) { const int t = tb - 2 + i; raw[i] = (t >= seq_lo && t < seq_hi) ? *(const u32x4*)(U + (size_t)t * NIN + U_XS + ch) : (u32x4){0u, 0u, 0u, 0u}; }
#pragma unroll
        for (int q = 0; q < 16; ++q) {
            float y[8];
#pragma unroll
            for (int i = 0; i < 8; ++i) y[i] = bv[i];
#pragma unroll
            for (int k = 0; k < 5; ++k) { const u32x4 w = raw[q + k];
                y[0] += wv[k][0] * bflo(w.x); y[1] += wv[k][1] * bfhi(w.x); y[2] += wv[k][2] * bflo(w.y); y[3] += wv[k][3] * bfhi(w.y);
                y[4] += wv[k][4] * bflo(w.z); y[5] += wv[k][5] * bfhi(w.z); y[6] += wv[k][6] * bflo(w.w); y[7] += wv[k][7] * bfhi(w.w); }
#pragma unroll
            for (int i = 0; i < 8; ++i) y[i] = siluf_(y[i]);
            const int t = tb + q, tl_ = ts * 16 + q;
            u32x4 w; w.x = pk2(y[0], y[1]); w.y = pk2(y[2], y[3]); w.z = pk2(y[4], y[5]); w.w = pk2(y[6], y[7]);
            if (cg < 32) {
                const int pos = (tl_ & ~15) | kperm(tl_ & 15);
#pragma unroll
                for (int i = 0; i < 8; ++i) xsT[toff(8 * cg + i, pos)] = f2bf(y[i]);
            } else if (cg < 48) {
                *(u32x4*)(BCN + (size_t)t * 512 + 128 * g + 8 * (cg - 32)) = w;
#pragma unroll
                for (int i = 0; i < 8; ++i) bT[toff(8 * (cg - 32) + i, tl_)] = f2bf(y[i]);
            } else {
                *(u32x4*)(BCN + (size_t)t * 512 + 256 + 128 * g + 8 * (cg - 48)) = w;
            }
        }
    }
    {
        const int j = wid, d = j >> 2, hh = 4 * g + (j & 3);
        const float a = -__expf(P.in[23][l * 16 + d * 8 + hh]);
        const float bias = P.in[22][l * 16 + d * 8 + hh];
        const int i0 = 2 * lane, i1 = 2 * lane + 1;
        const int k0 = d ? 127 - i0 : i0, k1 = d ? 127 - i1 : i1;
        const float r0 = DTR[(size_t)(t0 + k0) * 16 + d * 8 + hh] + bias, r1 = DTR[(size_t)(t0 + k1) * 16 + d * 8 + hh] + bias;
        const float sp0 = (r0 > 20.f) ? r0 : log1pf(__expf(r0)), sp1 = (r1 > 20.f) ? r1 : log1pf(__expf(r1));
        const float x0 = sp0 * a, x1 = sp1 * a;
        float incl = x0 + x1;
#pragma unroll
        for (int sft = 1; sft < 64; sft <<= 1) { const float tv = __shfl_up(incl, sft); if (lane >= sft) incl += tv; }
        const float c0 = incl - x1, c1 = incl;
        const float tot = __shfl(incl, 63);
        DTS[(size_t)(t0 + k0) * 16 + d * 8 + hh] = sp0; DTS[(size_t)(t0 + k1) * 16 + d * 8 + hh] = sp1;
        CUM[(size_t)(t0 + k0) * 16 + d * 8 + hh] = c0; CUM[(size_t)(t0 + k1) * 16 + d * 8 + hh] = c1;
        if (lane == 0) DEC[(size_t)chunk * 16 + d * 8 + hh] = __expf(tot);
        scl[j * 128 + ((k0 & ~15) | kperm(k0 & 15))] = sp0 * __expf(tot - c0);
        scl[j * 128 + ((k1 & ~15) | kperm(k1 & 15))] = sp1 * __expf(tot - c1);
    }
    __syncthreads();
    for (int i = tid; i < 256 * 16; i += NTHR) {
        const int chl = i >> 4, pc = i & 15;
        *(u32x4*)(XST + ((size_t)chunk * 512 + 256 * g + chl) * 128 + pc * 8) = *(const u32x4*)(xsT + toff(chl, pc * 8));
    }
    {
        const int j = wid, d = j >> 2, hl = j & 3, hh = 4 * g + hl;
        f32x16 acc[4][2];
#pragma unroll
        for (int nb = 0; nb < 4; ++nb)
#pragma unroll
            for (int pb = 0; pb < 2; ++pb)
#pragma unroll
                for (int i = 0; i < 16; ++i) acc[nb][pb][i] = 0.f;
        const int pr = perm32(r);
#pragma unroll 1
        for (int ks = 0; ks < 8; ++ks) {
            const f32x4 s0 = *(const f32x4*)(scl + j * 128 + 16 * ks + 8 * h), s1 = *(const f32x4*)(scl + j * 128 + 16 * ks + 8 * h + 4);
            bf16x8 xf[2];
#pragma unroll
            for (int pb = 0; pb < 2; ++pb) {
                const u32x4 w = *(const u32x4*)(xsT + toff(hl * 64 + pb * 32 + r, 16 * ks + 8 * h));
                u32x4 o; o.x = pk2(bflo(w.x) * s0.x, bfhi(w.x) * s0.y); o.y = pk2(bflo(w.y) * s0.z, bfhi(w.y) * s0.w);
                o.z = pk2(bflo(w.z) * s1.x, bfhi(w.z) * s1.y); o.w = pk2(bflo(w.w) * s1.z, bfhi(w.w) * s1.w);
                xf[pb] = __builtin_bit_cast(bf16x8, o);
            }
#pragma unroll
            for (int nb = 0; nb < 4; ++nb) {
                const u32x2 lo = *(const u32x2*)(bT + toff(nb * 32 + pr, 16 * ks + 4 * h)), hi = *(const u32x2*)(bT + toff(nb * 32 + pr, 16 * ks + 8 + 4 * h));
                u32x4 bw; bw.x = lo.x; bw.y = lo.y; bw.z = hi.x; bw.w = hi.y;
                const bf16x8 bf = __builtin_bit_cast(bf16x8, bw);
#pragma unroll
                for (int pb = 0; pb < 2; ++pb) acc[nb][pb] = MFMA32(bf, xf[pb], acc[nb][pb]);
            }
        }
        bf16_t* dst = ST + (((size_t)chunk * 2 + d) * 8 + hh) * 8192;
#pragma unroll
        for (int nb = 0; nb < 4; ++nb)
#pragma unroll
            for (int pb = 0; pb < 2; ++pb) { float v[16];
#pragma unroll
                for (int i = 0; i < 16; ++i) v[i] = acc[nb][pb][i];
                st_bf16x16(dst + (size_t)(pb * 32 + r) * 128 + nb * 32 + 16 * h, v); }
    }
    __syncthreads();
}

DI int first_unit(int off) { const int G = GRID; int v = opaque_bid() - (off % G); if (v < 0) v += G; return v; }
struct P3Sched {
    g8::GridSched<NQB, 7> G; const char* Bkv; size_t aoff;
    DI bool next(int i, g8::Unit& u) const {
        if (!G.next(i, u)) return false;
        if (u.t1 >= 3) { u.a += aoff; u.b = Bkv + (size_t)(u.t1 - 3) * G.bstep; }
        return true;
    }
};
struct EpiP3 {
    bf16_t* Q; bf16_t* KV;
    DI void operator()(const g8::Acc& acc, const g8::Unit& u, int wr, int wc, int fr, int fq) const {
        g8::Unit v = u;
        if (u.t1 < 3) { EpiBf16Plain e{Q, 768}; e(acc, v, wr, wc, fr, fq); }
        else { v.t1 = u.t1 - 3; EpiBf16Plain e{KV, 1024}; e(acc, v, wr, wc, fr, fq); }
    }
};
DI void phase_p3(const Params& P, int l, char* lds) {
    unsigned char* ws = P.ws;
    const int G = GRID;
    const bf16_t* U = (const bf16_t*)(ws + WS_U);
    for (int v = first_unit(0); v < P3_SSM; v += G) ssm_prep_unit(P, l, v >> 1, v & 1, lds);
    for (int v = first_unit(P3_SSM); v < P3_DIF; v += G) dif_prep_unit(P, l, v, lds);
    { P3Sched S; S.G.init(U + U_CQ, NIN, ws + WS_WUQ + l * SZ_WUQ, 256);
      S.G.gs = GRID - 8; S.G.c = (S.G.c < 8) ? (1 << 20) : (S.G.c - 8);
      S.Bkv = (const char*)(ws + WS_WUKV + l * SZ_WUKV); S.aoff = (size_t)(U_CKV - U_CQ) * 2;
      EpiP3 E{(bf16_t*)(ws + WS_QRAW), (bf16_t*)(ws + WS_KVRAW)};
      g8::gemm_phase<true>((LAS unsigned char*)lds, 256, NIN, S, E); }
}

DI void mla_finalize_unit(const Params& P, int l, int tile, char* lds) {
    unsigned char* ws = P.ws;
    const int tid = opaque_tid(), lane = tid & 63, wid = tid >> 6;
    const bf16_t* U = (const bf16_t*)(ws + WS_U);
    const bf16_t* QRAW = (const bf16_t*)(ws + WS_QRAW); const bf16_t* KVRAW = (const bf16_t*)(ws + WS_KVRAW);
    bf16_t* QM = (bf16_t*)(ws + WS_QM); bf16_t* KM = (bf16_t*)(ws + WS_KM); bf16_t* VMT = (bf16_t*)(ws + WS_VMT);
    const float* TABM = rope_tab(ws);
    const float* gqn = P.in[14] + l * 96; const float* gkn = P.in[15] + l * 96;
    const int head = lane >> 3, sub = lane & 7;
    const bool act = sub < 6;
    const float qscale = 0.10206207261596575f * LOG2E;
    bf16_t* vs = (bf16_t*)lds;
#pragma unroll 1
    for (int qb = 0; qb < 2; ++qb) {
    u32x2 l_cq[4]; unsigned l_ckv[4]; u32x4 l_q0[4], l_q1[4], l_k0[4], l_k1[4], l_v[4];
#pragma unroll
    for (int qq = 0; qq < 4; ++qq) {
        const int t = tile * 64 + wid * 8 + qb * 4 + qq;
        l_cq[qq] = *(const u32x2*)(U + (size_t)t * NIN + U_CQ + lane * 4);
        l_ckv[qq] = *(const unsigned*)(U + (size_t)t * NIN + U_CKV + lane * 2);
        if (act) { const bf16_t* src = QRAW + (size_t)t * 768 + head * 96 + sub * 16; l_q0[qq] = *(const u32x4*)src; l_q1[qq] = *(const u32x4*)(src + 8);
            const bf16_t* ks = (sub < 4) ? (KVRAW + (size_t)t * 1024 + head * 128 + sub * 16) : (U + (size_t)t * NIN + U_KR + (sub - 4) * 16);
            l_k0[qq] = *(const u32x4*)ks; l_k1[qq] = *(const u32x4*)(ks + 8); }
        else { l_q0[qq] = l_q1[qq] = l_k0[qq] = l_k1[qq] = (u32x4){0u, 0u, 0u, 0u}; }
        l_v[qq] = *(const u32x4*)(KVRAW + (size_t)t * 1024 + (lane >> 3) * 128 + 64 + (lane & 7) * 8);
    }
#pragma unroll
    for (int qq = 0; qq < 4; ++qq) {
        const int q = qb * 4 + qq;
        const int tl_ = wid * 8 + q, t = tile * 64 + tl_;
        const bool lat = t < SEQ;
        float rq, rkv;
        { const u32x2 w = l_cq[qq];
          float s = bflo(w.x) * bflo(w.x) + bfhi(w.x) * bfhi(w.x) + bflo(w.y) * bflo(w.y) + bfhi(w.y) * bfhi(w.y);
          s = wave_sum(s); rq = rsqrtf(s * (1.0f / 256.0f) + EPS);
          const unsigned w2 = l_ckv[qq];
          float s2 = bflo(w2) * bflo(w2) + bfhi(w2) * bfhi(w2);
          s2 = wave_sum(s2); rkv = rsqrtf(s2 * (1.0f / 128.0f) + EPS); }
        const int prow = t >> 6, pcol = 256 + (t & 63);
        {
            float x[16];
            { const u32x4 w0 = l_q0[qq], w1 = l_q1[qq];
                const unsigned ww[8] = {w0.x, w0.y, w0.z, w0.w, w1.x, w1.y, w1.z, w1.w};
#pragma unroll
                for (int i = 0; i < 8; ++i) { x[2 * i] = bflo(ww[i]) * rq; x[2 * i + 1] = bfhi(ww[i]) * rq; } }
            float ss = 0.f;
#pragma unroll
            for (int i = 0; i < 16; ++i) ss += x[i] * x[i];
            ss = oct_sum(ss);
            const float rstd = rsqrtf(ss * (1.0f / 96.0f) + EPS);
            if (act) {
#pragma unroll
                for (int i = 0; i < 16; ++i) x[i] = x[i] * rstd * gqn[sub * 16 + i];
                if (lat && sub >= 4) {
                    const int pos = (sub == 4) ? prow : pcol;
                    const float* cs = TABM + pos * 8; const float* sn = TABM + 320 * 8 + pos * 8;
#pragma unroll
                    for (int i = 0; i < 8; ++i) { const float a = x[i], b2 = x[8 + i], c = cs[i], s = sn[i]; x[i] = a * c - b2 * s; x[8 + i] = b2 * c + a * s; }
                }
#pragma unroll
                for (int i = 0; i < 16; ++i) x[i] *= qscale;
                st_bf16x16(QM + ((size_t)head * T + t) * 96 + sub * 16, x);
            }
        }
        {
            float x[16];
            { const float sc = (sub < 4) ? rkv : 1.0f;
                const u32x4 w0 = l_k0[qq], w1 = l_k1[qq];
                const unsigned ww[8] = {w0.x, w0.y, w0.z, w0.w, w1.x, w1.y, w1.z, w1.w};
#pragma unroll
                for (int i = 0; i < 8; ++i) { x[2 * i] = bflo(ww[i]) * sc; x[2 * i + 1] = bfhi(ww[i]) * sc; } }
            float ss = 0.f;
#pragma unroll
            for (int i = 0; i < 16; ++i) ss += x[i] * x[i];
            ss = oct_sum(ss);
            const float rstd = rsqrtf(ss * (1.0f / 96.0f) + EPS);
            if (act) {
#pragma unroll
                for (int i = 0; i < 16; ++i) x[i] = x[i] * rstd * gkn[sub * 16 + i];
                if (lat && sub >= 4) {
                    const int pos = (sub == 4) ? prow : pcol;
                    const float* cs = TABM + pos * 8; const float* sn = TABM + 320 * 8 + pos * 8;
#pragma unroll
                    for (int i = 0; i < 8; ++i) { const float a = x[i], b2 = x[8 + i], c = cs[i], s = sn[i]; x[i] = a * c - b2 * s; x[8 + i] = b2 * c + a * s; }
                }
                st_fp8x16((unsigned char*)KM + ((size_t)head * T + t) * 96 + sub * 16, x);
            }
        }
        {
            const int hh = lane >> 3, dv0 = (lane & 7) * 8;
            const u32x4 w = l_v[qq];
            u32x4 o; o.x = pk2(bflo(w.x) * rkv, bfhi(w.x) * rkv); o.y = pk2(bflo(w.y) * rkv, bfhi(w.y) * rkv); o.z = pk2(bflo(w.z) * rkv, bfhi(w.z) * rkv); o.w = pk2(bflo(w.w) * rkv, bfhi(w.w) * rkv);
            *(u32x4*)(vs + tl_ * 520 + hh * 64 + dv0) = o;
        }
    }
    }
    __syncthreads();
#pragma unroll 1
    for (int it = 0; it < 4; ++it) {
        const int cid = tid + it * NTHR;
        const int rowc = cid >> 2, pc = cid & 3;
        float e[16];
#pragma unroll
        for (int j = 0; j < 16; ++j) { const int key = kperm8(pc * 16 + j); e[j] = bf2f(vs[key * 520 + rowc]); }
        const int hh = rowc >> 6, dv = rowc & 63;
        st_fp8x16((unsigned char*)VMT + (((size_t)hh * NT64 + tile) * 64 + dv) * 64 + pc * 16, e);
    }
    __syncthreads();
}

DI void ssd_scan(const Params& P) {
    unsigned char* ws = P.ws;
    const bf16_t* __restrict__ ST = (const bf16_t*)(ws + WS_ST); const float* __restrict__ DEC = (const float*)(ws + WS_DEC);
    bf16_t* __restrict__ HIN = (bf16_t*)(ws + WS_HIN);
    const int total = 2 * 8 * 8192;
    static_assert(2 * 8 * 8192 == GRID * NTHR, "one element per thread");
    const int bid_ = opaque_bid();
    const int nsh = (bid_ < 4) ? 0 : ((bid_ < 8) ? 2 : 1);
#pragma unroll 1
    for (int sh = 0; sh < nsh; ++sh) {
        const int e = (sh == 0 ? bid_ : bid_ - 4) * NTHR + opaque_tid();
        const int dh = __builtin_amdgcn_readfirstlane(e >> 13), d = dh >> 3;
        float hst = 0.f;
#pragma unroll 1
        for (int b = 0; b < 5; ++b) {
            bf16_t stv[26]; float dcv[26];
#pragma unroll
            for (int j = 0; j < 26; ++j) {
                const int s = b * 26 + j;
                const int c = (d == 0) ? ((s < 2) ? (128 + s) : (s - 2)) : (129 - s);
                stv[j] = ST[(size_t)c * (16 * 8192) + e]; dcv[j] = DEC[c * 16 + dh];
            }
            __builtin_amdgcn_sched_barrier(0);
#pragma unroll
            for (int j = 0; j < 26; ++j) {
                const int s = b * 26 + j;
                const int c = (d == 0) ? ((s < 2) ? (128 + s) : (s - 2)) : (129 - s);
                HIN[(size_t)c * (16 * 8192) + e] = f2bf(hst);
                hst = hst * dcv[j] + bf2f(stv[j]);
            }
            __builtin_amdgcn_sched_barrier(0);
        }
    }
    (void)total;
}

DI void phase_p3b(const Params& P, int l, char* lds) {
    ssd_scan(P);
    for (int u = blockIdx.x; u < NT64; u += GRID) mla_finalize_unit(P, l, u, lds);
}

DI float gain_bound(const float* g, int n) { float m = 0.f; for (int i = 0; i < n; ++i) m = fmaxf(m, fabsf(g[i])); return m; }

DI void mla_attn_unit(const Params& P, int l, int head, int qb, char* lds, float shift) {
    unsigned char* ws = P.ws;
    const int tid = opaque_tid(), lane = tid & 63, wid = tid >> 6, r = lane & 31, h = lane >> 5;
    const bf16_t* QM = (const bf16_t*)(ws + WS_QM) + (size_t)head * T * 96;
    const unsigned char* KM = (const unsigned char*)(ws + WS_KM) + (size_t)head * T * 96;
    const unsigned char* VMT = (const unsigned char*)(ws + WS_VMT) + (size_t)head * T * 64;
    bf16_t* YA = (bf16_t*)(ws + WS_YA);
    const int kt0 = (qb == NQB - 1) ? (SEQ / 64) : 0, kt1 = NT64;
    f32x16 o[2]; float ls;
    attn_core<96, 64>(lds, QM + (size_t)(qb * 256 + wid * 32) * 96, KM, VMT, kt0, kt1, shift, o, ls);
    const float inv = 1.0f / ls;
    const int t = qb * 256 + wid * 32 + r;
#pragma unroll
    for (int db = 0; db < 2; ++db) { float v[16];
#pragma unroll
        for (int i = 0; i < 16; ++i) v[i] = o[db][i] * inv;
        st_bf16x16(YA + (size_t)t * 512 + head * 64 + db * 32 + 16 * h, v); }
}

DI void dif_attn_unit(const Params& P, int l, int head, int qb, char* lds, float shift, float lam, float lam_init) {
    unsigned char* ws = P.ws;
    const int tid = opaque_tid(), lane = tid & 63, wid = tid >> 6, r = lane & 31, h = lane >> 5;
    const unsigned char* VDT = (const unsigned char*)(ws + WS_VDT) + (size_t)head * T * 128;
    bf16_t* YB = (bf16_t*)(ws + WS_YB);
    float* O1 = (float*)(ws + WS_O1) + (size_t)blockIdx.x * 256 * 128;
    const int kt0 = (qb == NQB - 1) ? (SEQ / 64) : 0, kt1 = NT64;
    const int rowl = wid * 32 + r;
    {
        const int vh = head * 2;
        const bf16_t* QD = (const bf16_t*)(ws + WS_QD) + (size_t)vh * T * 64;
        const unsigned char* KD = (const unsigned char*)(ws + WS_KD) + (size_t)vh * T * 64;
        f32x16 o[4]; float ls;
        attn_core<64, 128>(lds, QD + (size_t)(qb * 256 + wid * 32) * 64, KD, VDT, kt0, kt1, shift, o, ls);
        const float inv = 1.0f / ls;
#pragma unroll
        for (int db = 0; db < 4; ++db)
#pragma unroll
            for (int q = 0; q < 4; ++q)
                *(f32x4*)(O1 + (size_t)rowl * 128 + db * 32 + 16 * h + 4 * q) = (f32x4){o[db][4 * q] * inv, o[db][4 * q + 1] * inv, o[db][4 * q + 2] * inv, o[db][4 * q + 3] * inv};
    }
    {
        const int vh = head * 2 + 1;
        const bf16_t* QD = (const bf16_t*)(ws + WS_QD) + (size_t)vh * T * 64;
        const unsigned char* KD = (const unsigned char*)(ws + WS_KD) + (size_t)vh * T * 64;
        f32x16 o[4]; float ls;
        attn_core<64, 128>(lds, QD + (size_t)(qb * 256 + wid * 32) * 64, KD, VDT, kt0, kt1, shift, o, ls);
        const float inv = 1.0f / ls;
        float ss = 0.f;
#pragma unroll
        for (int db = 0; db < 4; ++db)
#pragma unroll
            for (int q = 0; q < 4; ++q) {
                const f32x4 a = *(const f32x4*)(O1 + (size_t)rowl * 128 + db * 32 + 16 * h + 4 * q);
                o[db][4 * q] = a.x - lam * o[db][4 * q] * inv; o[db][4 * q + 1] = a.y - lam * o[db][4 * q + 1] * inv;
                o[db][4 * q + 2] = a.z - lam * o[db][4 * q + 2] * inv; o[db][4 * q + 3] = a.w - lam * o[db][4 * q + 3] * inv;
                ss += o[db][4 * q] * o[db][4 * q] + o[db][4 * q + 1] * o[db][4 * q + 1] + o[db][4 * q + 2] * o[db][4 * q + 2] + o[db][4 * q + 3] * o[db][4 * q + 3];
            }
        ss += __shfl_xor(ss, 32);
        const float rstd = rsqrtf(ss * (1.0f / 128.0f) + EPS) * (1.0f - lam_init);
        const float* gs = P.in[19] + l * 128;
        const int t = qb * 256 + rowl;
#pragma unroll
        for (int db = 0; db < 4; ++db) { float v[16];
#pragma unroll
            for (int i = 0; i < 16; ++i) v[i] = o[db][i] * rstd * gs[db * 32 + 16 * h + i];
            st_bf16x16(YB + (size_t)t * 512 + head * 128 + db * 32 + 16 * h, v); }
    }
}

DI void ssd_out_unit(const Params& P, int l, int chunk, int hf, int g, char* lds) {
    unsigned char* ws = P.ws;
    const int tid = opaque_tid(), lane = tid & 63, wid = tid >> 6, r = lane & 31, h = lane >> 5;
    const bf16_t* U = (const bf16_t*)(ws + WS_U);
    const bf16_t* XST = (const bf16_t*)(ws + WS_XST); const bf16_t* BCN = (const bf16_t*)(ws + WS_BCN);
    const float* DTS = (const float*)(ws + WS_DTS); const float* CUM = (const float*)(ws + WS_CUM);
    const bf16_t* HIN = (const bf16_t*)(ws + WS_HIN);
    bf16_t* YC = (bf16_t*)(ws + WS_YC);
    const int t0 = chunk * 128;
    char* Bs = lds; char* Cs = lds + 32768; char* Xs = lds + 49152;
    float* dt0 = (float*)(lds + 114688);
    float* dt1 = dt0 + 512; float* cm0 = dt1 + 512; float* cm1 = cm0 + 512;
    float* ssq = cm1 + 512;
    bf16x8 hq[2][8];
    { const int hl_ = wid >> 1, hh_ = 4 * g + hl_, pr_ = perm32(r);
      const bf16_t* hp_ = HIN + (((size_t)chunk * 2 + 0) * 8 + hh_) * 8192;
#pragma unroll
      for (int pb = 0; pb < 2; ++pb)
#pragma unroll
          for (int ks = 0; ks < 8; ++ks) hq[pb][ks] = *(const bf16x8*)(hp_ + (size_t)(pb * 32 + pr_) * 128 + 16 * ks + 8 * h); }
    {
        u32x4 tb_[4], tc_[2], tx_[8]; float ts_[4];
#pragma unroll
        for (int j = 0; j < 4; ++j) { const int i = tid + j * NTHR, row = i >> 4, c = i & 15; tb_[j] = *(const u32x4*)(BCN + (size_t)(t0 + row) * 512 + 128 * g + c * 8); }
#pragma unroll
        for (int j = 0; j < 2; ++j) { const int i = tid + j * NTHR, row = i >> 4, c = i & 15; tc_[j] = *(const u32x4*)(BCN + (size_t)(t0 + hf * 64 + row) * 512 + 256 + 128 * g + c * 8); }
#pragma unroll
        for (int j = 0; j < 8; ++j) { const int i = tid + j * NTHR, row = i >> 4, c = i & 15; tx_[j] = *(const u32x4*)(XST + ((size_t)chunk * 512 + 256 * g + row) * 128 + c * 8); }
        { const int hl_ = tid >> 7, s_ = tid & 127, hh_ = 4 * g + hl_; const size_t b_ = (size_t)(t0 + s_) * 16;
          ts_[0] = DTS[b_ + hh_]; ts_[1] = DTS[b_ + 8 + hh_]; ts_[2] = CUM[b_ + hh_]; ts_[3] = CUM[b_ + 8 + hh_]; }
#pragma unroll
        for (int j = 0; j < 4; ++j) { const int i = tid + j * NTHR, row = i >> 4, c = i & 15; *(u32x4*)(Bs + row * 256 + ((c ^ (row & 15)) << 4)) = tb_[j]; }
#pragma unroll
        for (int j = 0; j < 2; ++j) { const int i = tid + j * NTHR, row = i >> 4, c = i & 15; *(u32x4*)(Cs + row * 256 + ((c ^ (row & 15)) << 4)) = tc_[j]; }
#pragma unroll
        for (int j = 0; j < 8; ++j) { const int i = tid + j * NTHR, row = i >> 4, c = i & 15; *(u32x4*)(Xs + row * 256 + ((c ^ (row & 15)) << 4)) = tx_[j]; }
        dt0[tid] = ts_[0]; dt1[tid] = ts_[1]; cm0[tid] = ts_[2]; cm1[tid] = ts_[3];
    }
    __syncthreads();
    const int hl = wid >> 1, lb = wid & 1, hh = 4 * g + hl;
    const int lrow = hf * 64 + lb * 32 + r;
    const int pr = perm32(r);
    bf16x8 cf[8];
    { const int crow_ = lb * 32 + r;
#pragma unroll
      for (int ks = 0; ks < 8; ++ks) cf[ks] = *(const bf16x8*)(Cs + crow_ * 256 + (((2 * ks + h) ^ (crow_ & 15)) << 4)); }
    const float c0l = cm0[hl * 128 + lrow], c1l = cm1[hl * 128 + lrow];
    f32x16 y[2];
#pragma unroll
    for (int pb = 0; pb < 2; ++pb)
#pragma unroll
        for (int i = 0; i < 16; ++i) y[pb][i] = 0.f;
#define SSD_OFFDIAG(d) do { f32x16 a_[2]; \
        _Pragma("unroll") for (int pb = 0; pb < 2; ++pb) _Pragma("unroll") for (int i = 0; i < 16; ++i) a_[pb][i] = 0.f; \
        _Pragma("unroll") for (int ks = 0; ks < 8; ++ks) _Pragma("unroll") for (int pb = 0; pb < 2; ++pb) a_[pb] = MFMA32(hq[pb][ks], cf[ks], a_[pb]); \
        const float e_ = __expf((d) == 0 ? c0l : c1l); \
        _Pragma("unroll") for (int pb = 0; pb < 2; ++pb) _Pragma("unroll") for (int i = 0; i < 16; ++i) y[pb][i] += e_ * a_[pb][i]; } while (0)
#define SSD_LDH(d) do { const bf16_t* hp_ = HIN + (((size_t)chunk * 2 + (d)) * 8 + hh) * 8192; \
        _Pragma("unroll") for (int pb = 0; pb < 2; ++pb) _Pragma("unroll") for (int ks = 0; ks < 8; ++ks) hq[pb][ks] = *(const bf16x8*)(hp_ + (size_t)(pb * 32 + pr) * 128 + 16 * ks + 8 * h); } while (0)
    SSD_OFFDIAG(0);
    SSD_LDH(1);
#pragma unroll 1
    for (int sb = 0; sb < 4; ++sb) {
        f32x16 x;
#pragma unroll
        for (int i = 0; i < 16; ++i) x[i] = 0.f;
        const int brow = sb * 32 + r;
#pragma unroll
        for (int ks = 0; ks < 8; ++ks) {
            const bf16x8 bf = *(const bf16x8*)(Bs + brow * 256 + (((2 * ks + h) ^ (brow & 15)) << 4));
            x = MFMA32(bf, cf[ks], x);
        }
        float m[16];
#pragma unroll
        for (int q4 = 0; q4 < 4; ++q4) {
            const int s0 = sb * 32 + 8 * q4 + 4 * h;
            const f32x4 vc0 = *(const f32x4*)(cm0 + hl * 128 + s0), vc1 = *(const f32x4*)(cm1 + hl * 128 + s0);
            const f32x4 vd0 = *(const f32x4*)(dt0 + hl * 128 + s0), vd1 = *(const f32x4*)(dt1 + hl * 128 + s0);
#pragma unroll
            for (int jj = 0; jj < 4; ++jj) {
                const int s = s0 + jj;
                const float w0 = (s <= lrow) ? __expf(fminf(c0l - vc0[jj], 0.f)) * vd0[jj] : 0.f;
                const float w1 = (s >= lrow) ? __expf(fminf(c1l - vc1[jj], 0.f)) * vd1[jj] : 0.f;
                m[4 * q4 + jj] = x[4 * q4 + jj] * (w0 + w1);
            }
        }
#pragma unroll
        for (int s2 = 0; s2 < 2; ++s2) {
            u32x4 w; w.x = pk2(m[8 * s2 + 0], m[8 * s2 + 1]); w.y = pk2(m[8 * s2 + 2], m[8 * s2 + 3]); w.z = pk2(m[8 * s2 + 4], m[8 * s2 + 5]); w.w = pk2(m[8 * s2 + 6], m[8 * s2 + 7]);
            const bf16x8 mf = __builtin_bit_cast(bf16x8, w);
#pragma unroll
            for (int pb = 0; pb < 2; ++pb) {
                const int xrow = hl * 64 + pb * 32 + pr, c = 2 * (2 * sb + s2) + h;
                const bf16x8 xf = *(const bf16x8*)(Xs + xrow * 256 + ((c ^ (xrow & 15)) << 4));
                y[pb] = MFMA32(xf, mf, y[pb]);
            }
        }
    }
    SSD_OFFDIAG(1);
#undef SSD_OFFDIAG
#undef SSD_LDH
    const int t = t0 + lrow;
    const float dsk = P.in[24][l * 16 + hh] + P.in[24][l * 16 + 8 + hh];
    float ss = 0.f;
#pragma unroll
    for (int pb = 0; pb < 2; ++pb) {
        const int ch = hh * 64 + pb * 32 + 16 * h;
        const u32x4 z0 = *(const u32x4*)(U + (size_t)t * NIN + U_Z + ch), z1 = *(const u32x4*)(U + (size_t)t * NIN + U_Z + ch + 8);
        const unsigned zw[8] = {z0.x, z0.y, z0.z, z0.w, z1.x, z1.y, z1.z, z1.w};
        const int xpos = (lrow & ~15) | kperm(lrow & 15);
#pragma unroll
        for (int q = 0; q < 8; ++q) {
            const int xr0 = hl * 64 + pb * 32 + 16 * h + 2 * q, xr1 = xr0 + 1;
            const float xa = bf2f(*(const bf16_t*)(Xs + xr0 * 256 + (((xpos >> 3) ^ (xr0 & 15)) << 4) + (xpos & 7) * 2));
            const float xb = bf2f(*(const bf16_t*)(Xs + xr1 * 256 + (((xpos >> 3) ^ (xr1 & 15)) << 4) + (xpos & 7) * 2));
            float v0 = y[pb][2 * q] + dsk * xa, v1 = y[pb][2 * q + 1] + dsk * xb;
            v0 *= siluf_(bflo(zw[q])); v1 *= siluf_(bfhi(zw[q]));
            y[pb][2 * q] = v0; y[pb][2 * q + 1] = v1; ss += v0 * v0 + v1 * v1;
        }
    }
    ss += __shfl_xor(ss, 32);
    if (h == 0) ssq[hl * 64 + lb * 32 + r] = ss;
    __syncthreads();
    const int rr = lb * 32 + r;
    const float tot = ssq[rr] + ssq[64 + rr] + ssq[128 + rr] + ssq[192 + rr];
    const float rstd = rsqrtf(tot * (1.0f / 256.0f) + EPS);
    const float* gn = P.in[25] + l * 512;
#pragma unroll
    for (int pb = 0; pb < 2; ++pb) { const int ch = hh * 64 + pb * 32 + 16 * h; float v[16];
#pragma unroll
        for (int i = 0; i < 16; ++i) v[i] = y[pb][i] * rstd * gn[ch + i];
        st_bf16x16(YC + (size_t)t * 512 + ch, v); }
    __syncthreads();
}

constexpr int P4_DIF = 4 * NQB, P4_MLA = 8 * NQB, P4_SSD = NCHUNK * 4;

DI void phase_p4(const Params& P, int l, char* lds) {
    const int G = GRID;
    const float* ac_ = (const float*)((const int*)(P.ws + WS_CTL) + l * 32 * ECS + 40);
    const float sh_m = ac_[0], sh_d = ac_[1];
    float lam = ac_[2];
    const float lam_init = 0.8f - 0.6f * __expf(-0.3f * (float)l);
    lam += lam_init;
    const bool lastl = (l == NLAYER - 1);
    const int ndif = lastl ? 4 * (NQB - 1) : P4_DIF, nmla = lastl ? 8 * (NQB - 1) : P4_MLA, nssd = lastl ? (NCHUNK - 2) * 4 : P4_SSD;
    for (int v = first_unit(0); v < ndif; v += G) dif_attn_unit(P, l, v & 3, v >> 2, lds, sh_d, lam, lam_init);
    for (int v = first_unit(P4_DIF); v < nmla; v += G) mla_attn_unit(P, l, v & 7, v >> 3, lds, sh_m);
    {
        int* wq = (int*)(P.ws + WS_CTL) + l * 32 * ECS + 32;
        int* sl = (int*)(lds + 160000);
        for (;;) {
            __syncthreads();
            if (opaque_tid() == 0) *sl = __hip_atomic_fetch_add(wq, 1, __ATOMIC_RELAXED, __HIP_MEMORY_SCOPE_AGENT);
            __syncthreads();
            const int v = __builtin_amdgcn_readfirstlane(*sl);
            if (v >= nssd) break;
            ssd_out_unit(P, l, v >> 2, (v >> 1) & 1, v & 1, lds);
        }
    }
}

constexpr int N_PHASES = 2 + 10 * NLAYER;
#ifndef MK_PER_PHASE
#define MK_PER_PHASE 0
#endif

template <bool FUSED>
__global__ void __launch_bounds__(NTHR, 2) mega_fwd(Params P0) {
    extern __shared__ __attribute__((aligned(16))) char lds[];
    const int lo = FUSED ? 0 : P0.ph_lo, hi = FUSED ? N_PHASES : P0.ph_hi;
    constexpr bool fused = FUSED;
    volatile LAS unsigned* xbw = (volatile LAS unsigned*)(lds + LDS_BYTES - 16);
    XcdBarrier bar; bar.bar = (unsigned*)(P0.ws + WS_BAR); bar.x = 0; bar.st = xbw;
    if (fused) {
        if (threadIdx.x == 0) { xbw[0] = 0u; xbw[1] = 0u; xbw[2] = 0u; xbw[3] = 0u; }
        __syncthreads();
        bar = xcd_barrier_post((unsigned*)(P0.ws + WS_BAR), xbw);
    }
#define IN(k) (FUSED || (lo <= (k) && (k) < hi))
#define SEAM(k) do { if (FUSED) { if ((k) + 1 < N_PHASES) { XcdBarrier b2_ = bar; b2_.x = xb_xcc_id(); xcd_barrier(b2_); } } } while (0)
    if (IN(0)) phase_prologue(P0, lds);
    SEAM(0);
    if (IN(1)) phase_rows_norm1(P0, -1, 0);
    SEAM(1);
#pragma unroll 1
    for (int l = 0; l < NLAYER; ++l) {
        const int b = 2 + 10 * l;
        Params Q = P0; { int z = 0; asm volatile("" : "+s"(z)); Q.ws = P0.ws + z; }
        if (IN(b + 0)) phase_gemm_in(Q, l, lds);
        SEAM(b + 0);
        if (IN(b + 1)) phase_p3(Q, l, lds);
        SEAM(b + 1);
        if (IN(b + 2)) phase_p3b(Q, l, lds);
        SEAM(b + 2);
        if (IN(b + 3)) phase_p4(Q, l, lds);
        SEAM(b + 3);
        if (IN(b + 4)) phase_gemm_merge(Q, l, lds);
        SEAM(b + 4);
        if (IN(b + 5)) phase_gemm_out(Q, l, lds);
        SEAM(b + 5);
        if (IN(b + 6)) phase_router(Q, l, lds);
        SEAM(b + 6);
        if (IN(b + 7)) phase_moe_gu(Q, l, lds);
        SEAM(b + 7);
        if (IN(b + 8)) phase_moe_down(Q, l, lds);
        SEAM(b + 8);
        if (IN(b + 9)) phase_rows_norm1(Q, l, l + 1);
        SEAM(b + 9);
    }
#undef IN
#undef SEAM
}


extern "C" void kernel_launch(void* const* d_in, const int* in_sizes, int n_in, void* d_out, int out_size, void* d_ws, size_t ws_size, hipStream_t stream) {
    static int grid = 0;
    if (grid == 0) {
        if (n_in != 36 || ws_size < WS_END) { fprintf(stderr, "kernel_launch: unexpected n_in %d or ws_size %zu (< %zu)\n", n_in, ws_size, (size_t)WS_END); grid = -1; return; }
        int dev = 0, cus = 0;
        if (hipGetDevice(&dev) != hipSuccess || hipDeviceGetAttribute(&cus, hipDeviceAttributeMultiprocessorCount, dev) != hipSuccess) { grid = -1; return; }
        if (hipFuncSetAttribute((const void*)mega_fwd<MK_PER_PHASE == 0>, hipFuncAttributeMaxDynamicSharedMemorySize, LDS_BYTES) != hipSuccess) { fprintf(stderr, "kernel_launch: hipFuncSetAttribute failed\n"); grid = -1; return; }
        int per_cu = 0;
        if (hipOccupancyMaxActiveBlocksPerMultiprocessor(&per_cu, (const void*)mega_fwd<MK_PER_PHASE == 0>, NTHR, LDS_BYTES) != hipSuccess || per_cu < 1) { fprintf(stderr, "kernel_launch: occupancy query says %d\n", per_cu); }
        (void)hipGetLastError();
        if (cus < GRID) { fprintf(stderr, "kernel_launch: built for a %d-CU device, found %d CUs; nothing launched\n", GRID, cus); grid = -1; return; }
        grid = GRID;
    }
    if (grid < 0) return;
    (void)hipMemsetAsync((char*)d_ws + WS_BAR, 0, WS_MOD - WS_BAR, stream);
    Params p{};
    for (int i = 0; i < 36; ++i) p.in[i] = (const float*)d_in[i];
    p.out = (float*)d_out; p.ws = (unsigned char*)d_ws;
#if MK_PER_PHASE
    for (int k = 0; k < N_PHASES; ++k) { p.ph_lo = k; p.ph_hi = k + 1; hipLaunchKernelGGL(mega_fwd<MK_PER_PHASE == 0>, dim3(grid), dim3(NTHR), LDS_BYTES, stream, p); }
#else
    p.ph_lo = 0; p.ph_hi = N_PHASES;
    hipLaunchKernelGGL(mega_fwd<MK_PER_PHASE == 0>, dim3(grid), dim3(NTHR), LDS_BYTES, stream, p);
#endif
}
```

```cpp
#include <hip/hip_runtime.h>
#include <stdint.h>
#include <stdio.h>

#define DI __device__ __forceinline__
#define LAS __attribute__((address_space(3)))
typedef unsigned short bf16_t;
typedef short bf16x8 __attribute__((ext_vector_type(8)));
typedef float f32x16 __attribute__((ext_vector_type(16)));
typedef float f32x4 __attribute__((ext_vector_type(4)));
typedef float f32x2 __attribute__((ext_vector_type(2)));
typedef unsigned u32x4 __attribute__((ext_vector_type(4)));
typedef unsigned u32x2 __attribute__((ext_vector_type(2)));
typedef __bf16 bf16x2v __attribute__((ext_vector_type(2)));
typedef int i32x4 __attribute__((ext_vector_type(4)));

DI unsigned pk2(float a, float b) { f32x2 v = {a, b}; return __builtin_bit_cast(unsigned, __builtin_convertvector(v, bf16x2v)); }
typedef int i32x8 __attribute__((ext_vector_type(8)));
DI unsigned pk_fp8x4(float a, float b, float c, float d) { int v = __builtin_amdgcn_cvt_pk_fp8_f32(a, b, 0, false); v = __builtin_amdgcn_cvt_pk_fp8_f32(c, d, v, true); return (unsigned)v; }
DI unsigned pk_bf8x4(float a, float b, float c, float d) { int v = __builtin_amdgcn_cvt_pk_bf8_f32(a, b, 0, false); v = __builtin_amdgcn_cvt_pk_bf8_f32(c, d, v, true); return (unsigned)v; }
typedef short s16x2 __attribute__((ext_vector_type(2)));
DI unsigned pk_bf8x4s(float a, float b, float c, float d, float sc) {
    s16x2 r; asm volatile("" : "=v"(r));
    r = __builtin_amdgcn_cvt_scalef32_pk_bf8_f32(r, a, b, sc, false); r = __builtin_amdgcn_cvt_scalef32_pk_bf8_f32(r, c, d, sc, true); return __builtin_bit_cast(unsigned, r); }
DI void st_fp8x16(unsigned char* p, const float* v) {
    u32x4 w; w.x = pk_fp8x4(v[0], v[1], v[2], v[3]); w.y = pk_fp8x4(v[4], v[5], v[6], v[7]); w.z = pk_fp8x4(v[8], v[9], v[10], v[11]); w.w = pk_fp8x4(v[12], v[13], v[14], v[15]);
    *(u32x4*)p = w;
}
DI bf16_t f2bf(float a) { return (bf16_t)(pk2(a, 0.f) & 0xffffu); }
DI float bf2f(bf16_t v) { return __uint_as_float(((unsigned)v) << 16); }
DI float bflo(unsigned w) { return __uint_as_float(w << 16); }
DI float bfhi(unsigned w) { return __uint_as_float(w & 0xffff0000u); }
template <int CTRL, int RM> DI float dpp_add(float v) { const int y = __builtin_amdgcn_update_dpp(0, __float_as_int(v), CTRL, RM, 0xF, false); return v + __int_as_float(y); }
DI float quad_sum(float v) { v = dpp_add<0xB1, 0xF>(v); v = dpp_add<0x4E, 0xF>(v); return v; }
DI float oct_sum(float v) { v = quad_sum(v); v = dpp_add<0x141, 0xF>(v); return v; }
DI float wave_sum(float v) { v = oct_sum(v); v = dpp_add<0x140, 0xF>(v); v = dpp_add<0x142, 0xA>(v); v = dpp_add<0x143, 0xC>(v);
    return __int_as_float(__builtin_amdgcn_readlane(__float_as_int(v), 63)); }
template <int CTRL, int RM> DI float dpp_max(float v) { const int y = __builtin_amdgcn_update_dpp(__float_as_int(v), __float_as_int(v), CTRL, RM, 0xF, false); return fmaxf(v, __int_as_float(y)); }
DI float wave_max(float v) { v = dpp_max<0xB1, 0xF>(v); v = dpp_max<0x4E, 0xF>(v); v = dpp_max<0x141, 0xF>(v); v = dpp_max<0x140, 0xF>(v); v = dpp_max<0x142, 0xA>(v); v = dpp_max<0x143, 0xC>(v);
    return __int_as_float(__builtin_amdgcn_readlane(__float_as_int(v), 63)); }
DI unsigned pack_i8x4(float a, float b, float c, float d) {
    const int ia = (int)fminf(fmaxf(rintf(a), -127.f), 127.f), ib = (int)fminf(fmaxf(rintf(b), -127.f), 127.f), ic = (int)fminf(fmaxf(rintf(c), -127.f), 127.f), id = (int)fminf(fmaxf(rintf(d), -127.f), 127.f);
    return (unsigned)(ia & 0xff) | ((unsigned)(ib & 0xff) << 8) | ((unsigned)(ic & 0xff) << 16) | ((unsigned)(id & 0xff) << 24); }
DI float lane_xor1(float v) { return __int_as_float(__builtin_amdgcn_update_dpp(0, __float_as_int(v), 0xB1, 0xF, 0xF, false)); }
DI int opaque_tid() { int t = threadIdx.x; asm volatile("" : "+v"(t)); return t; }
DI int opaque_bid() { int b = blockIdx.x; asm volatile("" : "+s"(b)); return b; }
DI float fexp2(float x) { return __builtin_amdgcn_exp2f(x); }
DI float fexp(float x) { return __builtin_amdgcn_exp2f(x * 1.4426950408889634f); }
DI float frcp(float x) { return __builtin_amdgcn_rcpf(x); }
DI float sigmoidf_(float x) { return __builtin_amdgcn_rcpf(1.0f + __builtin_amdgcn_exp2f(-1.4426950408889634f * x)); }
DI float siluf_(float x) { return x * sigmoidf_(x); }

#define XB_TMO      128
#define XB_XCNT(j)  (256  + 64 * (j))
#define XB_XSUB(j)  (1280 + 64 * (j))
#define XB_XGEN(j)  (2304 + 64 * (j))
#define XB_TOP      3328
#define XB_TOPGEN   3392
#define XCD_BAR_WORDS 3456
#define XB_SPIN_CAP (1u << 18)
__device__ __forceinline__ unsigned xb_ld(unsigned* p)              { return __hip_atomic_load(p, __ATOMIC_RELAXED, __HIP_MEMORY_SCOPE_AGENT); }
__device__ __forceinline__ unsigned xb_add(unsigned* p, unsigned v) { return __hip_atomic_fetch_add(p, v, __ATOMIC_RELAXED, __HIP_MEMORY_SCOPE_AGENT); }
__device__ __forceinline__ unsigned xb_xcc_id() { return (unsigned)__builtin_amdgcn_s_getreg((3 << 11) | 20) & 0xFu; }
#define XB_SPIN(cond, bar) do { unsigned _sp = 0; while (cond) { __builtin_amdgcn_s_sleep(1); \
    if ((++_sp & 255u) == 0u) { if (xb_ld(&(bar)[XB_TMO])) break; if (_sp > XB_SPIN_CAP) { atomicAdd(&(bar)[XB_TMO], 1u); break; } } } } while (0)
struct XcdBarrier { unsigned* bar; unsigned x; volatile LAS unsigned* st; };
__device__ __forceinline__ XcdBarrier xcd_barrier_post(unsigned* bar, volatile LAS unsigned* st) {
    XcdBarrier b; b.bar = bar; b.x = xb_xcc_id(); b.st = st;
    if (threadIdx.x == 0) (void)xb_add(&bar[XB_XCNT(b.x)], 1u);
    return b;
}
__device__ __forceinline__ void xcd_barrier_complete(unsigned* bar, unsigned x, unsigned& nloc, unsigned& nx) {
    const unsigned G = gridDim.x * gridDim.y * gridDim.z;
    unsigned sum, cnt, mine, sp = 0u;
    for (;;) {
        sum = 0u; cnt = 0u; mine = 0u;
#pragma unroll
        for (unsigned j = 0; j < 16; ++j) { const unsigned c = xb_ld(&bar[XB_XCNT(j)]); sum += c; cnt += (c > 0u) ? 1u : 0u; mine = (j == x) ? c : mine; }
        if (sum == G) break;
        __builtin_amdgcn_s_sleep(1);
        if ((++sp & 255u) == 0u) { if (xb_ld(&bar[XB_TMO])) break; if (sp > XB_SPIN_CAP) { atomicAdd(&bar[XB_TMO], 1u); break; } }
    }
    nloc = mine > 0u ? mine : 1u; nx = cnt > 0u ? cnt : 1u;
}
__device__ __forceinline__ void xcd_barrier(const XcdBarrier& b) {
    asm volatile("s_waitcnt vmcnt(0)" ::: "memory");
    __syncthreads();
    if (threadIdx.x == 0) {
        unsigned* bar = b.bar;
        __builtin_amdgcn_s_waitcnt(0);
        unsigned nloc = b.st[0], nx = b.st[1];
        if (nloc == 0u) { xcd_barrier_complete(bar, b.x, nloc, nx); b.st[0] = nloc; b.st[1] = nx; }
        const unsigned old = xb_add(&bar[XB_XSUB(b.x)], 1u);
        const unsigned gen = old / nloc;
        if (old + 1u == (gen + 1u) * nloc) {
            __builtin_amdgcn_fence(__ATOMIC_RELEASE, "agent");
            asm volatile("s_waitcnt vmcnt(0)" ::: "memory");
            const unsigned og = xb_add(&bar[XB_TOP], 1u);
            const unsigned tg = og / nx;
            if (og + 1u == (tg + 1u) * nx) xb_add(&bar[XB_TOPGEN], 1u);
            else XB_SPIN(xb_ld(&bar[XB_TOPGEN]) == tg, bar);
            __builtin_amdgcn_fence(__ATOMIC_ACQUIRE, "agent");
            xb_add(&bar[XB_XGEN(b.x)], 1u);
            asm volatile("s_waitcnt vmcnt(0)" ::: "memory");
        } else {
            XB_SPIN(xb_ld(&bar[XB_XGEN(b.x)]) == gen, bar);
            __builtin_amdgcn_fence(__ATOMIC_ACQUIRE, "agent");
            asm volatile("s_waitcnt vmcnt(0)" ::: "memory");
        }
    }
    __syncthreads();
}

constexpr int DM = 1024, SEQ = 16384, CTXN = 256, T = SEQ + CTXN, NLAYER = 4;
constexpr int NIN = 6912;
constexpr int U_CQ = 0, U_CKV = 256, U_KR = 384, U_DQ = 512, U_DK = 1024, U_DV = 1536, U_Z = 2048, U_XS = 2560, U_B = 3072, U_C = 3328, U_DT = 3584, U_G = 3840;
constexpr int NT64 = T / 64, NCHUNK = T / 128, NQB = T / 256;
constexpr int NEXP = 32, DFF = 1024;
constexpr int MOE_ROWS = 74752;
constexpr float EPS = 1e-6f;
constexpr float LOG2E = 1.4426950408889634f;
constexpr int NTHR = 512;
constexpr int GRID = 256;
constexpr int LDS_BYTES = 160 * 1024 - 256;

constexpr size_t al256(size_t x) { return (x + 255) & ~(size_t)255; }
constexpr size_t WS_BAR   = 0;
constexpr size_t WS_CTL   = al256(WS_BAR + XCD_BAR_WORDS * 4);
constexpr int ECS = 64;
constexpr size_t WS_MOD   = al256(WS_CTL + (size_t)NLAYER * 32 * ECS * 4);
constexpr size_t WS_TAB   = al256(WS_MOD + (size_t)NLAYER * 2 * 6144 * 4);
constexpr size_t TAB_FLOATS = (256 + 64) * 8 * 2 + (256 + 64) * 16 * 2;
constexpr size_t WS_WRT   = al256(WS_TAB + TAB_FLOATS * 4);
constexpr size_t WS_WIN   = al256(WS_WRT + (size_t)NLAYER * 32 * 1024 * 4);
constexpr size_t SZ_WIN   = (size_t)NIN * 1024;
constexpr size_t WS_WUQ   = al256(WS_WIN + NLAYER * SZ_WIN);
constexpr size_t SZ_WUQ   = (size_t)768 * 256 * 2;
constexpr size_t WS_WUKV  = al256(WS_WUQ + NLAYER * SZ_WUQ);
constexpr size_t SZ_WUKV  = (size_t)1024 * 256 * 2;
constexpr size_t WS_WUP   = al256(WS_WUKV + NLAYER * SZ_WUKV);
constexpr size_t SZ_WUP   = (size_t)3 * 1024 * 512 * 2;
constexpr size_t WS_WOUT  = al256(WS_WUP + NLAYER * SZ_WUP);
constexpr size_t SZ_WOUT  = (size_t)1024 * 1024 * 2;
constexpr size_t WS_WGU   = al256(WS_WOUT + NLAYER * SZ_WOUT);
constexpr size_t SZ_WGU   = (size_t)32 * 2048 * 1024;
constexpr size_t WS_WDN   = al256(WS_WGU + NLAYER * SZ_WGU);
constexpr size_t SZ_WDN   = (size_t)32 * 1024 * 1024 * 2;
constexpr size_t WS_XCUR  = al256(WS_WDN + NLAYER * SZ_WDN);
constexpr size_t WS_H     = al256(WS_XCUR + (size_t)T * 1024 * 4);
constexpr size_t WS_U     = al256(WS_H + (size_t)T * 1024 * 2);
constexpr size_t WS_DTR   = al256(WS_U + (size_t)T * NIN * 2);
constexpr size_t WS_QRAW  = al256(WS_DTR + (size_t)T * 16 * 4);
constexpr size_t WS_KVRAW = al256(WS_QRAW + (size_t)T * 768 * 2);
constexpr size_t WS_QM    = al256(WS_KVRAW + (size_t)T * 1024 * 2);
constexpr size_t WS_KM    = al256(WS_QM + (size_t)8 * T * 96 * 2);
constexpr size_t WS_VMT   = al256(WS_KM + (size_t)8 * T * 96 * 2);
constexpr size_t WS_QD    = al256(WS_VMT + (size_t)8 * T * 64 * 2);
constexpr size_t WS_KD    = al256(WS_QD + (size_t)8 * T * 64 * 2);
constexpr size_t WS_VDT   = al256(WS_KD + (size_t)8 * T * 64 * 2);
constexpr size_t WS_XSN   = al256(WS_VDT + (size_t)4 * T * 128 * 2);
constexpr size_t WS_XST   = al256(WS_XSN + (size_t)T * 512 * 2);
constexpr size_t WS_BCN   = al256(WS_XST + (size_t)T * 512 * 2);
constexpr size_t WS_DTS   = al256(WS_BCN + (size_t)T * 512 * 2);
constexpr size_t WS_CUM   = al256(WS_DTS + (size_t)T * 16 * 4);
constexpr size_t WS_ST    = al256(WS_CUM + (size_t)T * 16 * 4);
constexpr size_t WS_DEC   = al256(WS_ST + (size_t)NCHUNK * 16 * 8192 * 2);
constexpr size_t WS_HIN   = al256(WS_DEC + (size_t)NCHUNK * 16 * 4);
constexpr size_t WS_YA    = al256(WS_HIN + (size_t)NCHUNK * 16 * 8192 * 2);
constexpr size_t WS_YB    = al256(WS_YA + (size_t)T * 512 * 2);
constexpr size_t WS_YC    = al256(WS_YB + (size_t)T * 512 * 2);
constexpr size_t WS_O1    = al256(WS_YC + (size_t)T * 512 * 2);
constexpr size_t WS_MRG   = al256(WS_O1 + (size_t)320 * 256 * 128 * 4);
constexpr size_t WS_TOPE  = al256(WS_MRG + (size_t)T * 1024 * 2);
constexpr size_t WS_TOPP  = al256(WS_TOPE + (size_t)T * 16);
constexpr size_t WS_TOPG  = al256(WS_TOPP + (size_t)T * 16);
constexpr size_t WS_ELIST = al256(WS_TOPG + (size_t)T * 16);
constexpr size_t WS_ACT   = al256(WS_ELIST + (size_t)32 * T * 4);
constexpr size_t WS_YMOE  = al256(WS_ACT + (size_t)MOE_ROWS * 1024 * 2);
constexpr size_t WS_XG    = al256(WS_YMOE + (size_t)MOE_ROWS * 1024 * 2);
constexpr size_t WS_XGS   = al256(WS_XG + (size_t)32 * T * 1024);
constexpr size_t WS_WGS   = al256(WS_XGS + (size_t)32 * T * 4);
constexpr size_t WS_WINS  = al256(WS_WGS + (size_t)NLAYER * 32 * 2048 * 4);
constexpr size_t WS_HS    = al256(WS_WINS + (size_t)NLAYER * NIN * 4);
constexpr size_t WS_END   = al256(WS_HS + (size_t)T * 4);

struct Params {
    const float* in[36];
    float* out;
    unsigned char* ws;
    int ph_lo, ph_hi;
};

DI int perm32(int r) { return 16 * ((r >> 2) & 1) + 4 * (r >> 3) + (r & 3); }
DI int swz128(int row, int chunk) { return row * 128 + ((chunk ^ ((row >> 1) & 7)) << 4); }

#define MFMA32(a, b, c) __builtin_amdgcn_mfma_f32_32x32x16_bf16((a), (b), (c), 0, 0, 0)

template <int NI> struct GemmAcc { f32x16 a[4][NI]; };

template <int NI, class ARow, int MI = 4>
DI void gemm_tile(char* lds, const ARow& arow, const bf16_t* __restrict__ Bt, int ldb, int K, GemmAcc<NI>& acc) {
    const int tid = opaque_tid(), lane = tid & 63, wid = tid >> 6, wr = wid >> 2, wc = wid & 3, r = lane & 31, h = lane >> 5;
    const int lrow = tid >> 3, lc = tid & 7;
    constexpr int NB = 2 * NI;
    constexpr int STG = 32768 + 16384 * NI;
    const bf16_t* ap[MI];
#pragma unroll
    for (int i = 0; i < MI; ++i) ap[i] = arow(lrow + 64 * i) + lc * 8;
    const bf16_t* bp = Bt + (size_t)lrow * ldb + lc * 8;
    const int woff = swz128(lrow, lc);
#pragma unroll
    for (int mi = 0; mi < MI; ++mi)
#pragma unroll
        for (int ni = 0; ni < NI; ++ni)
#pragma unroll
            for (int i = 0; i < 16; ++i) acc.a[mi][ni][i] = 0.f;
    u32x4 ra0[MI], rb0[NB], ra1[MI], rb1[NB];
#define GT_LOAD(RA, RB, ko) do { _Pragma("unroll") for (int i = 0; i < MI; ++i) RA[i] = *(const u32x4*)(ap[i] + (ko)); \
        _Pragma("unroll") for (int i = 0; i < NB; ++i) RB[i] = *(const u32x4*)(bp + (size_t)i * 64 * ldb + (ko)); } while (0)
#define GT_STORE(RA, RB, so) do { _Pragma("unroll") for (int i = 0; i < MI; ++i) *(u32x4*)(lds + (so) + woff + i * 8192) = RA[i]; \
        _Pragma("unroll") for (int i = 0; i < NB; ++i) *(u32x4*)(lds + (so) + 32768 + woff + i * 8192) = RB[i]; } while (0)
    const int nk = K >> 6;
    const int xsw = (r >> 1) & 7;
    const int pr = perm32(r), wsw = (pr >> 1) & 7;
    const int xbase = (wr * 32 * MI + r) * 128, wbase = 32768 + (wc * 32 * NI + pr) * 128;
#define GT_COMPUTE(st) do { _Pragma("unroll") for (int ks = 0; ks < 4; ++ks) { bf16x8 wf[NI], xf[MI]; \
        _Pragma("unroll") for (int ni = 0; ni < NI; ++ni) wf[ni] = *(const bf16x8*)(lds + (st) + wbase + ni * 4096 + (((2 * ks + h) ^ wsw) << 4)); \
        _Pragma("unroll") for (int mi = 0; mi < MI; ++mi) xf[mi] = *(const bf16x8*)(lds + (st) + xbase + mi * 4096 + (((2 * ks + h) ^ xsw) << 4)); \
        _Pragma("unroll") for (int mi = 0; mi < MI; ++mi) _Pragma("unroll") for (int ni = 0; ni < NI; ++ni) acc.a[mi][ni] = MFMA32(wf[ni], xf[mi], acc.a[mi][ni]); } } while (0)
    GT_LOAD(ra0, rb0, 0);
    GT_STORE(ra0, rb0, 0);
    GT_LOAD(ra1, rb1, 64);
    __syncthreads();
    for (int kt = 0; kt < nk; kt += 2) {
        if (kt + 2 < nk) GT_LOAD(ra0, rb0, (kt + 2) * 64);
        GT_COMPUTE(0);
        GT_STORE(ra1, rb1, STG);
        __syncthreads();
        if (kt + 3 < nk) GT_LOAD(ra1, rb1, (kt + 3) * 64);
        GT_COMPUTE(STG);
        if (kt + 2 < nk) GT_STORE(ra0, rb0, 0);
        __syncthreads();
    }
#undef GT_LOAD
#undef GT_STORE
#undef GT_COMPUTE
}

struct ARowPlain { const bf16_t* base; size_t ld; DI const bf16_t* operator()(int row) const { return base + (size_t)row * ld; } };
struct ARowGather { const bf16_t* base; const int* idx; DI const bf16_t* operator()(int row) const { return base + (size_t)idx[row] * 1024; } };

DI void st_bf16x16(bf16_t* p, const float* v) {
    u32x4 a, b;
    a.x = pk2(v[0], v[1]); a.y = pk2(v[2], v[3]); a.z = pk2(v[4], v[5]); a.w = pk2(v[6], v[7]);
    b.x = pk2(v[8], v[9]); b.y = pk2(v[10], v[11]); b.z = pk2(v[12], v[13]); b.w = pk2(v[14], v[15]);
    *(u32x4*)p = a; *(u32x4*)(p + 8) = b;
}

namespace g8 {
constexpr int BK = 64, HALF = 128, HTB = HALF * BK * 2, STAGE_BYTES = 8 * HTB;
DI int lds_byte(int r, int c) { const int st = (r >> 4) * 2 + (c >> 5), rr = r & 15, cc = c & 31, ob = rr * 64 + cc * 2; return st * 1024 + (ob ^ (((ob >> 9) & 1) << 5)); }
DI void stage_rc(int b, int& R, int& C) { const int st = b / 1024, sb = b % 1024, swz = sb ^ (((sb >> 9) & 1) << 5); R = (st >> 1) * 16 + swz / 64; C = (st & 1) * 32 + (swz % 64) / 2; }
DI int perm32g(int rho) { const int n = rho >> 4, i = rho & 15; return 8 * (i >> 2) + 4 * n + (i & 3); }
struct Unit { const char* a; const char* b; int t0, t1; };
typedef f32x4 Acc[2][2][4][2];
typedef i32x4 AccI[2][2][4][2];
template <bool I8> struct AccSel { typedef f32x4 T; };
template <> struct AccSel<true> { typedef i32x4 T; };

template <bool PERM, bool I8 = false, class Sched, class Epi>
DI void gemm_phase(LAS unsigned char* lds, const int K, const int lda, const Sched& S, const Epi& E) {
    typedef typename AccSel<I8>::T AT_;
    const int tid = opaque_tid(), wid = __builtin_amdgcn_readfirstlane(tid >> 6), lane = tid & 63, wr = wid >> 2, wc = wid & 3, fr = lane & 15, fq = lane >> 4;
    const int nt = K / BK;
    unsigned voffA[2], voffB[2];
#pragma unroll
    for (int i = 0; i < 2; ++i) { int R, C; stage_rc(tid * 16 + i * 8192, R, C); const int Rb = PERM ? ((R & ~31) + perm32g(R & 31)) : R;
        voffA[i] = (unsigned)(R * lda + C) * 2u; voffB[i] = (unsigned)(Rb * K + C) * 2u; }
    const size_t kstep = (size_t)(BK * 2);
    const size_t hstepA = (size_t)HALF * lda * 2, hstepB = (size_t)HALF * K * 2;
    const unsigned ldsw = (unsigned)wid * 1024u;
    const int aoff = lds_byte(wr * 64 + fr, fq * 8), boff = lds_byte(wc * 32 + fr, fq * 8);
#define G8_SA(b, h) (((b) * 2 + (h)) * HTB)
#define G8_SB(b, h) ((4 + (b) * 2 + (h)) * HTB)
#define G8_STAGE(bufoff, gbase, voff) do { _Pragma("unroll") for (int _i = 0; _i < 2; ++_i) \
        __builtin_amdgcn_global_load_lds((const unsigned*)((const char*)(gbase) + (voff)[_i]), (LAS unsigned*)(lds + (bufoff) + ldsw + _i * 8192), 16, 0, 0); } while (0)
#define G8_LDA(dst, b, h) do { _Pragma("unroll") for (int m = 0; m < 4; ++m) _Pragma("unroll") for (int k = 0; k < 2; ++k) dst[m][k] = *(const LAS bf16x8*)(lds + G8_SA(b, h) + aoff + m * 2048 + k * 1024); } while (0)
#define G8_LDB(dst, b, h) do { _Pragma("unroll") for (int n = 0; n < 2; ++n) _Pragma("unroll") for (int k = 0; k < 2; ++k) dst[n][k] = *(const LAS bf16x8*)(lds + G8_SB(b, h) + boff + n * 2048 + k * 1024); } while (0)
#define G8_MMA(ai, bj, At, Bt) do { __builtin_amdgcn_s_setprio(1); _Pragma("unroll") for (int m = 0; m < 4; ++m) _Pragma("unroll") for (int n = 0; n < 2; ++n) _Pragma("unroll") for (int k = 0; k < 2; ++k) \
        { if constexpr (I8) acc[ai][bj][m][n] = __builtin_amdgcn_mfma_i32_16x16x64_i8(__builtin_bit_cast(i32x4, Bt[n][k]), __builtin_bit_cast(i32x4, At[m][k]), acc[ai][bj][m][n], 0, 0, 0); \
          else acc[ai][bj][m][n] = __builtin_amdgcn_mfma_f32_16x16x32_bf16(Bt[n][k], At[m][k], acc[ai][bj][m][n], 0, 0, 0); } __builtin_amdgcn_s_setprio(0); } while (0)
#define G8_WAIT_V(n) asm volatile("s_waitcnt vmcnt(" #n ")" ::: "memory")
#define G8_WAIT_L(n) asm volatile("s_waitcnt lgkmcnt(" #n ")" ::: "memory")
#define G8_BAR __builtin_amdgcn_s_barrier()
#define G8_SCHED __builtin_amdgcn_sched_barrier(0)
    Unit cur, nxt; int ui = 0;
    if (!S.next(0, cur)) return;
    AT_ acc[2][2][4][2];
#pragma unroll
    for (int a = 0; a < 2; ++a)
#pragma unroll
        for (int b = 0; b < 2; ++b)
#pragma unroll
            for (int m = 0; m < 4; ++m)
#pragma unroll
                for (int n = 0; n < 2; ++n) acc[a][b][m][n] = AT_{};
    bf16x8 At[4][2], B0[2][2], B1[2][2];
    const char* cA = cur.a; const char* cB = cur.b;
    G8_STAGE(G8_SB(0, 0), cB, voffB); G8_STAGE(G8_SA(0, 0), cA, voffA); G8_STAGE(G8_SB(0, 1), cB + hstepB, voffB); G8_STAGE(G8_SA(0, 1), cA + hstepA, voffA);
    if (wr == 1) G8_BAR;
    G8_WAIT_V(4); G8_BAR;
    G8_STAGE(G8_SB(1, 0), cB + kstep, voffB); G8_STAGE(G8_SA(1, 0), cA + kstep, voffA); G8_STAGE(G8_SB(1, 1), cB + hstepB + kstep, voffB);
    G8_WAIT_V(6); G8_BAR;
    for (;;) {
        const bool has_next = S.next(ui + 1, nxt);
        const char* nA = has_next ? nxt.a : cA; const char* nB = has_next ? nxt.b : cB;
        for (int t = 0; t < nt; t += 2) {
            const bool last = (t == nt - 2);
            const char* a1 = cA + (size_t)(t + 1) * kstep;
            const char* a2 = last ? nA : cA + (size_t)(t + 2) * kstep; const char* b2 = last ? nB : cB + (size_t)(t + 2) * kstep;
            const char* a3 = a2 + kstep; const char* b3 = b2 + kstep;
            G8_LDB(B0, 0, 0); G8_SCHED; G8_LDA(At, 0, 0); G8_STAGE(G8_SA(1, 1), a1 + hstepA, voffA);
            G8_WAIT_L(8); G8_BAR; G8_WAIT_L(0); G8_MMA(0, 0, At, B0); G8_BAR; G8_SCHED;
            G8_LDB(B1, 0, 1); G8_STAGE(G8_SB(0, 0), b2, voffB);
            G8_BAR; G8_WAIT_L(0); G8_MMA(0, 1, At, B1); G8_BAR;
            G8_LDA(At, 0, 1); G8_STAGE(G8_SA(0, 0), a2, voffA);
            G8_BAR; G8_WAIT_L(0); G8_MMA(1, 0, At, B0); G8_BAR; G8_SCHED;
            G8_STAGE(G8_SB(0, 1), b2 + hstepB, voffB);
            G8_WAIT_V(6); G8_BAR; G8_MMA(1, 1, At, B1); G8_BAR;
            G8_LDB(B0, 1, 0); G8_SCHED; G8_LDA(At, 1, 0); G8_STAGE(G8_SA(0, 1), a2 + hstepA, voffA);
            G8_WAIT_L(8); G8_BAR; G8_WAIT_L(0); G8_MMA(0, 0, At, B0); G8_BAR; G8_SCHED;
            G8_LDB(B1, 1, 1); G8_STAGE(G8_SB(1, 0), b3, voffB);
            G8_BAR; G8_WAIT_L(0); G8_MMA(0, 1, At, B1); G8_BAR;
            G8_LDA(At, 1, 1); G8_STAGE(G8_SA(1, 0), a3, voffA);
            G8_BAR; G8_WAIT_L(0); G8_MMA(1, 0, At, B0); G8_BAR; G8_SCHED;
            G8_STAGE(G8_SB(1, 1), b3 + hstepB, voffB);
            G8_WAIT_V(6); G8_BAR; G8_MMA(1, 1, At, B1); G8_BAR;
        }
        E(acc, cur, wr, wc, fr, fq);
        if (!has_next) break;
#pragma unroll
        for (int a = 0; a < 2; ++a)
#pragma unroll
            for (int b = 0; b < 2; ++b)
#pragma unroll
                for (int m = 0; m < 4; ++m)
#pragma unroll
                    for (int n = 0; n < 2; ++n) acc[a][b][m][n] = AT_{};
        cur = nxt; cA = nA; cB = nB; ++ui;
    }
    G8_WAIT_V(0);
    if (wr == 0) G8_BAR;
    G8_BAR;
#undef G8_SA
#undef G8_SB
#undef G8_STAGE
#undef G8_LDA
#undef G8_LDB
#undef G8_MMA
#undef G8_WAIT_V
#undef G8_WAIT_L
#undef G8_BAR
#undef G8_SCHED
}

template <int nM, int nN>
struct GridSched {
    const char* A; const char* Bt; size_t astep, bstep; int c; int gs;
    DI void init(const void* A_, size_t lda, const void* Bt_, int K) { A = (const char*)A_; Bt = (const char*)Bt_; astep = 256 * lda * 2; bstep = (size_t)256 * K * 2; c = blockIdx.x; asm volatile("" : "+s"(c)); gs = GRID; }
    DI bool next(int i, Unit& u) const {
        constexpr int nwg = nM * nN;
        const int L = i * gs + c; if (L >= nwg) return false;
        int wgid = L; { constexpr int q = nwg / 8, r = nwg % 8; const int xcd = wgid % 8, off = wgid / 8; wgid = (xcd < r ? xcd * (q + 1) : r * (q + 1) + (xcd - r) * q) + off; }
        constexpr int nig = 8 * nN; const int gid = wgid / nig, fm = gid * 8, gsz = (nM - fm) < 8 ? (nM - fm) : 8;
        const int rem = wgid % nig;
        static_assert((nM % 8) == 0 || (nM % 8) == 1 || (nM % 8) == 2 || (nM % 8) == 4, "partial row-tile group must be a power of two");
        const int sh = __builtin_ctz(gsz);
        const int pm = fm + (rem & (gsz - 1)), pn = rem >> sh;
        u.a = A + (size_t)pm * astep; u.b = Bt + (size_t)pn * bstep; u.t0 = pm; u.t1 = pn; return true;
    }
};
}

template <int DK, int DV>
DI void attn_core(char* lds, const bf16_t* __restrict__ Qrows  , const unsigned char* __restrict__ Kt, const unsigned char* __restrict__ Vt,
                  int kt0, int kt1, float shift, f32x16 (&o)[DV / 32], float& lsum_out) {
    constexpr int KCH = DK / 16;
    constexpr int KROWB = (DK == 96) ? 128 : 64;
    constexpr int KSTG = 64 * KROWB, VSTG = DV * 64;
    constexpr int VBASE = 8 * KSTG;
    constexpr int NKP = KSTG / 1024, NVP = VSTG / 1024;
    constexpr int KTILEB = 64 * DK, VTILEB = DV * 64;
    const int tid = opaque_tid(), lane = tid & 63, r = lane & 31, h = lane >> 5;
    const int wid = __builtin_amdgcn_readfirstlane(tid >> 6);
    i32x8 qf8[(DK + 63) / 64];
    {
        const bf16_t* qp = Qrows + (size_t)r * DK;
#pragma unroll
        for (int st = 0; st < (DK + 63) / 64; ++st) {
            const int e0 = (st == 0) ? 32 * h : 64;
            unsigned d[8];
#pragma unroll
            for (int j = 0; j < 4; ++j) { const u32x4 w = *(const u32x4*)(qp + e0 + 8 * j);
                d[2 * j] = pk_fp8x4(bflo(w.x) * 8.0f, bfhi(w.x) * 8.0f, bflo(w.y) * 8.0f, bfhi(w.y) * 8.0f);
                d[2 * j + 1] = pk_fp8x4(bflo(w.z) * 8.0f, bfhi(w.z) * 8.0f, bflo(w.w) * 8.0f, bfhi(w.w) * 8.0f); }
            if (st == 1 && h == 1) {
#pragma unroll
                for (int j = 0; j < 8; ++j) d[j] = 0u;
            }
            qf8[st] = (i32x8){(int)d[0], (int)d[1], (int)d[2], (int)d[3], (int)d[4], (int)d[5], (int)d[6], (int)d[7]};
        }
    }
#define MFMA8(a, b, c) __builtin_amdgcn_mfma_scale_f32_32x32x64_f8f6f4((a), (b), (c), 0, 0, 0, 0x7F7F7F7F, 0, 0x7C7C7C7C)
#pragma unroll
    for (int db = 0; db < DV / 32; ++db)
#pragma unroll
        for (int i = 0; i < 16; ++i) o[db][i] = 0.f;
    const f32x16 cvec = {0.f, 0.f, 0.f, 0.f, 0.f, 0.f, 0.f, 0.f, 0.f, 0.f, 0.f, 0.f, 0.f, 0.f, 0.f, 0.f};
    const int csh = __builtin_amdgcn_readfirstlane((int)ceilf(fmaxf(shift - 15.0f, 0.f)));
    const float psc = __int_as_float((127 + csh) << 23);
    const int pvs = 127 + csh;
    float lsum = 0.f;
    const char* kg = (const char*)Kt + (size_t)kt0 * KTILEB;
    const char* vg = (const char*)Vt + (size_t)kt0 * VTILEB;
    LAS unsigned char* l3 = (LAS unsigned char*)lds;
    const int n = kt1 - kt0;
#define AT_DMAK(slot) do { if (wid < NKP) { const int b_ = wid * 1024 + lane * 16; const int row_ = b_ / KROWB, cs_ = (b_ % KROWB) >> 4; \
        const int c_ = (DK == 96) ? (cs_ ^ ((row_ >> 1) & 7)) : (cs_ ^ ((row_ >> 2) & 3)); \
        if (c_ < KCH) __builtin_amdgcn_global_load_lds((const unsigned*)(kg + (row_ * DK + c_ * 16)), (LAS unsigned*)(l3 + (slot) * KSTG + wid * 1024), 16, 0, 0); } kg += KTILEB; } while (0)
#define AT_DMAV(slot) do { const int pv_ = wid - (8 - NVP); if (pv_ >= 0) { const int b_ = pv_ * 1024 + lane * 16; const int row_ = b_ >> 6, cs_ = (b_ & 63) >> 4; const int c_ = cs_ ^ ((row_ >> 2) & 3) ^ ((row_ >> 4) & 1); \
        __builtin_amdgcn_global_load_lds((const unsigned*)(vg + (row_ * 64 + c_ * 16)), (LAS unsigned*)(l3 + VBASE + (slot) * VSTG + pv_ * 1024), 16, 0, 0); } vg += VTILEB; } while (0)
    const int pr = perm32(r), vsw = ((pr >> 2) & 3) ^ ((pr >> 4) & 1);
    const int onev = (((lane & 15) == 0 && ((lane >> 4) & 1) == 0) || ((lane & 15) == 1 && ((lane >> 4) & 1) == 1)) ? 0x38383838 : 0;
    f32x4 ol = {0.f, 0.f, 0.f, 0.f};
#define MFMA8S(b, c) __builtin_amdgcn_mfma_scale_f32_16x16x128_f8f6f4(((i32x8){onev, onev, onev, onev, onev, onev, onev, onev}), (b), (c), 0, 1, 0, 0x7F7F7F7F, 0, pvs)
    const int ksw = (DK == 96) ? ((r >> 1) & 7) : ((r >> 2) & 3);
#define MFMA8V(a, b, c) __builtin_amdgcn_mfma_scale_f32_32x32x64_f8f6f4((a), (b), (c), 0, 1, 0, 0x7F7F7F7F, 0, pvs)
#define AT_LD32(dst, rowp, c0, sw) do { const u32x4 a0_ = *(const u32x4*)((rowp) + ((((c0)) ^ (sw)) << 4)), a1_ = *(const u32x4*)((rowp) + ((((c0) + 1) ^ (sw)) << 4)); \
        dst = (i32x8){(int)a0_.x, (int)a0_.y, (int)a0_.z, (int)a0_.w, (int)a1_.x, (int)a1_.y, (int)a1_.z, (int)a1_.w}; } while (0)
#define AT_KROW(slot, kb) (lds + (slot) * KSTG + ((kb) * 32 + r) * KROWB)
#define AT_VROW(slot, db) (lds + VBASE + (slot) * VSTG + ((db) * 32 + pr) * 64)
#define AT_EXP(S, kb, a, b) do { _Pragma("unroll") for (int i_ = (a); i_ < (b); ++i_) S[kb][i_] = fexp2(S[kb][i_]); } while (0)
#define AT_ADD(S, kb, a, b) do { _Pragma("unroll") for (int i_ = (a); i_ < (b); ++i_) lsum += S[kb][i_]; } while (0)
#define AT_CVT(S, kb, d) do { _Pragma("unroll") for (int q_ = 0; q_ < 4; ++q_) d[4 * (kb) + q_] = pk_bf8x4s(S[kb][4 * q_], S[kb][4 * q_ + 1], S[kb][4 * q_ + 2], S[kb][4 * q_ + 3], psc); } while (0)
#define AT_SB __builtin_amdgcn_sched_barrier(0)
#define AT_QK(S, slot) do { _Pragma("unroll") for (int kb = 0; kb < 2; ++kb) { i32x8 kf; AT_LD32(kf, AT_KROW(slot, kb), 2 * h, ksw); S[kb] = MFMA8(kf, qf8[0], cvec); \
        if (DK == 96) { AT_LD32(kf, AT_KROW(slot, kb), 4, ksw); S[kb] = MFMA8(kf, qf8[(DK + 63) / 64 - 1], S[kb]); } } } while (0)
    i32x8 kc0, kc1;
#define AT_STEP(S, SN, ks, vs, PRE, NXT) do { unsigned d_[8]; \
        if (DK == 96) { i32x8 k1_, k3_, v0_, v1_; \
            if (!(PRE)) { AT_LD32(kc0, AT_KROW(ks, 0), 2 * h, ksw); AT_LD32(kc1, AT_KROW(ks, 1), 2 * h, ksw); } AT_SB; \
            SN[0] = MFMA8(kc0, qf8[0], cvec); AT_LD32(k1_, AT_KROW(ks, 0), 4, ksw); AT_EXP(S, 0, 0, 8); AT_SB; \
            SN[1] = MFMA8(kc1, qf8[0], cvec); AT_LD32(k3_, AT_KROW(ks, 1), 4, ksw); AT_EXP(S, 0, 8, 16); AT_SB; \
            SN[0] = MFMA8(k1_, qf8[(DK + 63) / 64 - 1], SN[0]); AT_LD32(v0_, AT_VROW(vs, 0), 2 * h, vsw); AT_EXP(S, 1, 0, 8); AT_SB; \
            SN[1] = MFMA8(k3_, qf8[(DK + 63) / 64 - 1], SN[1]); AT_LD32(v1_, AT_VROW(vs, 1), 2 * h, vsw); AT_EXP(S, 1, 8, 16); AT_SB; \
            o[0] = MFMA8V(v0_, pf8, o[0]); if (NXT) AT_LD32(kc0, AT_KROW(((ks) + 1) & 7, 0), 2 * h, ksw); AT_CVT(S, 0, d_); AT_SB; \
            o[1] = MFMA8V(v1_, pf8, o[1]); if (NXT) AT_LD32(kc1, AT_KROW(((ks) + 1) & 7, 1), 2 * h, ksw); AT_CVT(S, 1, d_); AT_SB; \
            ol = MFMA8S(pf8, ol); AT_SB; \
        } else { i32x8 v0_, v1_, v2_, v3_; \
            AT_LD32(kc0, AT_KROW(ks, 0), 2 * h, ksw); AT_LD32(kc1, AT_KROW(ks, 1), 2 * h, ksw); AT_SB;        \
            SN[0] = MFMA8(kc0, qf8[0], cvec); AT_LD32(v0_, AT_VROW(vs, 0), 2 * h, vsw); AT_EXP(S, 0, 0, 8); AT_SB; \
            SN[1] = MFMA8(kc1, qf8[0], cvec); AT_LD32(v1_, AT_VROW(vs, 1), 2 * h, vsw); AT_EXP(S, 0, 8, 16); AT_SB; \
            o[0] = MFMA8V(v0_, pf8, o[0]); AT_LD32(v2_, AT_VROW(vs, DV / 32 - 2), 2 * h, vsw); AT_EXP(S, 1, 0, 8); AT_SB; \
            o[1] = MFMA8V(v1_, pf8, o[1]); AT_LD32(v3_, AT_VROW(vs, DV / 32 - 1), 2 * h, vsw); AT_EXP(S, 1, 8, 16); AT_SB; \
            o[DV / 32 - 2] = MFMA8V(v2_, pf8, o[DV / 32 - 2]); AT_CVT(S, 0, d_); AT_SB; \
            o[DV / 32 - 1] = MFMA8V(v3_, pf8, o[DV / 32 - 1]); AT_CVT(S, 1, d_); AT_SB; \
            ol = MFMA8S(pf8, ol); AT_SB; \
        } \
        pf8 = (i32x8){(int)d_[0], (int)d_[1], (int)d_[2], (int)d_[3], (int)d_[4], (int)d_[5], (int)d_[6], (int)d_[7]}; } while (0)
    AT_DMAK(0); AT_DMAK(1); AT_DMAK(2); AT_DMAK(3); if (n > 4) AT_DMAK(4);
    AT_DMAV(7); vg -= VTILEB; AT_DMAV(0); AT_DMAV(1); AT_DMAV(2);
    asm volatile("s_waitcnt vmcnt(0)" ::: "memory");
    __syncthreads();
    f32x16 sa[2], sb[2];
    i32x8 pf8 = {0, 0, 0, 0, 0, 0, 0, 0};
    AT_QK(sa, 0);
    __syncthreads();
    for (int p = 0; p < n; p += 8) {
        if (p + 5 < n) { AT_DMAK(5); AT_DMAK(6); AT_DMAK(7); AT_DMAK(0); }
        AT_DMAV(3); if (p + 4 < n) { AT_DMAV(4); AT_DMAV(5); AT_DMAV(6); }
        AT_STEP(sa, sb, 1, 7, 0, 1); AT_STEP(sb, sa, 2, 0, 1, 1); AT_STEP(sa, sb, 3, 1, 1, 1); AT_STEP(sb, sa, 4, 2, 1, 0);
        asm volatile("s_waitcnt vmcnt(0)" ::: "memory");
        __syncthreads();
        if (p + 4 >= n) break;
        if (p + 9 < n) { AT_DMAK(1); AT_DMAK(2); AT_DMAK(3); AT_DMAK(4); }
        AT_DMAV(7); if (p + 8 < n) { AT_DMAV(0); AT_DMAV(1); AT_DMAV(2); }
        AT_STEP(sa, sb, 5, 3, 0, 1); AT_STEP(sb, sa, 6, 4, 1, 1); AT_STEP(sa, sb, 7, 5, 1, 1); AT_STEP(sb, sa, 0, 6, 1, 0);
        asm volatile("s_waitcnt vmcnt(0)" ::: "memory");
        __syncthreads();
    }
#pragma unroll
    for (int db = 0; db < DV / 32; ++db) { i32x8 vf; AT_LD32(vf, AT_VROW((n - 1) & 7, db), 2 * h, vsw); o[db] = MFMA8V(vf, pf8, o[db]); }
    ol = MFMA8S(pf8, ol);
#undef AT_DMAK
#undef AT_DMAV
#undef AT_QK
#undef AT_STEP
#undef AT_LD32
#undef AT_KROW
#undef AT_VROW
#undef AT_EXP
#undef AT_ADD
#undef AT_CVT
#undef AT_SB
#undef MFMA8
#undef MFMA8V
#undef MFMA8S
    { const float s0 = __shfl(ol[0], lane & 15), s1 = __shfl(ol[1], lane & 15); lsum_out = ((lane & 16) ? s1 : s0) + lsum; }
}
DI int kperm8(int pos) { const int h = pos >> 5, j = pos & 31; return ((j >> 4) << 5) | (((j >> 2) & 3) << 3) | (h << 2) | (j & 3); }
DI int kperm(int k) { return (k & ~12) | ((k & 4) << 1) | ((k & 8) >> 1); }


DI int win_src_col(int n) {
    if (n < 416) return n;
    if (n < 512) return -1;
    if (n < 3600) return n - 96;
    if (n < 3840) return -1;
    return n - 336;
}
DI int wgu_src_col(int rr) {
    const int ct = rr >> 8, half = (rr >> 7) & 1, jj = rr & 127;
    return half * 1024 + ct * 128 + jj;
}
template <int MAP>
DI void xpose_unit(float* tl, const float* __restrict__ src, int ld_src, int k0, int n0, bf16_t* __restrict__ dst, int ld_dst, const float* __restrict__ kscale) {
    (void)tl;
    const int tid = opaque_tid(), lane = tid & 63, wid = tid >> 6;
    const int n4 = (wid & 3) * 32 + (lane & 7) * 4, k8 = (wid >> 2) * 64 + (lane >> 3) * 8;
    const int nn = n0 + n4;
    const int sc = (MAP == 0) ? nn : (MAP == 1 ? win_src_col(nn) : wgu_src_col(nn));
    f32x4 v[8];
#pragma unroll
    for (int j = 0; j < 8; ++j)
        v[j] = (sc >= 0) ? __builtin_nontemporal_load((const f32x4*)(src + (size_t)(k0 + k8 + j) * ld_src + sc)) : (f32x4){0.f, 0.f, 0.f, 0.f};
    if (kscale) {
        const f32x4 s0 = *(const f32x4*)(kscale + k0 + k8), s1 = *(const f32x4*)(kscale + k0 + k8 + 4);
        v[0] = v[0] * s0.x; v[1] = v[1] * s0.y; v[2] = v[2] * s0.z; v[3] = v[3] * s0.w; v[4] = v[4] * s1.x; v[5] = v[5] * s1.y; v[6] = v[6] * s1.z; v[7] = v[7] * s1.w;
    }
    bf16_t* d = dst + (size_t)(n0 + n4) * ld_dst + k0 + k8;
    { u32x4 w;
      w.x = pk2(v[0].x, v[1].x); w.y = pk2(v[2].x, v[3].x); w.z = pk2(v[4].x, v[5].x); w.w = pk2(v[6].x, v[7].x); *(u32x4*)d = w;
      w.x = pk2(v[0].y, v[1].y); w.y = pk2(v[2].y, v[3].y); w.z = pk2(v[4].y, v[5].y); w.w = pk2(v[6].y, v[7].y); *(u32x4*)(d + ld_dst) = w;
      w.x = pk2(v[0].z, v[1].z); w.y = pk2(v[2].z, v[3].z); w.z = pk2(v[4].z, v[5].z); w.w = pk2(v[6].z, v[7].z); *(u32x4*)(d + 2 * (size_t)ld_dst) = w;
      w.x = pk2(v[0].w, v[1].w); w.y = pk2(v[2].w, v[3].w); w.z = pk2(v[4].w, v[5].w); w.w = pk2(v[6].w, v[7].w); *(u32x4*)(d + 3 * (size_t)ld_dst) = w; }
}

template <int MAP, int LDS_>
DI void quant_rows_unit(char* ldsb, const float* __restrict__ src  , int nt, signed char* __restrict__ dst  , float* __restrict__ scales  ) {
    const int tid = threadIdx.x;
    const int nb = tid & 7, kb = tid >> 3;
    const int n0 = nt * 32, n4 = nb * 4;
    const int sc = (MAP == 1) ? win_src_col(n0 + n4) : wgu_src_col(n0 + n4);
    float* am = (float*)ldsb;
    f32x4 v[16];
#pragma unroll
    for (int j = 0; j < 16; ++j) v[j] = (sc >= 0) ? __builtin_nontemporal_load((const f32x4*)(src + (size_t)(kb * 16 + j) * LDS_ + sc)) : (f32x4){0.f, 0.f, 0.f, 0.f};
    f32x4 mx = {0.f, 0.f, 0.f, 0.f};
#pragma unroll
    for (int j = 0; j < 16; ++j) { mx.x = fmaxf(mx.x, fabsf(v[j].x)); mx.y = fmaxf(mx.y, fabsf(v[j].y)); mx.z = fmaxf(mx.z, fabsf(v[j].z)); mx.w = fmaxf(mx.w, fabsf(v[j].w)); }
    *(f32x4*)(am + kb * 32 + n4) = mx;
    __syncthreads();
    if (tid < 32) { float m = 0.f;
#pragma unroll
        for (int q = 0; q < 64; ++q) m = fmaxf(m, am[q * 32 + tid]);
        const float sc_ = (m > 0.f) ? m * (1.0f / 127.0f) : 1.0f;
        scales[n0 + tid] = sc_; am[2048 + tid] = 1.0f / sc_; }
    __syncthreads();
    const f32x4 inv = *(const f32x4*)(am + 2048 + n4);
    signed char* d = dst + (size_t)(n0 + n4) * 1024 + kb * 16;
    { u32x4 w;
      w.x = pack_i8x4(v[0].x * inv.x, v[1].x * inv.x, v[2].x * inv.x, v[3].x * inv.x); w.y = pack_i8x4(v[4].x * inv.x, v[5].x * inv.x, v[6].x * inv.x, v[7].x * inv.x);
      w.z = pack_i8x4(v[8].x * inv.x, v[9].x * inv.x, v[10].x * inv.x, v[11].x * inv.x); w.w = pack_i8x4(v[12].x * inv.x, v[13].x * inv.x, v[14].x * inv.x, v[15].x * inv.x);
      *(u32x4*)d = w;
      w.x = pack_i8x4(v[0].y * inv.y, v[1].y * inv.y, v[2].y * inv.y, v[3].y * inv.y); w.y = pack_i8x4(v[4].y * inv.y, v[5].y * inv.y, v[6].y * inv.y, v[7].y * inv.y);
      w.z = pack_i8x4(v[8].y * inv.y, v[9].y * inv.y, v[10].y * inv.y, v[11].y * inv.y); w.w = pack_i8x4(v[12].y * inv.y, v[13].y * inv.y, v[14].y * inv.y, v[15].y * inv.y);
      *(u32x4*)(d + 1024) = w;
      w.x = pack_i8x4(v[0].z * inv.z, v[1].z * inv.z, v[2].z * inv.z, v[3].z * inv.z); w.y = pack_i8x4(v[4].z * inv.z, v[5].z * inv.z, v[6].z * inv.z, v[7].z * inv.z);
      w.z = pack_i8x4(v[8].z * inv.z, v[9].z * inv.z, v[10].z * inv.z, v[11].z * inv.z); w.w = pack_i8x4(v[12].z * inv.z, v[13].z * inv.z, v[14].z * inv.z, v[15].z * inv.z);
      *(u32x4*)(d + 2048) = w;
      w.x = pack_i8x4(v[0].w * inv.w, v[1].w * inv.w, v[2].w * inv.w, v[3].w * inv.w); w.y = pack_i8x4(v[4].w * inv.w, v[5].w * inv.w, v[6].w * inv.w, v[7].w * inv.w);
      w.z = pack_i8x4(v[8].w * inv.w, v[9].w * inv.w, v[10].w * inv.w, v[11].w * inv.w); w.w = pack_i8x4(v[12].w * inv.w, v[13].w * inv.w, v[14].w * inv.w, v[15].w * inv.w);
      *(u32x4*)(d + 3072) = w; }
    __syncthreads();
}

constexpr int XP_WIN = NIN / 32  , XP_WUQ = 2 * 6, XP_WUKV = 2 * 8, XP_WUP = 3 * 4 * 8, XP_WOUT = 8 * 8, XP_WGU = 32 * 64  , XP_WDN = 32 * 8 * 8;
constexpr int XP_LAYER = XP_WIN + XP_WUQ + XP_WUKV + XP_WUP + XP_WOUT + XP_WGU + XP_WDN;
constexpr int N_MODU = NLAYER * 96;

constexpr int XP_WDN_MERGE = 3 * (GRID - 32);
constexpr int XP_WDN_DOWN0 = XP_WDN_MERGE + 512, XP_WDN_DOWN1 = XP_WDN_DOWN0 + 512;
constexpr int XP_WDN_ROWS0 = XP_WDN - 336;
constexpr int XP_WDN_OUTN = (XP_WDN_DOWN0 - XP_WDN_MERGE) + (XP_WDN_ROWS0 - XP_WDN_DOWN1);
DI void wdn_units(const Params& P, int l, int u0, int u1, int rk, int nb) {
    unsigned char* ws = P.ws;
    for (int rr = u0 + rk; rr < u1; rr += nb) { const int e = rr / 64, q = rr % 64, kt = q & 7, nt = q >> 3;
        xpose_unit<0>(nullptr, P.in[34] + ((size_t)l * 32 + e) * 1024 * 1024, 1024, kt * 128, nt * 128, (bf16_t*)(ws + WS_WDN + l * SZ_WDN) + (size_t)e * 1024 * 1024, 1024, nullptr); }
}
DI void phase_prologue(const Params& P, char* lds) {
    float* tl = (float*)lds;
    unsigned char* ws = P.ws;
    const int G = GRID, b = blockIdx.x, tid = threadIdx.x;
    for (int u = b; u < NLAYER * XP_LAYER; u += G) {
        const int l = NLAYER - 1 - u / XP_LAYER; int rr = u % XP_LAYER;
        if (rr < XP_WIN) { quant_rows_unit<1, 6576>(lds, P.in[8] + (size_t)l * 1024 * 6576, rr, (signed char*)(ws + WS_WIN + l * SZ_WIN), (float*)(ws + WS_WINS) + (size_t)l * NIN); continue; }
        rr -= XP_WIN;
        if (rr < XP_WUQ) { const int kt = rr & 1, nt = rr >> 1;
            xpose_unit<0>(tl, P.in[11] + (size_t)l * 256 * 768, 768, kt * 128, nt * 128, (bf16_t*)(ws + WS_WUQ + l * SZ_WUQ), 256, P.in[10] + l * 256); continue; }
        rr -= XP_WUQ;
        if (rr < XP_WUKV) { const int kt = rr & 1, nt = rr >> 1;
            if (kt == 0) xpose_unit<0>(tl, P.in[13] + (size_t)l * 128 * 1024, 1024, 0, nt * 128, (bf16_t*)(ws + WS_WUKV + l * SZ_WUKV), 256, P.in[12] + l * 128);
            else { bf16_t* d = (bf16_t*)(ws + WS_WUKV + l * SZ_WUKV) + (size_t)(nt * 128 + (tid >> 2)) * 256 + 128 + (tid & 3) * 32;
#pragma unroll
                for (int q = 0; q < 4; ++q) *(u32x4*)(d + 8 * q) = (u32x4){0u, 0u, 0u, 0u}; }
            continue; }
        rr -= XP_WUKV;
        if (rr < XP_WUP) { const int br = rr / 32, q = rr % 32, kt = q & 3, nt = q >> 2;
            xpose_unit<0>(tl, P.in[26 + br] + (size_t)l * 512 * 1024, 1024, kt * 128, nt * 128, (bf16_t*)(ws + WS_WUP + l * SZ_WUP) + (size_t)br * 1024 * 512, 512, nullptr); continue; }
        rr -= XP_WUP;
        if (rr < XP_WOUT) { const int kt = rr & 7, nt = rr >> 3;
            xpose_unit<0>(tl, P.in[29] + (size_t)l * 1024 * 1024, 1024, kt * 128, nt * 128, (bf16_t*)(ws + WS_WOUT + l * SZ_WOUT), 1024, nullptr); continue; }
        rr -= XP_WOUT;
        if (rr < XP_WGU) { const int e = rr >> 6, nt = rr & 63;
            quant_rows_unit<2, 2048>(lds, P.in[32] + ((size_t)l * 32 + e) * 1024 * 2048, nt, (signed char*)(ws + WS_WGU + l * SZ_WGU) + (size_t)e * 2048 * 1024, (float*)(ws + WS_WGS) + ((size_t)l * 32 + e) * 2048); continue; }
        rr -= XP_WGU;
        if (l == 0) { const int e = rr / 64, q = rr % 64, kt = q & 7, nt = q >> 3;
            xpose_unit<0>(tl, P.in[34] + ((size_t)l * 32 + e) * 1024 * 1024, 1024, kt * 128, nt * 128, (bf16_t*)(ws + WS_WDN + l * SZ_WDN) + (size_t)e * 1024 * 1024, 1024, nullptr); }
    }
    __syncthreads();
    {
        float* sv = (float*)lds;
        float* red = sv + 2048;
        for (int i = tid; i < 2048; i += NTHR) { const float x = (i < 1024) ? P.in[1][i] : P.in[3][i - 1024]; sv[i] = siluf_(x); }
        __syncthreads();
        float* MOD = (float*)(ws + WS_MOD);
        for (int u = b; u < N_MODU; u += G) {
            const int l = u / 96, cg = u % 96, col = cg * 64 + (tid & 63), kp = tid >> 6;
            const float* w = P.in[4] + (size_t)l * 1024 * 6144 + col;
            float a0 = 0.f, a1 = 0.f;
#pragma unroll 16
            for (int k = kp * 128; k < kp * 128 + 128; ++k) { const float wv = w[(size_t)k * 6144]; a0 += sv[k] * wv; a1 += sv[1024 + k] * wv; }
            red[(kp * 64 + (tid & 63)) * 2 + 0] = a0; red[(kp * 64 + (tid & 63)) * 2 + 1] = a1;
            __syncthreads();
            if (tid < 128) { const int c = tid & 63, wsel = tid >> 6; float s = 0.f;
#pragma unroll
                for (int q = 0; q < 8; ++q) s += red[(q * 64 + c) * 2 + wsel];
                MOD[((size_t)l * 2 + wsel) * 6144 + cg * 64 + c] = s + P.in[5][(size_t)l * 6144 + cg * 64 + c]; }
            __syncthreads();
        }
    }
    if (b == G - 1) {
        float* TAB = (float*)(ws + WS_TAB);
        for (int i = tid; i < 320 * 8; i += NTHR) { const int pos = i >> 3, f = i & 7; const float p = (float)(pos < 256 ? pos : pos - 256);
            const float inv = exp2f(-((float)(2 * f) / 16.0f) * 13.287712379549449f); const float ang = p * inv;
            TAB[i] = cosf(ang); TAB[320 * 8 + i] = sinf(ang); }
        for (int i = tid; i < 320 * 16; i += NTHR) { const int pos = i >> 4, f = i & 15; const float p = (float)(pos < 256 ? pos : pos - 256);
            const float inv = exp2f(-((float)(2 * f) / 32.0f) * 13.287712379549449f); const float ang = p * inv;
            TAB[320 * 16 + i] = cosf(ang); TAB[320 * 16 + 320 * 16 + i] = sinf(ang); }
    }
    if (b == G - 2 && tid < NLAYER) {
        const int l = tid;
        float gq = 0.f, gk = 0.f, dq = 0.f, dk = 0.f;
        for (int i = 0; i < 96; ++i) { gq = fmaxf(gq, fabsf(P.in[14][l * 96 + i])); gk = fmaxf(gk, fabsf(P.in[15][l * 96 + i])); }
        for (int i = 0; i < 64; ++i) { dq = fmaxf(dq, fabsf(P.in[16][l * 64 + i])); dk = fmaxf(dk, fabsf(P.in[17][l * 64 + i])); }
        const float* lp = P.in[18] + l * 256;
        float s1 = 0.f, s2 = 0.f;
        for (int i = 0; i < 64; ++i) { s1 += lp[i] * lp[64 + i]; s2 += lp[128 + i] * lp[192 + i]; }
        float* ac_ = (float*)((int*)(ws + WS_CTL) + l * 32 * ECS + 40);
        ac_[0] = 9.797958971132712f * gq * gk * LOG2E * 1.02f;
        ac_[1] = 8.0f * dq * dk * LOG2E * 1.02f;
        ac_[2] = __expf(s1) - __expf(s2);
    }
    if (b < NLAYER) {
        float* WRT = (float*)(ws + WS_WRT) + (size_t)b * 32 * 1024;
        const float* src = P.in[30] + (size_t)b * 1024 * 32;
        for (int i = tid; i < 32 * 1024; i += NTHR) { const int k = i >> 5, e = i & 31; WRT[e * 1024 + k] = src[i]; }
    }
}

DI void phase_rows_norm1(const Params& P, int lprev  , int nl  ) {
    unsigned char* ws = P.ws;
    const int G = GRID, tid = opaque_tid(), lane = tid & 63, wid = tid >> 6;
    bf16_t* XCUR = (bf16_t*)(ws + WS_XCUR);
    signed char* H = (signed char*)(ws + WS_H); float* HS = (float*)(ws + WS_HS);
    const float* MOD = (const float*)(ws + WS_MOD);
    const int* ctl = (const int*)(ws + WS_CTL);
    int offs_lane = 0;
    if (lprev >= 0) {
        const int c = (lane < 32) ? ctl[(lprev * 32 + lane) * ECS] : 0;
        const int nb = (c + 255) >> 8;
        int incl = nb;
#pragma unroll
        for (int d = 1; d < 32; d <<= 1) { const int t = __shfl_up(incl, d); if ((lane & 31) >= d) incl += t; }
        offs_lane = (incl - nb) * 256;
    }
    f32x4 Lg1[4], Lsc[4], Lsh[4], Lgt2[4];
#pragma unroll
    for (int j = 0; j < 4; ++j) { const int e = 256 * j + 4 * lane;
        if (nl < NLAYER) { Lg1[j] = *(const f32x4*)(P.in[6] + (size_t)nl * 1024 + e); Lsh[j] = *(const f32x4*)(MOD + ((size_t)nl * 2) * 6144 + e); Lsc[j] = *(const f32x4*)(MOD + ((size_t)nl * 2) * 6144 + 1024 + e); }
        else { Lg1[j] = Lsh[j] = Lsc[j] = (f32x4){0.f, 0.f, 0.f, 0.f}; }
        if (lprev >= 0) Lgt2[j] = *(const f32x4*)(MOD + ((size_t)lprev * 2) * 6144 + 5 * 1024 + e); else Lgt2[j] = (f32x4){0.f, 0.f, 0.f, 0.f}; }
    const int tend = (nl < NLAYER) ? T : SEQ;
    for (int tb = blockIdx.x * 8 + wid; tb < tend; tb += G * 16) {
        int tt[2]; bool ok[2]; int isc[2];
        f32x4 x[2][4];
        int te[2][4], tp[2][4]; float tg[2][4];
#pragma unroll
        for (int q = 0; q < 2; ++q) {
            tt[q] = tb + q * G * 8; ok[q] = tt[q] < T; const int t = ok[q] ? tt[q] : tb; isc[q] = t >= SEQ;
            if (lprev < 0) {
                const float* src = isc[q] ? (P.in[2] + (size_t)(t - SEQ) * 1024) : (P.in[0] + (size_t)t * 1024);
#pragma unroll
                for (int j = 0; j < 4; ++j) x[q][j] = *(const f32x4*)(src + 256 * j + 4 * lane);
            } else {
#pragma unroll
                for (int j = 0; j < 4; ++j) { const u32x2 w = *(const u32x2*)(XCUR + (size_t)t * 1024 + 256 * j + 4 * lane); x[q][j] = (f32x4){bflo(w.x), bfhi(w.x), bflo(w.y), bfhi(w.y)}; }
            }
            if (lprev >= 0) {
                const int* tope = (const int*)(ws + WS_TOPE) + (size_t)t * 4; const int* topp = (const int*)(ws + WS_TOPP) + (size_t)t * 4; const float* topg = (const float*)(ws + WS_TOPG) + (size_t)t * 4;
#pragma unroll
                for (int k = 0; k < 4; ++k) { te[q][k] = tope[k]; tp[q][k] = topp[k]; tg[q][k] = topg[k]; }
            }
        }
        if (lprev >= 0) {
            const bf16_t* Y = (const bf16_t*)(ws + WS_YMOE);
            u32x2 yw[2][4][4];
#pragma unroll
            for (int q = 0; q < 2; ++q)
#pragma unroll
                for (int k = 0; k < 4; ++k) { const int row = __shfl(offs_lane, te[q][k]) + tp[q][k]; const bf16_t* yr = Y + (size_t)row * 1024;
#pragma unroll
                    for (int j = 0; j < 4; ++j) yw[q][k][j] = *(const u32x2*)(yr + 256 * j + 4 * lane); }
#pragma unroll
            for (int q = 0; q < 2; ++q) {
                const float* gt2 = MOD + ((size_t)lprev * 2 + isc[q]) * 6144 + 5 * 1024;
#pragma unroll
                for (int j = 0; j < 4; ++j) { f32x4 y = {0.f, 0.f, 0.f, 0.f};
#pragma unroll
                    for (int k = 0; k < 4; ++k) { const u32x2 w = yw[q][k][j]; const float g = tg[q][k]; y.x += g * bflo(w.x); y.y += g * bfhi(w.x); y.z += g * bflo(w.y); y.w += g * bfhi(w.y); }
                    const f32x4 gg = isc[q] ? *(const f32x4*)(gt2 + 256 * j + 4 * lane) : Lgt2[j]; x[q][j] = x[q][j] + gg * y; }
            }
        }
#pragma unroll
        for (int q = 0; q < 2; ++q) {
            if (!ok[q]) continue;
            const int t = tt[q];
            if (nl < NLAYER) {
#pragma unroll
                for (int j = 0; j < 4; ++j) { u32x2 w; w.x = pk2(x[q][j].x, x[q][j].y); w.y = pk2(x[q][j].z, x[q][j].w); *(u32x2*)(XCUR + (size_t)t * 1024 + 256 * j + 4 * lane) = w; }
                float ss = 0.f;
#pragma unroll
                for (int j = 0; j < 4; ++j) ss += x[q][j].x * x[q][j].x + x[q][j].y * x[q][j].y + x[q][j].z * x[q][j].z + x[q][j].w * x[q][j].w;
                ss = wave_sum(ss);
                const float rstd = rsqrtf(ss * (1.0f / 1024.0f) + EPS);
                const float* sh = MOD + ((size_t)nl * 2 + isc[q]) * 6144;
                const float* sc = sh + 1024;
                f32x4 hv[4]; float am = 0.f;
#pragma unroll
                for (int j = 0; j < 4; ++j) {
                    const int e = 256 * j + 4 * lane;
                    const f32x4 gg = Lg1[j], s1 = isc[q] ? *(const f32x4*)(sc + e) : Lsc[j], b1 = isc[q] ? *(const f32x4*)(sh + e) : Lsh[j];
                    hv[j] = (x[q][j] * rstd) * gg * (s1 + 1.0f) + b1;
                    am = fmaxf(am, fmaxf(fmaxf(fabsf(hv[j].x), fabsf(hv[j].y)), fmaxf(fabsf(hv[j].z), fabsf(hv[j].w))));
                }
                am = wave_max(am);
                const float qs = (am > 0.f) ? am * (1.0f / 127.0f) : 1.0f, qi = 1.0f / qs;
#pragma unroll
                for (int j = 0; j < 4; ++j) *(unsigned*)(H + (size_t)t * 1024 + 256 * j + 4 * lane) = pack_i8x4(hv[j].x * qi, hv[j].y * qi, hv[j].z * qi, hv[j].w * qi);
                if (lane == 0) HS[t] = qs;
            } else if (!isc[q]) {
#pragma unroll
                for (int j = 0; j < 4; ++j) *(f32x4*)(P.out + (size_t)t * 1024 + 256 * j + 4 * lane) = x[q][j];
            }
        }
    }
    if (lprev >= 0 && nl < NLAYER && blockIdx.x >= 32) wdn_units(P, nl, XP_WDN_ROWS0, XP_WDN, (int)blockIdx.x - 32, GRID - 32);
}

DI void phase_router(const Params& P, int l, char* lds) {
    unsigned char* ws = P.ws;
    const bf16_t* XCUR = (const bf16_t*)(ws + WS_XCUR);
    const float* MOD = (const float*)(ws + WS_MOD);
    const float* WRT = (const float*)(ws + WS_WRT) + (size_t)l * 32 * 1024;
    int* ecnt = (int*)(ws + WS_CTL) + l * 32 * ECS;
    float* fl = (float*)lds;
    float* part = fl;
    float* part2 = (float*)(lds + 135424);
    float* lgx = part2 + 512;
    int* dst = (int*)(lds + 135424 + 2048 + 1056);
    int* lcnt = dst + 33 * 4;
    int* lbase = lcnt + 32;
    const float* g2 = P.in[7] + (size_t)l * 1024;
    f32x4 Rg2[4], Rsc[4], Rsh[4];
    { const int lane_ = opaque_tid() & 63;
#pragma unroll
      for (int j = 0; j < 4; ++j) { const int e = 256 * j + 4 * lane_; Rg2[j] = *(const f32x4*)(g2 + e);
          Rsh[j] = *(const f32x4*)(MOD + ((size_t)l * 2) * 6144 + 3 * 1024 + e); Rsc[j] = *(const f32x4*)(MOD + ((size_t)l * 2) * 6144 + 4 * 1024 + e) + 1.0f; } }
    for (int i = opaque_tid(); i < 8 * 33; i += NTHR) lgx[i] = 0.f;
#pragma unroll 1
    for (int pass = 0; pass < 2; ++pass) {
        const int tbase = (int)blockIdx.x * 65;
        const int t0 = tbase + 32 * pass;
        const bool extra = pass == 0;
        const int tx = tbase + 64;
        const int tid = opaque_tid(), lane = tid & 63, wid = tid >> 6, r = lane & 31, h = lane >> 5; (void)tid;
        unsigned pq[5][4]; float rsc[5];
        {
            f32x4 x[5][4]; float ss[5];
#pragma unroll
            for (int q = 0; q < 5; ++q) { const int t = (q < 4) ? (t0 + wid * 4 + q) : tx;
#pragma unroll
                for (int j = 0; j < 4; ++j) { const u32x2 w = *(const u32x2*)(XCUR + (size_t)t * 1024 + 256 * j + 4 * lane); x[q][j] = (f32x4){bflo(w.x), bfhi(w.x), bflo(w.y), bfhi(w.y)}; } }
#pragma unroll
            for (int q = 0; q < 5; ++q) { float s = 0.f;
#pragma unroll
                for (int j = 0; j < 4; ++j) s += x[q][j].x * x[q][j].x + x[q][j].y * x[q][j].y + x[q][j].z * x[q][j].z + x[q][j].w * x[q][j].w;
                ss[q] = wave_sum(s); }
#pragma unroll
            for (int q = 0; q < 5; ++q) {
                if (q == 4 && !(extra && wid == 0)) continue;
                const int t = (q < 4) ? (t0 + wid * 4 + q) : tx, tr = (q < 4) ? (wid * 4 + q) : 32;
                const int isctx = t >= SEQ;
                const float* sh = MOD + ((size_t)l * 2 + isctx) * 6144 + 3 * 1024;
                const float* sc = sh + 1024;
                const float rstd = rsqrtf(ss[q] * (1.0f / 1024.0f) + EPS);
                f32x4 hv[4]; float am = 0.f;
#pragma unroll
                for (int j = 0; j < 4; ++j) {
                    const int e = 256 * j + 4 * lane;
                    const f32x4 gg = Rg2[j], s1 = isctx ? (*(const f32x4*)(sc + e) + 1.0f) : Rsc[j], b1 = isctx ? *(const f32x4*)(sh + e) : Rsh[j];
                    hv[j] = (x[q][j] * rstd) * gg * s1 + b1;
                    am = fmaxf(am, fmaxf(fmaxf(fabsf(hv[j].x), fabsf(hv[j].y)), fmaxf(fabsf(hv[j].z), fabsf(hv[j].w))));
                    float* d = fl + tr * 1025 + e; d[0] = hv[j].x; d[1] = hv[j].y; d[2] = hv[j].z; d[3] = hv[j].w;
                }
                am = wave_max(am);
                const float qs = (am > 0.f) ? am * (1.0f / 127.0f) : 1.0f, qi = 1.0f / qs;
                rsc[q] = qs;
#pragma unroll
                for (int j = 0; j < 4; ++j) pq[q][j] = pack_i8x4(hv[j].x * qi, hv[j].y * qi, hv[j].z * qi, hv[j].w * qi);
            }
        }
        if (tid < 32) lcnt[tid] = 0;
        __syncthreads();
        {
            f32x16 acc;
#pragma unroll
            for (int i = 0; i < 16; ++i) acc[i] = 0.f;
            const int kb = 128 * wid + 64 * h;
            const float* wrow = WRT + (size_t)r * 1024 + kb;
            const float* frow = fl + r * 1025 + kb;
            f32x4 wv[16];
#pragma unroll
            for (int c = 0; c < 16; ++c) wv[c] = *(const f32x4*)(wrow + 4 * c);
#pragma unroll
            for (int c = 0; c < 16; ++c) {
                acc = __builtin_amdgcn_mfma_f32_32x32x2f32(frow[4 * c + 0], wv[c].x, acc, 0, 0, 0);
                acc = __builtin_amdgcn_mfma_f32_32x32x2f32(frow[4 * c + 1], wv[c].y, acc, 0, 0, 0);
                acc = __builtin_amdgcn_mfma_f32_32x32x2f32(frow[4 * c + 2], wv[c].z, acc, 0, 0, 0);
                acc = __builtin_amdgcn_mfma_f32_32x32x2f32(frow[4 * c + 3], wv[c].w, acc, 0, 0, 0);
            }
            if (extra) {
                const float* fx = fl + 32 * 1025 + kb; float a = 0.f;
#pragma unroll
                for (int c = 0; c < 16; ++c) a += fx[4 * c] * wv[c].x + fx[4 * c + 1] * wv[c].y + fx[4 * c + 2] * wv[c].z + fx[4 * c + 3] * wv[c].w;
                part2[(2 * wid + h) * 32 + r] = a;
            }
            __syncthreads();
#pragma unroll
            for (int i = 0; i < 16; ++i) { const int tok = (i & 3) + 8 * (i >> 2) + 4 * h; part[(wid * 32 + tok) * 33 + r] = acc[i]; }
            if (extra && wid == 1 && lane < 32) { float a = 0.f;
#pragma unroll
                for (int w = 0; w < 16; ++w) a += part2[w * 32 + lane];
                lgx[lane] = a; }
        }
        __syncthreads();
        if (wid == 0) {
            int te[4] = {0, 0, 0, 0}; float tg[4] = {0.f, 0.f, 0.f, 0.f}; int lr[4] = {0, 0, 0, 0};
            const bool act = lane < 32 || (extra && lane == 32);
            const int t = (lane < 32) ? (t0 + lane) : tx;
            if (act) {
                float lg[32];
                const float* lsrc = (lane < 32) ? (part + lane * 33) : lgx; const int lstr = (lane < 32) ? 32 * 33 : 33;
#pragma unroll
                for (int e = 0; e < 32; ++e) { float s = P.in[31][l * 32 + e];
#pragma unroll
                    for (int w = 0; w < 8; ++w) s += lsrc[w * lstr + e];
                    lg[e] = s; }
                float tv[4];
#pragma unroll
                for (int k = 0; k < 4; ++k) {
                    float best = -3.0e38f; int bi = 0;
#pragma unroll
                    for (int e = 0; e < 32; ++e) { const bool better = lg[e] > best; best = better ? lg[e] : best; bi = better ? e : bi; }
                    te[k] = bi; tv[k] = best;
#pragma unroll
                    for (int e = 0; e < 32; ++e) lg[e] = (e == bi) ? -3.0e38f : lg[e];
                }
                float se = 0.f;
#pragma unroll
                for (int k = 0; k < 4; ++k) { tg[k] = __expf(tv[k] - tv[0]); se += tg[k]; }
                const float inv = 1.0f / se;
#pragma unroll
                for (int k = 0; k < 4; ++k) { tg[k] *= inv; lr[k] = atomicAdd(lcnt + te[k], 1); }
            }
            if (lane < 32) { const int c = lcnt[lane]; lbase[lane] = c ? atomicAdd(ecnt + lane * ECS, c) : 0; }
            if (act) {
                int* tope = (int*)(ws + WS_TOPE) + (size_t)t * 4;
                int* topp = (int*)(ws + WS_TOPP) + (size_t)t * 4;
                float* topg = (float*)(ws + WS_TOPG) + (size_t)t * 4;
#pragma unroll
                for (int k = 0; k < 4; ++k) {
                    const int pos = lbase[te[k]] + lr[k];
                    tope[k] = te[k]; topp[k] = pos; topg[k] = tg[k];
                    dst[lane * 4 + k] = te[k] * T + pos;
                }
            }
        }
        __syncthreads();
        {
            signed char* XG = (signed char*)(ws + WS_XG); float* XGS = (float*)(ws + WS_XGS);
#pragma unroll
            for (int q = 0; q < 5; ++q) { if (q == 4 && !(extra && wid == 0)) continue;
                const int tr = (q < 4) ? (wid * 4 + q) : 32;
#pragma unroll
                for (int k = 0; k < 4; ++k) { const int drow = dst[tr * 4 + k]; signed char* d = XG + (size_t)drow * 1024 + 4 * lane;
#pragma unroll
                    for (int j = 0; j < 4; ++j) *(unsigned*)(d + 256 * j) = pq[q][j];
                    if (lane == 0) XGS[drow] = rsc[q]; } }
        }
        __syncthreads();
    }
}


struct EpiIn {
    bf16_t* U; float* DTR; const float* bg; const float* hs; const float* wins;
    DI void operator()(const g8::AccI& acc, const g8::Unit& u, int wr, int wc, int fr, int fq) const {
        const bool gate = u.t1 >= (U_G / 256);
        float sa_[2][4];
#pragma unroll
        for (int ai = 0; ai < 2; ++ai)
#pragma unroll
            for (int m = 0; m < 4; ++m) sa_[ai][m] = hs[u.t0 * 256 + 128 * ai + 64 * wr + 16 * m + fr];
        __builtin_amdgcn_sched_barrier(0);
#pragma unroll
        for (int bj = 0; bj < 2; ++bj) {
            const int col = u.t1 * 256 + 128 * bj + 32 * wc + 8 * fq;
            const f32x4 w0 = *(const f32x4*)(wins + col), w1 = *(const f32x4*)(wins + col + 4);
            f32x4 b0 = {0.f, 0.f, 0.f, 0.f}, b1 = {0.f, 0.f, 0.f, 0.f};
            if (gate) { b0 = *(const f32x4*)(bg + col - U_G); b1 = *(const f32x4*)(bg + col - U_G + 4); }
#pragma unroll
            for (int ai = 0; ai < 2; ++ai)
#pragma unroll
                for (int m = 0; m < 4; ++m) {
                    const int row = u.t0 * 256 + 128 * ai + 64 * wr + 16 * m + fr;
                    const float sa = sa_[ai][m];
                    const i32x4 a0 = acc[ai][bj][m][0], a1 = acc[ai][bj][m][1];
                    f32x4 v0 = {(float)a0.x * (sa * w0.x), (float)a0.y * (sa * w0.y), (float)a0.z * (sa * w0.z), (float)a0.w * (sa * w0.w)};
                    f32x4 v1 = {(float)a1.x * (sa * w1.x), (float)a1.y * (sa * w1.y), (float)a1.z * (sa * w1.z), (float)a1.w * (sa * w1.w)};
                    if (gate) {
                        v0.x = sigmoidf_(v0.x + b0.x); v0.y = sigmoidf_(v0.y + b0.y); v0.z = sigmoidf_(v0.z + b0.z); v0.w = sigmoidf_(v0.w + b0.w);
                        v1.x = sigmoidf_(v1.x + b1.x); v1.y = sigmoidf_(v1.y + b1.y); v1.z = sigmoidf_(v1.z + b1.z); v1.w = sigmoidf_(v1.w + b1.w);
                    } else if (col >= U_DT && col < U_DT + 16) {
                        *(f32x4*)(DTR + (size_t)row * 16 + (col - U_DT)) = v0; *(f32x4*)(DTR + (size_t)row * 16 + (col - U_DT) + 4) = v1;
                    }
                    u32x4 w; w.x = pk2(v0.x, v0.y); w.y = pk2(v0.z, v0.w); w.z = pk2(v1.x, v1.y); w.w = pk2(v1.z, v1.w);
                    *(u32x4*)(U + (size_t)row * NIN + col) = w;
                }
        }
    }
};
DI void phase_gemm_in(const Params& P, int l, char* lds) {
    unsigned char* ws = P.ws;
    g8::GridSched<NQB, NIN / 256> S; S.init(ws + WS_H, 512, ws + WS_WIN + l * SZ_WIN, 512);
    EpiIn E{(bf16_t*)(ws + WS_U), (float*)(ws + WS_DTR), P.in[9] + (size_t)l * 3072, (const float*)(ws + WS_HS), (const float*)(ws + WS_WINS) + (size_t)l * NIN};
    g8::gemm_phase<true, true>((LAS unsigned char*)lds, 512, 512, S, E);
}

struct EpiBf16Plain {
    bf16_t* C; int ldc;
    DI void operator()(const g8::Acc& acc, const g8::Unit& u, int wr, int wc, int fr, int fq) const {
#pragma unroll
        for (int ai = 0; ai < 2; ++ai)
#pragma unroll
            for (int m = 0; m < 4; ++m) {
                const int row = u.t0 * 256 + 128 * ai + 64 * wr + 16 * m + fr;
#pragma unroll
                for (int bj = 0; bj < 2; ++bj) {
                    const int col = u.t1 * 256 + 128 * bj + 32 * wc + 8 * fq;
                    const f32x4 v0 = acc[ai][bj][m][0], v1 = acc[ai][bj][m][1];
                    u32x4 w; w.x = pk2(v0.x, v0.y); w.y = pk2(v0.z, v0.w); w.z = pk2(v1.x, v1.y); w.w = pk2(v1.z, v1.w);
                    *(u32x4*)(C + (size_t)row * ldc + col) = w;
                }
            }
    }
};

template <int NI>
DI void gemm_store_bf16(const GemmAcc<NI>& acc, bf16_t* C, size_t ldc, int row0, int col0) {
    const int tid = opaque_tid(), lane = tid & 63, wid = tid >> 6, wr = wid >> 2, wc = wid & 3, r = lane & 31, h = lane >> 5;
#pragma unroll
    for (int mi = 0; mi < 4; ++mi)
#pragma unroll
        for (int ni = 0; ni < NI; ++ni) {
            float v[16];
#pragma unroll
            for (int i = 0; i < 16; ++i) v[i] = acc.a[mi][ni][i];
            st_bf16x16(C + (size_t)(row0 + wr * 128 + mi * 32 + r) * ldc + col0 + wc * 32 * NI + ni * 32 + 16 * h, v);
        }
}

DI void phase_gemm_merge(const Params& P, int l, char* lds) {
    unsigned char* ws = P.ws;
    const int G = GRID;
    const bf16_t* U = (const bf16_t*)(ws + WS_U);
    const bf16_t* WUP = (const bf16_t*)(ws + WS_WUP + l * SZ_WUP);
    bf16_t* MRG = (bf16_t*)(ws + WS_MRG);
    const int nu = (NQB - 1) * 8;
    const int bx_ = opaque_bid() & 7, by_ = opaque_bid() >> 3;
    for (int k_ = 0; ; ++k_) {
        const int rt = k_ * 32 + bx_ * 4 + (by_ >> 3), ct = by_ & 7;
        if (rt * 8 >= nu) break;
        const int tid = opaque_tid(), lane = tid & 63, wid = tid >> 6, wr = wid >> 2, wc = wid & 3, r = lane & 31, h = lane >> 5; (void)tid; (void)wr; (void)wc; (void)r; (void)h;
        float tot[4][16];
#pragma unroll
        for (int mi = 0; mi < 4; ++mi)
#pragma unroll
            for (int i = 0; i < 16; ++i) tot[mi][i] = 0.f;
#pragma unroll 1
        for (int br = 0; br < 3; ++br) {
            const bf16_t* Y = (const bf16_t*)(ws + (br == 0 ? WS_YA : (br == 1 ? WS_YB : WS_YC)));
            GemmAcc<1> acc;
            gemm_tile<1>(lds, ARowPlain{Y + (size_t)rt * 256 * 512, 512}, WUP + (size_t)br * 1024 * 512 + (size_t)ct * 128 * 512, 512, 512, acc);
            u32x4 gg0[4], gg1[4];
#pragma unroll
            for (int mi = 0; mi < 4; ++mi) { const bf16_t* gp = U + (size_t)(rt * 256 + wr * 128 + mi * 32 + r) * NIN + U_G + br * 1024 + ct * 128 + wc * 32 + 16 * h;
                gg0[mi] = *(const u32x4*)gp; gg1[mi] = *(const u32x4*)(gp + 8); }
            __builtin_amdgcn_sched_barrier(0);
#pragma unroll
            for (int mi = 0; mi < 4; ++mi) {
                const u32x4 g0 = gg0[mi], g1 = gg1[mi];
                const unsigned gw[8] = {g0.x, g0.y, g0.z, g0.w, g1.x, g1.y, g1.z, g1.w};
#pragma unroll
                for (int q = 0; q < 8; ++q) { tot[mi][2 * q] += bflo(gw[q]) * acc.a[mi][0][2 * q]; tot[mi][2 * q + 1] += bfhi(gw[q]) * acc.a[mi][0][2 * q + 1]; }
            }
        }
#pragma unroll
        for (int mi = 0; mi < 4; ++mi)
            st_bf16x16(MRG + (size_t)(rt * 256 + wr * 128 + mi * 32 + r) * 1024 + ct * 128 + wc * 32 + 16 * h, tot[mi]);
    }
    if (l + 1 < NLAYER) {
        const int c_ = opaque_bid();
        if ((c_ & 7) == 0) {
            const int su = c_ >> 3, ct = su & 7, qr = su >> 3;
            const int tid = opaque_tid(), lane = tid & 63, wid = tid >> 6, wr = wid >> 2, wc = wid & 3, r = lane & 31, h = lane >> 5; (void)tid;
            const int row = (NQB - 1) * 256 + qr * 64 + wr * 32 + r;
            float tot[16];
#pragma unroll
            for (int i = 0; i < 16; ++i) tot[i] = 0.f;
#pragma unroll 1
            for (int br = 0; br < 3; ++br) {
                const bf16_t* Y = (const bf16_t*)(ws + (br == 0 ? WS_YA : (br == 1 ? WS_YB : WS_YC)));
                GemmAcc<1> acc;
                gemm_tile<1, ARowPlain, 1>(lds, ARowPlain{Y + (size_t)((NQB - 1) * 256 + qr * 64) * 512, 512}, WUP + (size_t)br * 1024 * 512 + (size_t)ct * 128 * 512, 512, 512, acc);
                const bf16_t* gp = U + (size_t)row * NIN + U_G + br * 1024 + ct * 128 + wc * 32 + 16 * h;
                const u32x4 g0 = *(const u32x4*)gp, g1 = *(const u32x4*)(gp + 8);
                const unsigned gw[8] = {g0.x, g0.y, g0.z, g0.w, g1.x, g1.y, g1.z, g1.w};
#pragma unroll
                for (int q = 0; q < 8; ++q) { tot[2 * q] += bflo(gw[q]) * acc.a[0][0][2 * q]; tot[2 * q + 1] += bfhi(gw[q]) * acc.a[0][0][2 * q + 1]; }
            }
            st_bf16x16(MRG + (size_t)row * 1024 + ct * 128 + wc * 32 + 16 * h, tot);
        } else {
            wdn_units(P, l + 1, 0, XP_WDN_MERGE, c_ - (c_ >> 3) - 1, GRID - 32);
        }
    }
}

struct EpiOut {
    bf16_t* XCUR; const float* MOD; int l;
    DI void operator()(const g8::Acc& acc, const g8::Unit& u, int wr, int wc, int fr, int fq) const {
        const float* gt1 = MOD + ((size_t)l * 2 + (u.t0 == NQB - 1 ? 1 : 0)) * 6144 + 2 * 1024;
        f32x4 g[2][2];
#pragma unroll
        for (int bj = 0; bj < 2; ++bj)
#pragma unroll
            for (int n = 0; n < 2; ++n) g[bj][n] = *(const f32x4*)(gt1 + u.t1 * 256 + 128 * bj + 32 * wc + 16 * n + 4 * fq);
#pragma unroll
        for (int ai = 0; ai < 2; ++ai)
#pragma unroll
            for (int mp = 0; mp < 4; mp += 2) {
                u32x2 w[2][2][2];
#pragma unroll
                for (int mm = 0; mm < 2; ++mm) { const int row = u.t0 * 256 + 128 * ai + 64 * wr + 16 * (mp + mm) + fr;
#pragma unroll
                    for (int bj = 0; bj < 2; ++bj)
#pragma unroll
                        for (int n = 0; n < 2; ++n) w[mm][bj][n] = *(const u32x2*)(XCUR + (size_t)row * 1024 + u.t1 * 256 + 128 * bj + 32 * wc + 16 * n + 4 * fq); }
                __builtin_amdgcn_sched_barrier(0);
#pragma unroll
                for (int mm = 0; mm < 2; ++mm) { const int row = u.t0 * 256 + 128 * ai + 64 * wr + 16 * (mp + mm) + fr;
#pragma unroll
                    for (int bj = 0; bj < 2; ++bj)
#pragma unroll
                        for (int n = 0; n < 2; ++n) {
                            const u32x2 ww = w[mm][bj][n];
                            const f32x4 v = (f32x4){bflo(ww.x), bfhi(ww.x), bflo(ww.y), bfhi(ww.y)} + g[bj][n] * acc[ai][bj][mp + mm][n];
                            u32x2 o2; o2.x = pk2(v.x, v.y); o2.y = pk2(v.z, v.w);
                            *(u32x2*)(XCUR + (size_t)row * 1024 + u.t1 * 256 + 128 * bj + 32 * wc + 16 * n + 4 * fq) = o2;
                        } }
                __builtin_amdgcn_sched_barrier(0);
            }
    }
};
DI void phase_gemm_out(const Params& P, int l, char* lds) {
    unsigned char* ws = P.ws;
    EpiOut E{(bf16_t*)(ws + WS_XCUR), (const float*)(ws + WS_MOD), l};
    {
        g8::GridSched<NQB - 1, 4> S; S.init(ws + WS_MRG, 1024, ws + WS_WOUT + l * SZ_WOUT, 1024);
        g8::gemm_phase<false>((LAS unsigned char*)lds, 1024, 1024, S, E);
    }
    if (l + 1 < NLAYER) {
        const int c_ = opaque_bid();
        __syncthreads();
        if ((c_ & 7) == 0) {
            const int su = c_ >> 3, ct = su & 7, qr = su >> 3;
            const int tid = opaque_tid(), lane = tid & 63, wid = tid >> 6, wr = wid >> 2, wc = wid & 3, r = lane & 31, h = lane >> 5; (void)tid;
            const int row = (NQB - 1) * 256 + qr * 64 + wr * 32 + r, col = ct * 128 + wc * 32 + 16 * h;
            GemmAcc<1> acc;
            gemm_tile<1, ARowPlain, 1>(lds, ARowPlain{(const bf16_t*)(ws + WS_MRG) + (size_t)((NQB - 1) * 256 + qr * 64) * 1024, 1024}, (const bf16_t*)(ws + WS_WOUT + l * SZ_WOUT) + (size_t)ct * 128 * 1024, 1024, 1024, acc);
            const float* gt1 = (const float*)(ws + WS_MOD) + ((size_t)l * 2 + 1) * 6144 + 2 * 1024 + col;
            bf16_t* xp = (bf16_t*)(ws + WS_XCUR) + (size_t)row * 1024 + col;
            const u32x4 x0 = *(const u32x4*)xp, x1 = *(const u32x4*)(xp + 8);
            const unsigned xw[8] = {x0.x, x0.y, x0.z, x0.w, x1.x, x1.y, x1.z, x1.w};
            float v[16];
#pragma unroll
            for (int q = 0; q < 8; ++q) { v[2 * q] = bflo(xw[q]) + gt1[2 * q] * acc.a[0][0][2 * q]; v[2 * q + 1] = bfhi(xw[q]) + gt1[2 * q + 1] * acc.a[0][0][2 * q + 1]; }
            st_bf16x16(xp, v);
        } else {
            const int rk = c_ - (c_ >> 3) - 1;
            for (int u = rk; u < XP_WDN_OUTN; u += GRID - 32) { const int rr = (u < XP_WDN_DOWN0 - XP_WDN_MERGE) ? (XP_WDN_MERGE + u) : (XP_WDN_DOWN1 + (u - (XP_WDN_DOWN0 - XP_WDN_MERGE)));
                wdn_units(P, l + 1, rr, rr + 1, 0, 1); }
        }
    }
}

constexpr int MOE_TAB_OFF = 131072 + 1024;
DI int moe_build_table(const int* ecnt, char* lds) {
    int* tab = (int*)(lds + MOE_TAB_OFF);
    const int tid = opaque_tid();
    if (tid < 64) {
        const int e = tid & 31;
        const int nb = (tid < 32) ? ((ecnt[e * ECS] + 255) >> 8) : 0;
        int incl = nb;
#pragma unroll
        for (int d = 1; d < 32; d <<= 1) { const int t = __shfl_up(incl, d); if ((tid & 31) >= d) incl += t; }
        if (tid < 32) { const int base = incl - nb; for (int j = 0; j < nb; ++j) tab[1 + base + j] = (e << 16) | j; if (tid == 31) tab[0] = incl; }
    }
    __syncthreads();
    return tab[0];
}
template <int NCT, bool SPARSE, size_t A_EXPERT_STEP, size_t A_BLK_STEP, size_t W_EXPERT_STEP, size_t W_CT_STEP>
struct MoeSched {
    const char* A; const char* W; const int* tab; int nunits; int c;
    DI bool next(int i, g8::Unit& u) const {
        constexpr int RPX = 32 / NCT;
        const int x = c & 7, y = c >> 3;
        const int rb = i * (GRID / NCT) + x * RPX + y / NCT, ct = y % NCT;
        if (rb * NCT >= nunits) return false;
        const int ej = tab[1 + rb], e = ej >> 16, j = ej & 0xffff;
        u.a = SPARSE ? (A + (size_t)e * A_EXPERT_STEP + (size_t)j * A_BLK_STEP) : (A + (size_t)rb * A_BLK_STEP);
        u.b = W + (size_t)e * W_EXPERT_STEP + (size_t)ct * W_CT_STEP; u.t0 = rb; u.t1 = ct | (e << 8); return true;
    }
};
struct EpiGu {
    bf16_t* ACT; const float* bgu_l; const float* xgs; const float* wgs_l; const int* tab;
    DI void operator()(const g8::AccI& acc, const g8::Unit& u, int wr, int wc, int fr, int fq) const {
        const int ct = u.t1 & 255, e = u.t1 >> 8;
        const int j0 = ct * 128 + 32 * wc + 8 * fq;
        const float* bg = bgu_l + (size_t)e * 2048 + j0;
        const f32x4 bg0 = *(const f32x4*)bg, bg1 = *(const f32x4*)(bg + 4), bl0 = *(const f32x4*)(bg + 1024), bl1 = *(const f32x4*)(bg + 1028);
        const float* ws_ = wgs_l + (size_t)e * 2048 + ct * 256 + 32 * wc + 8 * fq;
        const f32x4 sg0 = *(const f32x4*)ws_, sg1 = *(const f32x4*)(ws_ + 4), sl0 = *(const f32x4*)(ws_ + 128), sl1 = *(const f32x4*)(ws_ + 132);
        const int ej = tab[1 + u.t0];
        const float* xs = xgs + (size_t)(ej >> 16) * T + (ej & 0xffff) * 256;
        float sa_[2][4];
#pragma unroll
        for (int ai = 0; ai < 2; ++ai)
#pragma unroll
            for (int m = 0; m < 4; ++m) sa_[ai][m] = xs[128 * ai + 64 * wr + 16 * m + fr];
        __builtin_amdgcn_sched_barrier(0);
#pragma unroll
        for (int ai = 0; ai < 2; ++ai)
#pragma unroll
            for (int m = 0; m < 4; ++m) {
                const int rl = 128 * ai + 64 * wr + 16 * m + fr, row = u.t0 * 256 + rl;
                const float sa = sa_[ai][m];
                float v[8];
#pragma unroll
                for (int q = 0; q < 8; ++q) {
                    float glu = (float)acc[ai][0][m][q >> 2][q & 3] * (sa * ((q < 4) ? sg0[q & 3] : sg1[q & 3])) + ((q < 4) ? bg0[q & 3] : bg1[q & 3]);
                    float lin = (float)acc[ai][1][m][q >> 2][q & 3] * (sa * ((q < 4) ? sl0[q & 3] : sl1[q & 3])) + ((q < 4) ? bl0[q & 3] : bl1[q & 3]);
                    glu = fminf(glu, 7.0f); lin = fminf(fmaxf(lin, -7.0f), 7.0f);
                    v[q] = glu * sigmoidf_(1.702f * glu) * (lin + 1.0f);
                }
                u32x4 w; w.x = pk2(v[0], v[1]); w.y = pk2(v[2], v[3]); w.z = pk2(v[4], v[5]); w.w = pk2(v[6], v[7]);
                *(u32x4*)(ACT + (size_t)row * 1024 + j0) = w;
            }
    }
};
DI void phase_moe_gu(const Params& P, int l, char* lds) {
    unsigned char* ws = P.ws;
    const int* ecnt = (const int*)(ws + WS_CTL) + l * 32 * ECS;
    const int nblk = moe_build_table(ecnt, lds);
    MoeSched<8, true, (size_t)T * 1024, (size_t)256 * 1024, (size_t)2048 * 1024, (size_t)256 * 1024> S{(const char*)(ws + WS_XG), (const char*)(ws + WS_WGU + l * SZ_WGU), (const int*)(lds + MOE_TAB_OFF), nblk * 8, opaque_bid()};
    EpiGu E{(bf16_t*)(ws + WS_ACT), P.in[33] + (size_t)l * 32 * 2048, (const float*)(ws + WS_XGS), (const float*)(ws + WS_WGS) + (size_t)l * 32 * 2048, (const int*)(lds + MOE_TAB_OFF)};
    g8::gemm_phase<true, true>((LAS unsigned char*)lds, 512, 512, S, E);
}
struct EpiDown {
    bf16_t* Y; const float* bd_l;
    DI void operator()(const g8::Acc& acc, const g8::Unit& u, int wr, int wc, int fr, int fq) const {
        const int ct = u.t1 & 255, e = u.t1 >> 8;
#pragma unroll
        for (int bj = 0; bj < 2; ++bj) {
            const int col = ct * 256 + 128 * bj + 32 * wc + 8 * fq;
            const f32x4 b0 = *(const f32x4*)(bd_l + (size_t)e * 1024 + col), b1 = *(const f32x4*)(bd_l + (size_t)e * 1024 + col + 4);
#pragma unroll
            for (int ai = 0; ai < 2; ++ai)
#pragma unroll
                for (int m = 0; m < 4; ++m) {
                    const int row = u.t0 * 256 + 128 * ai + 64 * wr + 16 * m + fr;
                    const f32x4 v0 = acc[ai][bj][m][0] + b0, v1 = acc[ai][bj][m][1] + b1;
                    u32x4 w; w.x = pk2(v0.x, v0.y); w.y = pk2(v0.z, v0.w); w.z = pk2(v1.x, v1.y); w.w = pk2(v1.z, v1.w);
                    *(u32x4*)(Y + (size_t)row * 1024 + col) = w;
                }
        }
    }
};
DI void phase_moe_down(const Params& P, int l, char* lds) {
    unsigned char* ws = P.ws;
    const int nblk = ((const int*)(lds + MOE_TAB_OFF))[0];
    MoeSched<4, false, 0, (size_t)256 * 2048, (size_t)1024 * 2048, (size_t)256 * 2048> S{(const char*)(ws + WS_ACT), (const char*)(ws + WS_WDN + l * SZ_WDN), (const int*)(lds + MOE_TAB_OFF), nblk * 4, opaque_bid()};
    EpiDown E{(bf16_t*)(ws + WS_YMOE), P.in[35] + (size_t)l * 32 * 1024};
    g8::gemm_phase<true>((LAS unsigned char*)lds, 1024, 1024, S, E);
    if (l + 1 < NLAYER) {
        const int m = nblk - ((nblk - 1) >> 6) * 64;
        const int c_ = opaque_bid(), key = ((c_ & 7) * 8 + ((c_ >> 3) >> 2)) * 4 + ((c_ >> 3) & 3);
        if (m == 64) wdn_units(P, l + 1, XP_WDN_DOWN0, XP_WDN_DOWN1, c_, GRID);
        else if (key >= 4 * m) wdn_units(P, l + 1, XP_WDN_DOWN0, XP_WDN_DOWN1, key - 4 * m, GRID - 4 * m);
    }
}

constexpr int P3_SSM = NCHUNK * 2;
constexpr int P3_MLAQ = NQB * 3, P3_MLAKV = NQB * 4;
constexpr int P3_DIF = NT64;

DI const float* rope_tab(const unsigned char* ws) { return (const float*)(ws + WS_TAB); }

DI void dif_prep_unit(const Params& P, int l, int tile, char* lds) {
    unsigned char* ws = P.ws;
    const int tid = opaque_tid(), lane = tid & 63, wid = tid >> 6;
    const bf16_t* U = (const bf16_t*)(ws + WS_U);
    bf16_t* QD = (bf16_t*)(ws + WS_QD); bf16_t* KD = (bf16_t*)(ws + WS_KD); bf16_t* VDT = (bf16_t*)(ws + WS_VDT);
    const float* TABD = rope_tab(ws) + 320 * 16;
    const float* gq = P.in[16] + l * 64; const float* gk = P.in[17] + l * 64;
    const int sub = lane & 3, grp = lane >> 2;
    const float qscale = 0.125f * LOG2E;
    bf16_t* vs = (bf16_t*)lds;
    u32x4 ld0[8], ld1[8], ldv[8];
#pragma unroll
    for (int q = 0; q < 8; ++q) {
        const int t = tile * 64 + wid * 8 + q;
        const bf16_t* src = U + (size_t)t * NIN + U_DQ + grp * 64 + sub * 16;
        ld0[q] = *(const u32x4*)src; ld1[q] = *(const u32x4*)(src + 8);
        ldv[q] = *(const u32x4*)(U + (size_t)t * NIN + U_DV + lane * 8);
    }
#pragma unroll
    for (int q = 0; q < 8; ++q) {
        const int tl_ = wid * 8 + q, t = tile * 64 + tl_;
        const bool lat = t < SEQ;
        const u32x4 w0 = ld0[q], w1 = ld1[q];
        float x[16] = {bflo(w0.x), bfhi(w0.x), bflo(w0.y), bfhi(w0.y), bflo(w0.z), bfhi(w0.z), bflo(w0.w), bfhi(w0.w),
                       bflo(w1.x), bfhi(w1.x), bflo(w1.y), bfhi(w1.y), bflo(w1.z), bfhi(w1.z), bflo(w1.w), bfhi(w1.w)};
        float ss = 0.f;
#pragma unroll
        for (int i = 0; i < 16; ++i) ss += x[i] * x[i];
        ss = quad_sum(ss);
        const float rstd = rsqrtf(ss * (1.0f / 64.0f) + EPS);
        const float* g = (grp < 8 ? gq : gk) + sub * 16;
#pragma unroll
        for (int i = 0; i < 16; ++i) x[i] = x[i] * rstd * g[i];
        if (lat) {
            const int pos = (sub < 2) ? (t >> 6) : (256 + (t & 63));
            const float* cs = TABD + pos * 16; const float* sn = TABD + 320 * 16 + pos * 16;
#pragma unroll
            for (int i = 0; i < 16; ++i) {
                const float other = lane_xor1(x[i]);
                const float c = cs[i], s = sn[i];
                x[i] = (sub & 1) ? (x[i] * c + other * s) : (x[i] * c - other * s);
            }
        }
        if (grp < 8) {
#pragma unroll
            for (int i = 0; i < 16; ++i) x[i] *= qscale;
            st_bf16x16(QD + ((size_t)grp * T + t) * 64 + sub * 16, x);
        } else {
            st_fp8x16((unsigned char*)KD + ((size_t)(grp - 8) * T + t) * 64 + sub * 16, x);
        }
        *(u32x4*)(vs + tl_ * 520 + lane * 8) = ldv[q];
    }
    __syncthreads();
#pragma unroll 1
    for (int it = 0; it < 4; ++it) {
        const int cid = tid + it * NTHR;
        const int rowc = cid >> 2, pc = cid & 3;
        float e[16];
#pragma unroll
        for (int j = 0; j < 16; ++j) { const int key = kperm8(pc * 16 + j); e[j] = bf2f(vs[key * 520 + rowc]); }
        const int head = rowc >> 7, dv = rowc & 127;
        st_fp8x16((unsigned char*)VDT + (((size_t)head * NT64 + tile) * 128 + dv) * 64 + pc * 16, e);
    }
    __syncthreads();
}

DI void ssm_prep_unit(const Params& P, int l, int chunk, int g, char* lds) {
    unsigned char* ws = P.ws;
    const int tid = opaque_tid(), lane = tid & 63, wid = tid >> 6, r = lane & 31, h = lane >> 5;
    const bf16_t* U = (const bf16_t*)(ws + WS_U);
    const float* DTR = (const float*)(ws + WS_DTR);
    bf16_t* XST = (bf16_t*)(ws + WS_XST); bf16_t* BCN = (bf16_t*)(ws + WS_BCN);
    float* DTS = (float*)(ws + WS_DTS); float* CUM = (float*)(ws + WS_CUM); bf16_t* ST = (bf16_t*)(ws + WS_ST); float* DEC = (float*)(ws + WS_DEC);
    const float* cw = P.in[20] + (size_t)l * 5 * 1024; const float* cb = P.in[21] + (size_t)l * 1024;
    const int t0 = chunk * 128;
    const int seq_lo = (t0 < SEQ) ? 0 : SEQ, seq_hi = (t0 < SEQ) ? SEQ : T;
    constexpr int PT = 136;
    bf16_t* xsT = (bf16_t*)lds;
    bf16_t* bT = (bf16_t*)(lds + 69632);
    float* scl = (float*)(lds + 69632 + 34816);
    auto toff = [](int row, int pos) { return row * PT + ((((pos >> 3) ^ ((row >> 3) & 15)) << 3) | (pos & 7)); };
    {
        const int cg = tid & 63, ts = tid >> 6;
        int ch;
        if (cg < 32) ch = 256 * g + 8 * cg; else if (cg < 48) ch = 512 + 128 * g + 8 * (cg - 32); else ch = 768 + 128 * g + 8 * (cg - 48);
        float wv[5][8], bv[8];
#pragma unroll
        for (int k = 0; k < 5; ++k) {
            const f32x4 a = *(const f32x4*)(cw + (size_t)k * 1024 + ch), b2 = *(const f32x4*)(cw + (size_t)k * 1024 + ch + 4);
            wv[k][0] = a.x; wv[k][1] = a.y; wv[k][2] = a.z; wv[k][3] = a.w; wv[k][4] = b2.x; wv[k][5] = b2.y; wv[k][6] = b2.z; wv[k][7] = b2.w;
        }
        { const f32x4 a = *(const f32x4*)(cb + ch), b2 = *(const f32x4*)(cb + ch + 4); bv[0] = a.x; bv[1] = a.y; bv[2] = a.z; bv[3] = a.w; bv[4] = b2.x; bv[5] = b2.y; bv[6] = b2.z; bv[7] = b2.w; }
        const int tb = t0 + ts * 16;
        u32x4 raw[20];
#pragma unroll
        for (int i = 0; i < 20; ++i) { const int t = tb - 2 + i; raw[i] = (t >= seq_lo && t < seq_hi) ? *(const u32x4*)(U + (size_t)t * NIN + U_XS + ch) : (u32x4){0u, 0u, 0u, 0u}; }
#pragma unroll
        for (int q = 0; q < 16; ++q) {
            float y[8];
#pragma unroll
            for (int i = 0; i < 8; ++i) y[i] = bv[i];
#pragma unroll
            for (int k = 0; k < 5; ++k) { const u32x4 w = raw[q + k];
                y[0] += wv[k][0] * bflo(w.x); y[1] += wv[k][1] * bfhi(w.x); y[2] += wv[k][2] * bflo(w.y); y[3] += wv[k][3] * bfhi(w.y);
                y[4] += wv[k][4] * bflo(w.z); y[5] += wv[k][5] * bfhi(w.z); y[6] += wv[k][6] * bflo(w.w); y[7] += wv[k][7] * bfhi(w.w); }
#pragma unroll
            for (int i = 0; i < 8; ++i) y[i] = siluf_(y[i]);
            const int t = tb + q, tl_ = ts * 16 + q;
            u32x4 w; w.x = pk2(y[0], y[1]); w.y = pk2(y[2], y[3]); w.z = pk2(y[4], y[5]); w.w = pk2(y[6], y[7]);
            if (cg < 32) {
                const int pos = (tl_ & ~15) | kperm(tl_ & 15);
#pragma unroll
                for (int i = 0; i < 8; ++i) xsT[toff(8 * cg + i, pos)] = f2bf(y[i]);
            } else if (cg < 48) {
                *(u32x4*)(BCN + (size_t)t * 512 + 128 * g + 8 * (cg - 32)) = w;
#pragma unroll
                for (int i = 0; i < 8; ++i) bT[toff(8 * (cg - 32) + i, tl_)] = f2bf(y[i]);
            } else {
                *(u32x4*)(BCN + (size_t)t * 512 + 256 + 128 * g + 8 * (cg - 48)) = w;
            }
        }
    }
    {
        const int j = wid, d = j >> 2, hh = 4 * g + (j & 3);
        const float a = -__expf(P.in[23][l * 16 + d * 8 + hh]);
        const float bias = P.in[22][l * 16 + d * 8 + hh];
        const int i0 = 2 * lane, i1 = 2 * lane + 1;
        const int k0 = d ? 127 - i0 : i0, k1 = d ? 127 - i1 : i1;
        const float r0 = DTR[(size_t)(t0 + k0) * 16 + d * 8 + hh] + bias, r1 = DTR[(size_t)(t0 + k1) * 16 + d * 8 + hh] + bias;
        const float sp0 = (r0 > 20.f) ? r0 : log1pf(__expf(r0)), sp1 = (r1 > 20.f) ? r1 : log1pf(__expf(r1));
        const float x0 = sp0 * a, x1 = sp1 * a;
        float incl = x0 + x1;
#pragma unroll
        for (int sft = 1; sft < 64; sft <<= 1) { const float tv = __shfl_up(incl, sft); if (lane >= sft) incl += tv; }
        const float c0 = incl - x1, c1 = incl;
        const float tot = __shfl(incl, 63);
        DTS[(size_t)(t0 + k0) * 16 + d * 8 + hh] = sp0; DTS[(size_t)(t0 + k1) * 16 + d * 8 + hh] = sp1;
        CUM[(size_t)(t0 + k0) * 16 + d * 8 + hh] = c0; CUM[(size_t)(t0 + k1) * 16 + d * 8 + hh] = c1;
        if (lane == 0) DEC[(size_t)chunk * 16 + d * 8 + hh] = __expf(tot);
        scl[j * 128 + ((k0 & ~15) | kperm(k0 & 15))] = sp0 * __expf(tot - c0);
        scl[j * 128 + ((k1 & ~15) | kperm(k1 & 15))] = sp1 * __expf(tot - c1);
    }
    __syncthreads();
    for (int i = tid; i < 256 * 16; i += NTHR) {
        const int chl = i >> 4, pc = i & 15;
        *(u32x4*)(XST + ((size_t)chunk * 512 + 256 * g + chl) * 128 + pc * 8) = *(const u32x4*)(xsT + toff(chl, pc * 8));
    }
    {
        const int j = wid, d = j >> 2, hl = j & 3, hh = 4 * g + hl;
        f32x16 acc[4][2];
#pragma unroll
        for (int nb = 0; nb < 4; ++nb)
#pragma unroll
            for (int pb = 0; pb < 2; ++pb)
#pragma unroll
                for (int i = 0; i < 16; ++i) acc[nb][pb][i] = 0.f;
        const int pr = perm32(r);
#pragma unroll 1
        for (int ks = 0; ks < 8; ++ks) {
            const f32x4 s0 = *(const f32x4*)(scl + j * 128 + 16 * ks + 8 * h), s1 = *(const f32x4*)(scl + j * 128 + 16 * ks + 8 * h + 4);
            bf16x8 xf[2];
#pragma unroll
            for (int pb = 0; pb < 2; ++pb) {
                const u32x4 w = *(const u32x4*)(xsT + toff(hl * 64 + pb * 32 + r, 16 * ks + 8 * h));
                u32x4 o; o.x = pk2(bflo(w.x) * s0.x, bfhi(w.x) * s0.y); o.y = pk2(bflo(w.y) * s0.z, bfhi(w.y) * s0.w);
                o.z = pk2(bflo(w.z) * s1.x, bfhi(w.z) * s1.y); o.w = pk2(bflo(w.w) * s1.z, bfhi(w.w) * s1.w);
                xf[pb] = __builtin_bit_cast(bf16x8, o);
            }
#pragma unroll
            for (int nb = 0; nb < 4; ++nb) {
                const u32x2 lo = *(const u32x2*)(bT + toff(nb * 32 + pr, 16 * ks + 4 * h)), hi = *(const u32x2*)(bT + toff(nb * 32 + pr, 16 * ks + 8 + 4 * h));
                u32x4 bw; bw.x = lo.x; bw.y = lo.y; bw.z = hi.x; bw.w = hi.y;
                const bf16x8 bf = __builtin_bit_cast(bf16x8, bw);
#pragma unroll
                for (int pb = 0; pb < 2; ++pb) acc[nb][pb] = MFMA32(bf, xf[pb], acc[nb][pb]);
            }
        }
        bf16_t* dst = ST + (((size_t)chunk * 2 + d) * 8 + hh) * 8192;
#pragma unroll
        for (int nb = 0; nb < 4; ++nb)
#pragma unroll
            for (int pb = 0; pb < 2; ++pb) { float v[16];
#pragma unroll
                for (int i = 0; i < 16; ++i) v[i] = acc[nb][pb][i];
                st_bf16x16(dst + (size_t)(pb * 32 + r) * 128 + nb * 32 + 16 * h, v); }
    }
    __syncthreads();
}

DI int first_unit(int off) { const int G = GRID; int v = opaque_bid() - (off % G); if (v < 0) v += G; return v; }
struct P3Sched {
    g8::GridSched<NQB, 7> G; const char* Bkv; size_t aoff;
    DI bool next(int i, g8::Unit& u) const {
        if (!G.next(i, u)) return false;
        if (u.t1 >= 3) { u.a += aoff; u.b = Bkv + (size_t)(u.t1 - 3) * G.bstep; }
        return true;
    }
};
struct EpiP3 {
    bf16_t* Q; bf16_t* KV;
    DI void operator()(const g8::Acc& acc, const g8::Unit& u, int wr, int wc, int fr, int fq) const {
        g8::Unit v = u;
        if (u.t1 < 3) { EpiBf16Plain e{Q, 768}; e(acc, v, wr, wc, fr, fq); }
        else { v.t1 = u.t1 - 3; EpiBf16Plain e{KV, 1024}; e(acc, v, wr, wc, fr, fq); }
    }
};
DI void phase_p3(const Params& P, int l, char* lds) {
    unsigned char* ws = P.ws;
    const int G = GRID;
    const bf16_t* U = (const bf16_t*)(ws + WS_U);
    for (int v = first_unit(0); v < P3_SSM; v += G) ssm_prep_unit(P, l, v >> 1, v & 1, lds);
    for (int v = first_unit(P3_SSM); v < P3_DIF; v += G) dif_prep_unit(P, l, v, lds);
    { P3Sched S; S.G.init(U + U_CQ, NIN, ws + WS_WUQ + l * SZ_WUQ, 256);
      S.G.gs = GRID - 8; S.G.c = (S.G.c < 8) ? (1 << 20) : (S.G.c - 8);
      S.Bkv = (const char*)(ws + WS_WUKV + l * SZ_WUKV); S.aoff = (size_t)(U_CKV - U_CQ) * 2;
      EpiP3 E{(bf16_t*)(ws + WS_QRAW), (bf16_t*)(ws + WS_KVRAW)};
      g8::gemm_phase<true>((LAS unsigned char*)lds, 256, NIN, S, E); }
}

DI void mla_finalize_unit(const Params& P, int l, int tile, char* lds) {
    unsigned char* ws = P.ws;
    const int tid = opaque_tid(), lane = tid & 63, wid = tid >> 6;
    const bf16_t* U = (const bf16_t*)(ws + WS_U);
    const bf16_t* QRAW = (const bf16_t*)(ws + WS_QRAW); const bf16_t* KVRAW = (const bf16_t*)(ws + WS_KVRAW);
    bf16_t* QM = (bf16_t*)(ws + WS_QM); bf16_t* KM = (bf16_t*)(ws + WS_KM); bf16_t* VMT = (bf16_t*)(ws + WS_VMT);
    const float* TABM = rope_tab(ws);
    const float* gqn = P.in[14] + l * 96; const float* gkn = P.in[15] + l * 96;
    const int head = lane >> 3, sub = lane & 7;
    const bool act = sub < 6;
    const float qscale = 0.10206207261596575f * LOG2E;
    bf16_t* vs = (bf16_t*)lds;
#pragma unroll 1
    for (int qb = 0; qb < 2; ++qb) {
    u32x2 l_cq[4]; unsigned l_ckv[4]; u32x4 l_q0[4], l_q1[4], l_k0[4], l_k1[4], l_v[4];
#pragma unroll
    for (int qq = 0; qq < 4; ++qq) {
        const int t = tile * 64 + wid * 8 + qb * 4 + qq;
        l_cq[qq] = *(const u32x2*)(U + (size_t)t * NIN + U_CQ + lane * 4);
        l_ckv[qq] = *(const unsigned*)(U + (size_t)t * NIN + U_CKV + lane * 2);
        if (act) { const bf16_t* src = QRAW + (size_t)t * 768 + head * 96 + sub * 16; l_q0[qq] = *(const u32x4*)src; l_q1[qq] = *(const u32x4*)(src + 8);
            const bf16_t* ks = (sub < 4) ? (KVRAW + (size_t)t * 1024 + head * 128 + sub * 16) : (U + (size_t)t * NIN + U_KR + (sub - 4) * 16);
            l_k0[qq] = *(const u32x4*)ks; l_k1[qq] = *(const u32x4*)(ks + 8); }
        else { l_q0[qq] = l_q1[qq] = l_k0[qq] = l_k1[qq] = (u32x4){0u, 0u, 0u, 0u}; }
        l_v[qq] = *(const u32x4*)(KVRAW + (size_t)t * 1024 + (lane >> 3) * 128 + 64 + (lane & 7) * 8);
    }
#pragma unroll
    for (int qq = 0; qq < 4; ++qq) {
        const int q = qb * 4 + qq;
        const int tl_ = wid * 8 + q, t = tile * 64 + tl_;
        const bool lat = t < SEQ;
        float rq, rkv;
        { const u32x2 w = l_cq[qq];
          float s = bflo(w.x) * bflo(w.x) + bfhi(w.x) * bfhi(w.x) + bflo(w.y) * bflo(w.y) + bfhi(w.y) * bfhi(w.y);
          s = wave_sum(s); rq = rsqrtf(s * (1.0f / 256.0f) + EPS);
          const unsigned w2 = l_ckv[qq];
          float s2 = bflo(w2) * bflo(w2) + bfhi(w2) * bfhi(w2);
          s2 = wave_sum(s2); rkv = rsqrtf(s2 * (1.0f / 128.0f) + EPS); }
        const int prow = t >> 6, pcol = 256 + (t & 63);
        {
            float x[16];
            { const u32x4 w0 = l_q0[qq], w1 = l_q1[qq];
                const unsigned ww[8] = {w0.x, w0.y, w0.z, w0.w, w1.x, w1.y, w1.z, w1.w};
#pragma unroll
                for (int i = 0; i < 8; ++i) { x[2 * i] = bflo(ww[i]) * rq; x[2 * i + 1] = bfhi(ww[i]) * rq; } }
            float ss = 0.f;
#pragma unroll
            for (int i = 0; i < 16; ++i) ss += x[i] * x[i];
            ss = oct_sum(ss);
            const float rstd = rsqrtf(ss * (1.0f / 96.0f) + EPS);
            if (act) {
#pragma unroll
                for (int i = 0; i < 16; ++i) x[i] = x[i] * rstd * gqn[sub * 16 + i];
                if (lat && sub >= 4) {
                    const int pos = (sub == 4) ? prow : pcol;
                    const float* cs = TABM + pos * 8; const float* sn = TABM + 320 * 8 + pos * 8;
#pragma unroll
                    for (int i = 0; i < 8; ++i) { const float a = x[i], b2 = x[8 + i], c = cs[i], s = sn[i]; x[i] = a * c - b2 * s; x[8 + i] = b2 * c + a * s; }
                }
#pragma unroll
                for (int i = 0; i < 16; ++i) x[i] *= qscale;
                st_bf16x16(QM + ((size_t)head * T + t) * 96 + sub * 16, x);
            }
        }
        {
            float x[16];
            { const float sc = (sub < 4) ? rkv : 1.0f;
                const u32x4 w0 = l_k0[qq], w1 = l_k1[qq];
                const unsigned ww[8] = {w0.x, w0.y, w0.z, w0.w, w1.x, w1.y, w1.z, w1.w};
#pragma unroll
                for (int i = 0; i < 8; ++i) { x[2 * i] = bflo(ww[i]) * sc; x[2 * i + 1] = bfhi(ww[i]) * sc; } }
            float ss = 0.f;
#pragma unroll
            for (int i = 0; i < 16; ++i) ss += x[i] * x[i];
            ss = oct_sum(ss);
            const float rstd = rsqrtf(ss * (1.0f / 96.0f) + EPS);
            if (act) {
#pragma unroll
                for (int i = 0; i < 16; ++i) x[i] = x[i] * rstd * gkn[sub * 16 + i];
                if (lat && sub >= 4) {
                    const int pos = (sub == 4) ? prow : pcol;
                    const float* cs = TABM + pos * 8; const float* sn = TABM + 320 * 8 + pos * 8;
#pragma unroll
                    for (int i = 0; i < 8; ++i) { const float a = x[i], b2 = x[8 + i], c = cs[i], s = sn[i]; x[i] = a * c - b2 * s; x[8 + i] = b2 * c + a * s; }
                }
                st_fp8x16((unsigned char*)KM + ((size_t)head * T + t) * 96 + sub * 16, x);
            }
        }
        {
            const int hh = lane >> 3, dv0 = (lane & 7) * 8;
            const u32x4 w = l_v[qq];
            u32x4 o; o.x = pk2(bflo(w.x) * rkv, bfhi(w.x) * rkv); o.y = pk2(bflo(w.y) * rkv, bfhi(w.y) * rkv); o.z = pk2(bflo(w.z) * rkv, bfhi(w.z) * rkv); o.w = pk2(bflo(w.w) * rkv, bfhi(w.w) * rkv);
            *(u32x4*)(vs + tl_ * 520 + hh * 64 + dv0) = o;
        }
    }
    }
    __syncthreads();
#pragma unroll 1
    for (int it = 0; it < 4; ++it) {
        const int cid = tid + it * NTHR;
        const int rowc = cid >> 2, pc = cid & 3;
        float e[16];
#pragma unroll
        for (int j = 0; j < 16; ++j) { const int key = kperm8(pc * 16 + j); e[j] = bf2f(vs[key * 520 + rowc]); }
        const int hh = rowc >> 6, dv = rowc & 63;
        st_fp8x16((unsigned char*)VMT + (((size_t)hh * NT64 + tile) * 64 + dv) * 64 + pc * 16, e);
    }
    __syncthreads();
}

DI void ssd_scan(const Params& P) {
    unsigned char* ws = P.ws;
    const bf16_t* __restrict__ ST = (const bf16_t*)(ws + WS_ST); const float* __restrict__ DEC = (const float*)(ws + WS_DEC);
    bf16_t* __restrict__ HIN = (bf16_t*)(ws + WS_HIN);
    const int total = 2 * 8 * 8192;
    static_assert(2 * 8 * 8192 == GRID * NTHR, "one element per thread");
    const int bid_ = opaque_bid();
    const int nsh = (bid_ < 4) ? 0 : ((bid_ < 8) ? 2 : 1);
#pragma unroll 1
    for (int sh = 0; sh < nsh; ++sh) {
        const int e = (sh == 0 ? bid_ : bid_ - 4) * NTHR + opaque_tid();
        const int dh = __builtin_amdgcn_readfirstlane(e >> 13), d = dh >> 3;
        float hst = 0.f;
#pragma unroll 1
        for (int b = 0; b < 5; ++b) {
            bf16_t stv[26]; float dcv[26];
#pragma unroll
            for (int j = 0; j < 26; ++j) {
                const int s = b * 26 + j;
                const int c = (d == 0) ? ((s < 2) ? (128 + s) : (s - 2)) : (129 - s);
                stv[j] = ST[(size_t)c * (16 * 8192) + e]; dcv[j] = DEC[c * 16 + dh];
            }
            __builtin_amdgcn_sched_barrier(0);
#pragma unroll
            for (int j = 0; j < 26; ++j) {
                const int s = b * 26 + j;
                const int c = (d == 0) ? ((s < 2) ? (128 + s) : (s - 2)) : (129 - s);
                HIN[(size_t)c * (16 * 8192) + e] = f2bf(hst);
                hst = hst * dcv[j] + bf2f(stv[j]);
            }
            __builtin_amdgcn_sched_barrier(0);
        }
    }
    (void)total;
}

DI void phase_p3b(const Params& P, int l, char* lds) {
    ssd_scan(P);
    for (int u = blockIdx.x; u < NT64; u += GRID) mla_finalize_unit(P, l, u, lds);
}

DI float gain_bound(const float* g, int n) { float m = 0.f; for (int i = 0; i < n; ++i) m = fmaxf(m, fabsf(g[i])); return m; }

DI void mla_attn_unit(const Params& P, int l, int head, int qb, char* lds, float shift) {
    unsigned char* ws = P.ws;
    const int tid = opaque_tid(), lane = tid & 63, wid = tid >> 6, r = lane & 31, h = lane >> 5;
    const bf16_t* QM = (const bf16_t*)(ws + WS_QM) + (size_t)head * T * 96;
    const unsigned char* KM = (const unsigned char*)(ws + WS_KM) + (size_t)head * T * 96;
    const unsigned char* VMT = (const unsigned char*)(ws + WS_VMT) + (size_t)head * T * 64;
    bf16_t* YA = (bf16_t*)(ws + WS_YA);
    const int kt0 = (qb == NQB - 1) ? (SEQ / 64) : 0, kt1 = NT64;
    f32x16 o[2]; float ls;
    attn_core<96, 64>(lds, QM + (size_t)(qb * 256 + wid * 32) * 96, KM, VMT, kt0, kt1, shift, o, ls);
    const float inv = 1.0f / ls;
    const int t = qb * 256 + wid * 32 + r;
#pragma unroll
    for (int db = 0; db < 2; ++db) { float v[16];
#pragma unroll
        for (int i = 0; i < 16; ++i) v[i] = o[db][i] * inv;
        st_bf16x16(YA + (size_t)t * 512 + head * 64 + db * 32 + 16 * h, v); }
}

DI void dif_attn_unit(const Params& P, int l, int head, int qb, char* lds, float shift, float lam, float lam_init) {
    unsigned char* ws = P.ws;
    const int tid = opaque_tid(), lane = tid & 63, wid = tid >> 6, r = lane & 31, h = lane >> 5;
    const unsigned char* VDT = (const unsigned char*)(ws + WS_VDT) + (size_t)head * T * 128;
    bf16_t* YB = (bf16_t*)(ws + WS_YB);
    float* O1 = (float*)(ws + WS_O1) + (size_t)blockIdx.x * 256 * 128;
    const int kt0 = (qb == NQB - 1) ? (SEQ / 64) : 0, kt1 = NT64;
    const int rowl = wid * 32 + r;
    {
        const int vh = head * 2;
        const bf16_t* QD = (const bf16_t*)(ws + WS_QD) + (size_t)vh * T * 64;
        const unsigned char* KD = (const unsigned char*)(ws + WS_KD) + (size_t)vh * T * 64;
        f32x16 o[4]; float ls;
        attn_core<64, 128>(lds, QD + (size_t)(qb * 256 + wid * 32) * 64, KD, VDT, kt0, kt1, shift, o, ls);
        const float inv = 1.0f / ls;
#pragma unroll
        for (int db = 0; db < 4; ++db)
#pragma unroll
            for (int q = 0; q < 4; ++q)
                *(f32x4*)(O1 + (size_t)rowl * 128 + db * 32 + 16 * h + 4 * q) = (f32x4){o[db][4 * q] * inv, o[db][4 * q + 1] * inv, o[db][4 * q + 2] * inv, o[db][4 * q + 3] * inv};
    }
    {
        const int vh = head * 2 + 1;
        const bf16_t* QD = (const bf16_t*)(ws + WS_QD) + (size_t)vh * T * 64;
        const unsigned char* KD = (const unsigned char*)(ws + WS_KD) + (size_t)vh * T * 64;
        f32x16 o[4]; float ls;
        attn_core<64, 128>(lds, QD + (size_t)(qb * 256 + wid * 32) * 64, KD, VDT, kt0, kt1, shift, o, ls);
        const float inv = 1.0f / ls;
        float ss = 0.f;
#pragma unroll
        for (int db = 0; db < 4; ++db)
#pragma unroll
            for (int q = 0; q < 4; ++q) {
                const f32x4 a = *(const f32x4*)(O1 + (size_t)rowl * 128 + db * 32 + 16 * h + 4 * q);
                o[db][4 * q] = a.x - lam * o[db][4 * q] * inv; o[db][4 * q + 1] = a.y - lam * o[db][4 * q + 1] * inv;
                o[db][4 * q + 2] = a.z - lam * o[db][4 * q + 2] * inv; o[db][4 * q + 3] = a.w - lam * o[db][4 * q + 3] * inv;
                ss += o[db][4 * q] * o[db][4 * q] + o[db][4 * q + 1] * o[db][4 * q + 1] + o[db][4 * q + 2] * o[db][4 * q + 2] + o[db][4 * q + 3] * o[db][4 * q + 3];
            }
        ss += __shfl_xor(ss, 32);
        const float rstd = rsqrtf(ss * (1.0f / 128.0f) + EPS) * (1.0f - lam_init);
        const float* gs = P.in[19] + l * 128;
        const int t = qb * 256 + rowl;
#pragma unroll
        for (int db = 0; db < 4; ++db) { float v[16];
#pragma unroll
            for (int i = 0; i < 16; ++i) v[i] = o[db][i] * rstd * gs[db * 32 + 16 * h + i];
            st_bf16x16(YB + (size_t)t * 512 + head * 128 + db * 32 + 16 * h, v); }
    }
}

DI void ssd_out_unit(const Params& P, int l, int chunk, int hf, int g, char* lds) {
    unsigned char* ws = P.ws;
    const int tid = opaque_tid(), lane = tid & 63, wid = tid >> 6, r = lane & 31, h = lane >> 5;
    const bf16_t* U = (const bf16_t*)(ws + WS_U);
    const bf16_t* XST = (const bf16_t*)(ws + WS_XST); const bf16_t* BCN = (const bf16_t*)(ws + WS_BCN);
    const float* DTS = (const float*)(ws + WS_DTS); const float* CUM = (const float*)(ws + WS_CUM);
    const bf16_t* HIN = (const bf16_t*)(ws + WS_HIN);
    bf16_t* YC = (bf16_t*)(ws + WS_YC);
    const int t0 = chunk * 128;
    char* Bs = lds; char* Cs = lds + 32768; char* Xs = lds + 49152;
    float* dt0 = (float*)(lds + 114688);
    float* dt1 = dt0 + 512; float* cm0 = dt1 + 512; float* cm1 = cm0 + 512;
    float* ssq = cm1 + 512;
    bf16x8 hq[2][8];
    { const int hl_ = wid >> 1, hh_ = 4 * g + hl_, pr_ = perm32(r);
      const bf16_t* hp_ = HIN + (((size_t)chunk * 2 + 0) * 8 + hh_) * 8192;
#pragma unroll
      for (int pb = 0; pb < 2; ++pb)
#pragma unroll
          for (int ks = 0; ks < 8; ++ks) hq[pb][ks] = *(const bf16x8*)(hp_ + (size_t)(pb * 32 + pr_) * 128 + 16 * ks + 8 * h); }
    {
        u32x4 tb_[4], tc_[2], tx_[8]; float ts_[4];
#pragma unroll
        for (int j = 0; j < 4; ++j) { const int i = tid + j * NTHR, row = i >> 4, c = i & 15; tb_[j] = *(const u32x4*)(BCN + (size_t)(t0 + row) * 512 + 128 * g + c * 8); }
#pragma unroll
        for (int j = 0; j < 2; ++j) { const int i = tid + j * NTHR, row = i >> 4, c = i & 15; tc_[j] = *(const u32x4*)(BCN + (size_t)(t0 + hf * 64 + row) * 512 + 256 + 128 * g + c * 8); }
#pragma unroll
        for (int j = 0; j < 8; ++j) { const int i = tid + j * NTHR, row = i >> 4, c = i & 15; tx_[j] = *(const u32x4*)(XST + ((size_t)chunk * 512 + 256 * g + row) * 128 + c * 8); }
        { const int hl_ = tid >> 7, s_ = tid & 127, hh_ = 4 * g + hl_; const size_t b_ = (size_t)(t0 + s_) * 16;
          ts_[0] = DTS[b_ + hh_]; ts_[1] = DTS[b_ + 8 + hh_]; ts_[2] = CUM[b_ + hh_]; ts_[3] = CUM[b_ + 8 + hh_]; }
#pragma unroll
        for (int j = 0; j < 4; ++j) { const int i = tid + j * NTHR, row = i >> 4, c = i & 15; *(u32x4*)(Bs + row * 256 + ((c ^ (row & 15)) << 4)) = tb_[j]; }
#pragma unroll
        for (int j = 0; j < 2; ++j) { const int i = tid + j * NTHR, row = i >> 4, c = i & 15; *(u32x4*)(Cs + row * 256 + ((c ^ (row & 15)) << 4)) = tc_[j]; }
#pragma unroll
        for (int j = 0; j < 8; ++j) { const int i = tid + j * NTHR, row = i >> 4, c = i & 15; *(u32x4*)(Xs + row * 256 + ((c ^ (row & 15)) << 4)) = tx_[j]; }
        dt0[tid] = ts_[0]; dt1[tid] = ts_[1]; cm0[tid] = ts_[2]; cm1[tid] = ts_[3];
    }
    __syncthreads();
    const int hl = wid >> 1, lb = wid & 1, hh = 4 * g + hl;
    const int lrow = hf * 64 + lb * 32 + r;
    const int pr = perm32(r);
    bf16x8 cf[8];
    { const int crow_ = lb * 32 + r;
#pragma unroll
      for (int ks = 0; ks < 8; ++ks) cf[ks] = *(const bf16x8*)(Cs + crow_ * 256 + (((2 * ks + h) ^ (crow_ & 15)) << 4)); }
    const float c0l = cm0[hl * 128 + lrow], c1l = cm1[hl * 128 + lrow];
    f32x16 y[2];
#pragma unroll
    for (int pb = 0; pb < 2; ++pb)
#pragma unroll
        for (int i = 0; i < 16; ++i) y[pb][i] = 0.f;
#define SSD_OFFDIAG(d) do { f32x16 a_[2]; \
        _Pragma("unroll") for (int pb = 0; pb < 2; ++pb) _Pragma("unroll") for (int i = 0; i < 16; ++i) a_[pb][i] = 0.f; \
        _Pragma("unroll") for (int ks = 0; ks < 8; ++ks) _Pragma("unroll") for (int pb = 0; pb < 2; ++pb) a_[pb] = MFMA32(hq[pb][ks], cf[ks], a_[pb]); \
        const float e_ = __expf((d) == 0 ? c0l : c1l); \
        _Pragma("unroll") for (int pb = 0; pb < 2; ++pb) _Pragma("unroll") for (int i = 0; i < 16; ++i) y[pb][i] += e_ * a_[pb][i]; } while (0)
#define SSD_LDH(d) do { const bf16_t* hp_ = HIN + (((size_t)chunk * 2 + (d)) * 8 + hh) * 8192; \
        _Pragma("unroll") for (int pb = 0; pb < 2; ++pb) _Pragma("unroll") for (int ks = 0; ks < 8; ++ks) hq[pb][ks] = *(const bf16x8*)(hp_ + (size_t)(pb * 32 + pr) * 128 + 16 * ks + 8 * h); } while (0)
    SSD_OFFDIAG(0);
    SSD_LDH(1);
#pragma unroll 1
    for (int sb = 0; sb < 4; ++sb) {
        f32x16 x;
#pragma unroll
        for (int i = 0; i < 16; ++i) x[i] = 0.f;
        const int brow = sb * 32 + r;
#pragma unroll
        for (int ks = 0; ks < 8; ++ks) {
            const bf16x8 bf = *(const bf16x8*)(Bs + brow * 256 + (((2 * ks + h) ^ (brow & 15)) << 4));
            x = MFMA32(bf, cf[ks], x);
        }
        float m[16];
#pragma unroll
        for (int q4 = 0; q4 < 4; ++q4) {
            const int s0 = sb * 32 + 8 * q4 + 4 * h;
            const f32x4 vc0 = *(const f32x4*)(cm0 + hl * 128 + s0), vc1 = *(const f32x4*)(cm1 + hl * 128 + s0);
            const f32x4 vd0 = *(const f32x4*)(dt0 + hl * 128 + s0), vd1 = *(const f32x4*)(dt1 + hl * 128 + s0);
#pragma unroll
            for (int jj = 0; jj < 4; ++jj) {
                const int s = s0 + jj;
                const float w0 = (s <= lrow) ? __expf(fminf(c0l - vc0[jj], 0.f)) * vd0[jj] : 0.f;
                const float w1 = (s >= lrow) ? __expf(fminf(c1l - vc1[jj], 0.f)) * vd1[jj] : 0.f;
                m[4 * q4 + jj] = x[4 * q4 + jj] * (w0 + w1);
            }
        }
#pragma unroll
        for (int s2 = 0; s2 < 2; ++s2) {
            u32x4 w; w.x = pk2(m[8 * s2 + 0], m[8 * s2 + 1]); w.y = pk2(m[8 * s2 + 2], m[8 * s2 + 3]); w.z = pk2(m[8 * s2 + 4], m[8 * s2 + 5]); w.w = pk2(m[8 * s2 + 6], m[8 * s2 + 7]);
            const bf16x8 mf = __builtin_bit_cast(bf16x8, w);
#pragma unroll
            for (int pb = 0; pb < 2; ++pb) {
                const int xrow = hl * 64 + pb * 32 + pr, c = 2 * (2 * sb + s2) + h;
                const bf16x8 xf = *(const bf16x8*)(Xs + xrow * 256 + ((c ^ (xrow & 15)) << 4));
                y[pb] = MFMA32(xf, mf, y[pb]);
            }
        }
    }
    SSD_OFFDIAG(1);
#undef SSD_OFFDIAG
#undef SSD_LDH
    const int t = t0 + lrow;
    const float dsk = P.in[24][l * 16 + hh] + P.in[24][l * 16 + 8 + hh];
    float ss = 0.f;
#pragma unroll
    for (int pb = 0; pb < 2; ++pb) {
        const int ch = hh * 64 + pb * 32 + 16 * h;
        const u32x4 z0 = *(const u32x4*)(U + (size_t)t * NIN + U_Z + ch), z1 = *(const u32x4*)(U + (size_t)t * NIN + U_Z + ch + 8);
        const unsigned zw[8] = {z0.x, z0.y, z0.z, z0.w, z1.x, z1.y, z1.z, z1.w};
        const int xpos = (lrow & ~15) | kperm(lrow & 15);
#pragma unroll
        for (int q = 0; q < 8; ++q) {
            const int xr0 = hl * 64 + pb * 32 + 16 * h + 2 * q, xr1 = xr0 + 1;
            const float xa = bf2f(*(const bf16_t*)(Xs + xr0 * 256 + (((xpos >> 3) ^ (xr0 & 15)) << 4) + (xpos & 7) * 2));
            const float xb = bf2f(*(const bf16_t*)(Xs + xr1 * 256 + (((xpos >> 3) ^ (xr1 & 15)) << 4) + (xpos & 7) * 2));
            float v0 = y[pb][2 * q] + dsk * xa, v1 = y[pb][2 * q + 1] + dsk * xb;
            v0 *= siluf_(bflo(zw[q])); v1 *= siluf_(bfhi(zw[q]));
            y[pb][2 * q] = v0; y[pb][2 * q + 1] = v1; ss += v0 * v0 + v1 * v1;
        }
    }
    ss += __shfl_xor(ss, 32);
    if (h == 0) ssq[hl * 64 + lb * 32 + r] = ss;
    __syncthreads();
    const int rr = lb * 32 + r;
    const float tot = ssq[rr] + ssq[64 + rr] + ssq[128 + rr] + ssq[192 + rr];
    const float rstd = rsqrtf(tot * (1.0f / 256.0f) + EPS);
    const float* gn = P.in[25] + l * 512;
#pragma unroll
    for (int pb = 0; pb < 2; ++pb) { const int ch = hh * 64 + pb * 32 + 16 * h; float v[16];
#pragma unroll
        for (int i = 0; i < 16; ++i) v[i] = y[pb][i] * rstd * gn[ch + i];
        st_bf16x16(YC + (size_t)t * 512 + ch, v); }
    __syncthreads();
}

constexpr int P4_DIF = 4 * NQB, P4_MLA = 8 * NQB, P4_SSD = NCHUNK * 4;

DI void phase_p4(const Params& P, int l, char* lds) {
    const int G = GRID;
    const float* ac_ = (const float*)((const int*)(P.ws + WS_CTL) + l * 32 * ECS + 40);
    const float sh_m = ac_[0], sh_d = ac_[1];
    float lam = ac_[2];
    const float lam_init = 0.8f - 0.6f * __expf(-0.3f * (float)l);
    lam += lam_init;
    const bool lastl = (l == NLAYER - 1);
    const int ndif = lastl ? 4 * (NQB - 1) : P4_DIF, nmla = lastl ? 8 * (NQB - 1) : P4_MLA, nssd = lastl ? (NCHUNK - 2) * 4 : P4_SSD;
    for (int v = first_unit(0); v < ndif; v += G) dif_attn_unit(P, l, v & 3, v >> 2, lds, sh_d, lam, lam_init);
    for (int v = first_unit(P4_DIF); v < nmla; v += G) mla_attn_unit(P, l, v & 7, v >> 3, lds, sh_m);
    {
        int* wq = (int*)(P.ws + WS_CTL) + l * 32 * ECS + 32;
        int* sl = (int*)(lds + 160000);
        for (;;) {
            __syncthreads();
            if (opaque_tid() == 0) *sl = __hip_atomic_fetch_add(wq, 1, __ATOMIC_RELAXED, __HIP_MEMORY_SCOPE_AGENT);
            __syncthreads();
            const int v = __builtin_amdgcn_readfirstlane(*sl);
            if (v >= nssd) break;
            ssd_out_unit(P, l, v >> 2, (v >> 1) & 1, v & 1, lds);
        }
    }
}

constexpr int N_PHASES = 2 + 10 * NLAYER;
#ifndef MK_PER_PHASE
#define MK_PER_PHASE 0
#endif

template <bool FUSED>
__global__ void __launch_bounds__(NTHR, 2) mega_fwd(Params P0) {
    extern __shared__ __attribute__((aligned(16))) char lds[];
    const int lo = FUSED ? 0 : P0.ph_lo, hi = FUSED ? N_PHASES : P0.ph_hi;
    constexpr bool fused = FUSED;
    volatile LAS unsigned* xbw = (volatile LAS unsigned*)(lds + LDS_BYTES - 16);
    XcdBarrier bar; bar.bar = (unsigned*)(P0.ws + WS_BAR); bar.x = 0; bar.st = xbw;
    if (fused) {
        if (threadIdx.x == 0) { xbw[0] = 0u; xbw[1] = 0u; xbw[2] = 0u; xbw[3] = 0u; }
        __syncthreads();
        bar = xcd_barrier_post((unsigned*)(P0.ws + WS_BAR), xbw);
    }
#define IN(k) (FUSED || (lo <= (k) && (k) < hi))
#define SEAM(k) do { if (FUSED) { if ((k) + 1 < N_PHASES) { XcdBarrier b2_ = bar; b2_.x = xb_xcc_id(); xcd_barrier(b2_); } } } while (0)
    if (IN(0)) phase_prologue(P0, lds);
    SEAM(0);
    if (IN(1)) phase_rows_norm1(P0, -1, 0);
    SEAM(1);
#pragma unroll 1
    for (int l = 0; l < NLAYER; ++l) {
        const int b = 2 + 10 * l;
        Params Q = P0; { int z = 0; asm volatile("" : "+s"(z)); Q.ws = P0.ws + z; }
        if (IN(b + 0)) phase_gemm_in(Q, l, lds);
        SEAM(b + 0);
        if (IN(b + 1)) phase_p3(Q, l, lds);
        SEAM(b + 1);
        if (IN(b + 2)) phase_p3b(Q, l, lds);
        SEAM(b + 2);
        if (IN(b + 3)) phase_p4(Q, l, lds);
        SEAM(b + 3);
        if (IN(b + 4)) phase_gemm_merge(Q, l, lds);
        SEAM(b + 4);
        if (IN(b + 5)) phase_gemm_out(Q, l, lds);
        SEAM(b + 5);
        if (IN(b + 6)) phase_router(Q, l, lds);
        SEAM(b + 6);
        if (IN(b + 7)) phase_moe_gu(Q, l, lds);
        SEAM(b + 7);
        if (IN(b + 8)) phase_moe_down(Q, l, lds);
        SEAM(b + 8);
        if (IN(b + 9)) phase_rows_norm1(Q, l, l + 1);
        SEAM(b + 9);
    }
#undef IN
#undef SEAM
}


extern "C" void kernel_launch(void* const* d_in, const int* in_sizes, int n_in, void* d_out, int out_size, void* d_ws, size_t ws_size, hipStream_t stream) {
    static int grid = 0;
    if (grid == 0) {
        if (n_in != 36 || ws_size < WS_END) { fprintf(stderr, "kernel_launch: unexpected n_in %d or ws_size %zu (< %zu)\n", n_in, ws_size, (size_t)WS_END); grid = -1; return; }
        int dev = 0, cus = 0;
        if (hipGetDevice(&dev) != hipSuccess || hipDeviceGetAttribute(&cus, hipDeviceAttributeMultiprocessorCount, dev) != hipSuccess) { grid = -1; return; }
        if (hipFuncSetAttribute((const void*)mega_fwd<MK_PER_PHASE == 0>, hipFuncAttributeMaxDynamicSharedMemorySize, LDS_BYTES) != hipSuccess) { fprintf(stderr, "kernel_launch: hipFuncSetAttribute failed\n"); grid = -1; return; }
        int per_cu = 0;
        if (hipOccupancyMaxActiveBlocksPerMultiprocessor(&per_cu, (const void*)mega_fwd<MK_PER_PHASE == 0>, NTHR, LDS_BYTES) != hipSuccess || per_cu < 1) { fprintf(stderr, "kernel_launch: occupancy query says %d\n", per_cu); }
        (void)hipGetLastError();
        if (cus < GRID) { fprintf(stderr, "kernel_launch: built for a %d-CU device, found %d CUs; nothing launched\n", GRID, cus); grid = -1; return; }
        grid = GRID;
    }
    if (grid < 0) return;
    (void)hipMemsetAsync((char*)d_ws + WS_BAR, 0, WS_MOD - WS_BAR, stream);
    Params p{};
    for (int i = 0; i < 36; ++i) p.in[i] = (const float*)d_in[i];
    p.out = (float*)d_out; p.ws = (unsigned char*)d_ws;
#if MK_PER_PHASE
    for (int k = 0; k < N_PHASES; ++k) { p.ph_lo = k; p.ph_hi = k + 1; hipLaunchKernelGGL(mega_fwd<MK_PER_PHASE == 0>, dim3(grid), dim3(NTHR), LDS_BYTES, stream, p); }
#else
    p.ph_lo = 0; p.ph_hi = N_PHASES;
    hipLaunchKernelGGL(mega_fwd<MK_PER_PHASE == 0>, dim3(grid), dim3(NTHR), LDS_BYTES, stream, p);
#endif
}
```
